# Optimizing an MI355X kernel written in HIP

```python
import jax
import jax.numpy as jnp
from jax import lax
import numpy as np

D_MODEL = 2048
BATCH = 4
SEQ = 4096
DEPTH = 2
DEC_BATCH = 8
DEC_SEQ = 16
PAST_LEN = 1024

CHUNK = 64
Q_BLOCK = 128
D_MIX = D_MODEL
D_A = D_MIX // 2
H_A = 4
DV_A = D_A // H_A
DK_A = DV_A // 2
D_B = D_MIX - D_A
H_B = 8
DH_B = D_B // H_B
D_FF = 4 * D_MODEL
N_GATES = 2 * H_A + H_B
ALPHA = (2 * DEPTH) ** 0.25
BETA = (8 * DEPTH) ** -0.25
LN_EPS = 1e-5
HEAD_NORM_EPS = 1e-6
IN_WIDTHS = (H_A * DK_A, H_A * DK_A, D_A, D_A, H_A, H_A, D_B, D_B, D_B, H_B)
N_IN = sum(IN_WIDTHS)
SPLIT_POINTS = tuple(int(s) for s in np.cumsum(IN_WIDTHS)[:-1])

kernel_name = 'hybrid_mlstm_fox_stream_step'


def layer_norm(x, g, b):
    xf = x.astype(jnp.float32)
    mu = jnp.mean(xf, axis=-1, keepdims=True)
    var = jnp.mean(jnp.square(xf - mu), axis=-1, keepdims=True)
    y = (xf - mu) * lax.rsqrt(var + LN_EPS) * g.astype(jnp.float32) + b.astype(jnp.float32)
    return y.astype(x.dtype)


def heads_first(t, n_heads):
    b, l, _ = t.shape
    return t.reshape(b, l, n_heads, -1).transpose(0, 2, 1, 3).astype(jnp.float32)


def mlstm_chunk(carry, inp):
    c, n, m = carry
    q, k, v, ig, lf = inp
    cl = q.shape[2]
    b = jnp.cumsum(lf, axis=-1)
    causal = jnp.tril(jnp.ones((cl, cl), dtype=bool))
    d = jnp.where(causal, b[..., :, None] - b[..., None, :] + ig[..., None, :], -jnp.inf)
    g = b + m[..., None]
    m_t = jnp.maximum(g, jnp.max(d, axis=-1))
    w_inter = jnp.exp(g - m_t)
    s = jnp.einsum('bhtk,bhsk->bhts', q, k) * jnp.exp(d - m_t[..., None])
    num = w_inter[..., None] * jnp.einsum('bhvk,bhtk->bhtv', c, q) + jnp.einsum('bhts,bhsv->bhtv', s, v)
    den = w_inter * jnp.einsum('bhk,bhtk->bht', n, q) + jnp.sum(s, axis=-1)
    h = num / jnp.maximum(jnp.abs(den), jnp.exp(-m_t))[..., None]
    m_new = m_t[..., -1]
    a = jnp.exp(b[..., -1:] - b + ig - m_new[..., None])
    decay = jnp.exp(b[..., -1] + m - m_new)
    c_new = decay[..., None, None] * c + jnp.einsum('bhs,bhsv,bhsk->bhvk', a, v, k)
    n_new = decay[..., None] * n + jnp.einsum('bhs,bhsk->bhk', a, k)
    return (c_new, n_new, m_new), h


def mlstm_sequence(q, k, v, ig, lf, c0, n0, m0):
    bsz, nh, l, _ = q.shape
    cl = min(CHUNK, l)
    nc = l // cl

    def to_chunks(t):
        return jnp.moveaxis(t.reshape(t.shape[:2] + (nc, cl) + t.shape[3:]), 2, 0)

    carry0 = (c0.astype(jnp.float32), n0.astype(jnp.float32), m0.astype(jnp.float32))
    xs = (to_chunks(q), to_chunks(k), to_chunks(v), to_chunks(ig), to_chunks(lf))
    (c, n, m), h = lax.scan(mlstm_chunk, carry0, xs)
    h = jnp.moveaxis(h, 0, 2).reshape(bsz, nh, l, -1)
    return h, c, n, m


def mlstm_mixer(qa, ka, va, oa, ig, lf, g_head, c0, n0, m0):
    bsz, l, _ = qa.shape
    q = heads_first(qa, H_A) * (DK_A ** -0.5)
    k = heads_first(ka, H_A)
    v = heads_first(va, H_A)
    h, c, n, m = mlstm_sequence(q, k, v, ig.transpose(0, 2, 1), lf.transpose(0, 2, 1), c0, n0, m0)
    h = h * lax.rsqrt(jnp.mean(jnp.square(h), axis=-1, keepdims=True) + HEAD_NORM_EPS)
    h = h.transpose(0, 2, 1, 3).reshape(bsz, l, D_A) * g_head.astype(jnp.float32)
    h = h * jax.nn.sigmoid(oa.astype(jnp.float32))
    return h.astype(qa.dtype), c, n, m


def fox_attend(q, fq, pos_q, k, v, fk):
    logits = jnp.einsum('bthd,bshd->bhts', q, k, preferred_element_type=jnp.float32) * (DH_B ** -0.5)
    logits = logits + fq.transpose(0, 2, 1)[..., :, None] - fk.transpose(0, 2, 1)[..., None, :]
    visible = jnp.arange(k.shape[1])[None, :] <= pos_q[:, None]
    p = jax.nn.softmax(jnp.where(visible, logits, -jnp.inf), axis=-1)
    return jnp.einsum('bhts,bshd->bthd', p.astype(v.dtype), v)


def fox_prompt(q, k, v, lf):
    bsz, l, nh, dh = q.shape
    f = jnp.cumsum(lf, axis=1)

    def block(i):
        start = i * Q_BLOCK
        qb = lax.dynamic_slice_in_dim(q, start, Q_BLOCK, axis=1)
        fb = lax.dynamic_slice_in_dim(f, start, Q_BLOCK, axis=1)
        return fox_attend(qb, fb, start + jnp.arange(Q_BLOCK), k, v, f)

    out = lax.map(block, jnp.arange(l // Q_BLOCK))
    return jnp.moveaxis(out, 0, 1).reshape(bsz, l, nh * dh)


def fox_sample(q, k, v, lf, ck, cv, clf):
    bsz, l, nh, dh = q.shape
    past = ck.shape[1]
    k_all = jnp.concatenate([ck.astype(k.dtype), k], axis=1)
    v_all = jnp.concatenate([cv.astype(v.dtype), v], axis=1)
    f = jnp.cumsum(jnp.concatenate([clf.astype(jnp.float32), lf], axis=1), axis=1)
    out = fox_attend(q, f[:, past:], past + jnp.arange(l), k_all, v_all, f)
    return out.reshape(bsz, l, nh * dh)


def trunk_layer(x, past, w_in, b_gates, g_mlstm, w_out, ln1_g, ln1_b, w_up, w_down, ln2_g, ln2_b):
    bsz, l, _ = x.shape
    qa, ka, va, oa, ia, fa, qb, kb, vb, fb = jnp.split(x @ w_in, SPLIT_POINTS, axis=-1)
    gates = jnp.concatenate([ia, fa, fb], axis=-1).astype(jnp.float32) + b_gates.astype(jnp.float32)
    ig = gates[..., :H_A]
    lfa = jax.nn.log_sigmoid(gates[..., H_A:2 * H_A])
    lfb = jax.nn.log_sigmoid(gates[..., 2 * H_A:])
    qb = qb.reshape(bsz, l, H_B, DH_B)
    kb = kb.reshape(bsz, l, H_B, DH_B)
    vb = vb.reshape(bsz, l, H_B, DH_B)
    if past is None:
        c0 = jnp.zeros((bsz, H_A, DV_A, DK_A), jnp.float32)
        n0 = jnp.zeros((bsz, H_A, DK_A), jnp.float32)
        m0 = jnp.zeros((bsz, H_A), jnp.float32)
        h_b = fox_prompt(qb, kb, vb, lfb)
    else:
        ck, cv, clf, c0, n0, m0 = past
        h_b = fox_sample(qb, kb, vb, lfb, ck, cv, clf)
    h_a, c, n, m = mlstm_mixer(qa, ka, va, oa, ig, lfa, g_mlstm, c0, n0, m0)
    mix = jnp.concatenate([h_a, h_b.astype(h_a.dtype)], axis=-1) @ w_out
    x1 = layer_norm(ALPHA * x + mix, ln1_g, ln1_b)
    ff = jnp.square(jax.nn.relu(x1 @ w_up)) @ w_down
    y = layer_norm(ALPHA * x1 + ff, ln2_g, ln2_b)
    dt = x.dtype
    return y, (kb, vb, lfb.astype(dt), c.astype(dt), n.astype(dt), m.astype(dt))


def stack_field(states, i):
    return jnp.stack([s[i] for s in states], axis=0)


def setup_inputs(seed: int = 0) -> dict:
    key = jax.random.key(seed)
    ks = jax.random.split(key, 20)
    nrm = jax.random.normal
    f32 = jnp.float32
    x_prompt = nrm(ks[0], (BATCH, SEQ, D_MODEL), f32)
    x_sample = nrm(ks[1], (DEC_BATCH, DEC_SEQ, D_MODEL), f32)
    cache_fox_k = nrm(ks[2], (DEPTH, DEC_BATCH, PAST_LEN, H_B, DH_B), f32)
    cache_fox_v = nrm(ks[3], (DEPTH, DEC_BATCH, PAST_LEN, H_B, DH_B), f32)
    cache_fox_logf = jax.nn.log_sigmoid(3.0 + nrm(ks[4], (DEPTH, DEC_BATCH, PAST_LEN, H_B), f32))
    state_mlstm_c = 0.1 * nrm(ks[5], (DEPTH, DEC_BATCH, H_A, DV_A, DK_A), f32)
    state_mlstm_n = 0.1 * nrm(ks[6], (DEPTH, DEC_BATCH, H_A, DK_A), f32)
    state_mlstm_m = 1.0 + 0.5 * nrm(ks[7], (DEPTH, DEC_BATCH, H_A), f32)
    w_in = nrm(ks[8], (DEPTH, D_MODEL, N_IN), f32) * (D_MODEL ** -0.5)
    gate_base = jnp.concatenate([jnp.full((H_A,), -1.0, f32),
                                 jnp.linspace(3.0, 6.0, H_A, dtype=f32),
                                 jnp.linspace(1.0, 5.0, H_B, dtype=f32)])
    b_gates = gate_base[None, :] + 0.1 * nrm(ks[9], (DEPTH, N_GATES), f32)
    g_mlstm = 1.0 + 0.01 * nrm(ks[10], (DEPTH, D_A), f32)
    w_out = nrm(ks[11], (DEPTH, D_MIX, D_MODEL), f32) * (D_MIX ** -0.5 * BETA)
    ln1_g = 1.0 + 0.01 * nrm(ks[12], (DEPTH, D_MODEL), f32)
    ln1_b = 0.01 * nrm(ks[13], (DEPTH, D_MODEL), f32)
    w_up = nrm(ks[14], (DEPTH, D_MODEL, D_FF), f32) * (D_MODEL ** -0.5)
    w_down = nrm(ks[15], (DEPTH, D_FF, D_MODEL), f32) * (D_FF ** -0.5 * BETA)
    ln2_g = 1.0 + 0.01 * nrm(ks[16], (DEPTH, D_MODEL), f32)
    ln2_b = 0.01 * nrm(ks[17], (DEPTH, D_MODEL), f32)
    return {'x_prompt': x_prompt, 'x_sample': x_sample,
            'cache_fox_k': cache_fox_k, 'cache_fox_v': cache_fox_v, 'cache_fox_logf': cache_fox_logf,
            'state_mlstm_c': state_mlstm_c, 'state_mlstm_n': state_mlstm_n, 'state_mlstm_m': state_mlstm_m,
            'w_in': w_in, 'b_gates': b_gates, 'g_mlstm': g_mlstm, 'w_out': w_out,
            'ln1_g': ln1_g, 'ln1_b': ln1_b, 'w_up': w_up, 'w_down': w_down,
            'ln2_g': ln2_g, 'ln2_b': ln2_b}


def reference(x_prompt, x_sample, cache_fox_k, cache_fox_v, cache_fox_logf, state_mlstm_c,
              state_mlstm_n, state_mlstm_m, w_in, b_gates, g_mlstm, w_out, ln1_g, ln1_b,
              w_up, w_down, ln2_g, ln2_b):
    yp = x_prompt
    ys = x_sample
    new_p = []
    new_s = []
    for layer in range(DEPTH):
        weights = (w_in[layer], b_gates[layer], g_mlstm[layer], w_out[layer], ln1_g[layer],
                   ln1_b[layer], w_up[layer], w_down[layer], ln2_g[layer], ln2_b[layer])
        yp, st_p = trunk_layer(yp, None, *weights)
        past = (cache_fox_k[layer], cache_fox_v[layer], cache_fox_logf[layer],
                state_mlstm_c[layer], state_mlstm_n[layer], state_mlstm_m[layer])
        ys, st_s = trunk_layer(ys, past, *weights)
        new_p.append(st_p)
        new_s.append(st_s)
    fox_k_p = stack_field(new_p, 0)
    fox_v_p = stack_field(new_p, 1)
    fox_logf_p = stack_field(new_p, 2)
    mlstm_c_p = stack_field(new_p, 3)
    mlstm_n_p = stack_field(new_p, 4)
    mlstm_m_p = stack_field(new_p, 5)
    fox_k_s = stack_field(new_s, 0)
    fox_v_s = stack_field(new_s, 1)
    fox_logf_s = stack_field(new_s, 2)
    mlstm_c_s = stack_field(new_s, 3)
    mlstm_n_s = stack_field(new_s, 4)
    mlstm_m_s = stack_field(new_s, 5)
    return (yp, ys, fox_k_p, fox_v_p, fox_logf_p, mlstm_c_p, mlstm_n_p, mlstm_m_p,
            fox_k_s, fox_v_s, fox_logf_s, mlstm_c_s, mlstm_n_s, mlstm_m_s)
```

```cpp
#include <hip/hip_runtime.h>
#include <hip/hip_cooperative_groups.h>
#include <cstdio>
#include <cstdint>
namespace cg = cooperative_groups;

constexpr int DM = 2048, NBATCH = 4, SEQ = 4096, MP = NBATCH * SEQ;
constexpr int SBATCH = 8, SLEN = 16, MS = SBATCH * SLEN;
constexpr int MT = MP + MS, MPAD = 16640;
constexpr int PAST = 1024, HA = 4, DVA = 256, DKA = 128, HB = 8, DHB = 128, DFF = 8192;
constexpr int NP = 6144;
constexpr int NIN = 6400, NINSRC = 6160;
constexpr int PC_QA = 0, PC_KA = 512, PC_VA = 1024, PC_OA = 2048, PC_QB = 3072, PC_KB = 4096, PC_VB = 5120;
constexpr float ALPHA = 1.4142135623730951f;
constexpr float LN_EPS = 1e-5f, HN_EPS = 1e-6f;
constexpr float LOG2E = 1.4426950408889634f;
constexpr float QA_SCALE = 0.08838834764831845f;
constexpr float QB_SCALE = 0.08838834764831845f * 1.4426950408889634f;

constexpr size_t O_YP = 0, O_YS = O_YP + (size_t)MP * DM, O_KP = O_YS + (size_t)MS * DM, O_VP = O_KP + (size_t)2 * MP * 1024,
                 O_LFP = O_VP + (size_t)2 * MP * 1024, O_CP = O_LFP + (size_t)2 * MP * 8, O_NP = O_CP + (size_t)2 * 4 * 4 * 256 * 128,
                 O_MP = O_NP + (size_t)2 * 4 * 4 * 128, O_KS = O_MP + 32, O_VS = O_KS + (size_t)2 * MS * 1024, O_LFS = O_VS + (size_t)2 * MS * 1024,
                 O_CS = O_LFS + (size_t)2 * MS * 8, O_NS = O_CS + (size_t)2 * 8 * 4 * 256 * 128, O_MS = O_NS + (size_t)2 * 8 * 4 * 128, O_END = O_MS + 64;

constexpr size_t MiB = 1u << 20;
constexpr size_t WS_CTL = 0;
constexpr size_t WS_WIN = 1 * MiB;
constexpr size_t WS_WOUT = 26 * MiB;
constexpr size_t WS_WUP = 34 * MiB;
constexpr size_t WS_WDN = 66 * MiB;
constexpr size_t WS_XB = 98 * MiB;
constexpr size_t WS_G = 163 * MiB;
constexpr size_t WS_LFT = WS_G + (size_t)MPAD * 16 * 4;
constexpr size_t WS_LFS = WS_LFT + (size_t)32 * 4096 * 4;
constexpr size_t WS_Z = 166 * MiB;
constexpr size_t WS_P = 296 * MiB;
constexpr size_t WS_MIX = WS_P + (size_t)MPAD * NP * 2;
constexpr size_t WS_H = WS_P;
constexpr size_t WS_PART = WS_P + (size_t)MPAD * DFF * 2;
constexpr size_t WS_WOUT2 = WS_PART + (size_t)32 * MS * DM * 4;
constexpr size_t WS_WUP2 = WS_WOUT2 + 8 * MiB;
constexpr size_t WS_END = WS_WUP2 + 32 * MiB;
constexpr int NSL_OUT = 16, NSL_DN = 32;
static_assert(WS_LFS + 64 * 16 * 4 <= WS_Z && WS_Z + (size_t)MPAD * DM * 4 <= WS_P && WS_MIX + (size_t)MPAD * DM * 2 <= WS_PART, "ws map");

#define LAS __attribute__((address_space(3)))
#define GAS __attribute__((address_space(1)))
typedef unsigned short bf16_t;
typedef short bf16x8 __attribute__((ext_vector_type(8)));
typedef short s16x4 __attribute__((ext_vector_type(4)));
typedef float f32x2 __attribute__((ext_vector_type(2)));
typedef float f32x4 __attribute__((ext_vector_type(4)));
typedef float f32x16 __attribute__((ext_vector_type(16)));
typedef unsigned u32x2 __attribute__((ext_vector_type(2)));
typedef unsigned u32x4 __attribute__((ext_vector_type(4)));
typedef __bf16 bf16x2_t __attribute__((ext_vector_type(2)));

__device__ __forceinline__ int opaque_tid(int wv) { int l; asm volatile("v_mbcnt_lo_u32_b32 %0, -1, 0\n\tv_mbcnt_hi_u32_b32 %0, -1, %0" : "=v"(l)); return wv * 64 + l; }
template <class T> __device__ __forceinline__ T* as_global(T* p) { return (T*)(__attribute__((address_space(1))) T*)p; }
__device__ __forceinline__ float bf2f(unsigned short u) { return __uint_as_float((unsigned)u << 16); }
__device__ __forceinline__ float bflo(unsigned u) { return __uint_as_float(u << 16); }
__device__ __forceinline__ float bfhi(unsigned u) { return __uint_as_float(u & 0xffff0000u); }
__device__ __forceinline__ unsigned pkbf(float lo, float hi) { f32x2 v = {lo, hi}; bf16x2_t b = __builtin_convertvector(v, bf16x2_t); return __builtin_bit_cast(unsigned, b); }
__device__ __forceinline__ float log_sigmoid(float x) {
    const float e = __expf(-fabsf(x));
    const float l = e < 0.03125f ? e * (1.0f - e * (0.5f - e * (0.33333334f - 0.25f * e))) : __logf(1.0f + e);
    return fminf(x, 0.f) - l; }
__device__ __forceinline__ int crow(int r, int hi) { return (r & 3) + 8 * (r >> 2) + 4 * hi; }
__device__ __forceinline__ s16x4 lds_tr(LAS const char* p) { return __builtin_bit_cast(s16x4, __builtin_amdgcn_ds_read_tr16_b64_v4i16((LAS s16x4*)p)); }
__device__ __forceinline__ bf16x8 cat44(s16x4 a, s16x4 b) { return (bf16x8){a[0], a[1], a[2], a[3], b[0], b[1], b[2], b[3]}; }

namespace pg8 {
#define PG8_LAS __attribute__((address_space(3)))
typedef unsigned short bf16_t;
typedef short bf16x8 __attribute__((ext_vector_type(8)));
typedef float f32x4 __attribute__((ext_vector_type(4)));
typedef unsigned u32x4 __attribute__((ext_vector_type(4)));
constexpr int BM = 256, BK = 64, HALF = 128, HTB = HALF * BK * 2  , STAGE_BYTES = 8 * HTB, NXCD = 8, WGM = 8;

__host__ __device__ __forceinline__ int lds_byte(int r, int c) { const int st = (r >> 4) * 2 + (c >> 5), rr = r & 15, cc = c & 31, ob = rr * 64 + cc * 2; return st * 1024 + (ob ^ (((ob >> 9) & 1) << 5)); }
__host__ __device__ __forceinline__ void stage_rc(int b, int& R, int& C) { const int st = b / 1024, sb = b % 1024, swz = sb ^ (((sb >> 9) & 1) << 5); R = (st >> 1) * 16 + swz / 64; C = (st & 1) * 32 + (swz % 64) / 2; }
__host__ __device__ __forceinline__ int perm32(int rho) { const int n = rho >> 4, i = rho & 15; return 8 * (i >> 2) + 4 * n + (i & 3); }

struct Unit { int pm, pn, pk; };
struct Gemm { const bf16_t* A; const bf16_t* Bt; int M, N, K, ld; };

struct StaticOrder {
    int nM, nN, nwg, G, c;
    __host__ __device__ void init(int M, int N, int G_, int c_) { nM = M / BM; nN = N / BM; nwg = nM * nN; G = G_; c = c_; }
    __host__ __device__ bool next(int i, Unit& u) const {
        const long L = (long)i * G + c; if (L >= nwg) return false;
        int wgid = (int)L; { const int q = nwg / NXCD, r = nwg % NXCD, xcd = wgid % NXCD, off = wgid / NXCD; wgid = (xcd < r ? xcd * (q + 1) : r * (q + 1) + (xcd - r) * q) + off; }
        const int nig = WGM * nN, gid = wgid / nig, fm = gid * WGM, gsz = (nM - fm) < WGM ? (nM - fm) : WGM;
        u.pm = fm + ((wgid % nig) % gsz); u.pn = (wgid % nig) / gsz; u.pk = 0; return true;
    }
    __device__ __forceinline__ void a_ready(const Unit&) const {}
    __device__ __forceinline__ void done(const Unit&) const {}
};

__device__ __forceinline__ unsigned cvt_pk_bf16(float lo, float hi) { unsigned r; asm volatile("v_cvt_pk_bf16_f32 %0, %1, %2" : "=v"(r) : "v"(lo), "v"(hi)); return r; }
typedef float f32x2 __attribute__((ext_vector_type(2)));
struct SplitOrder {
    int nN, np, G, c, pm0;
    __host__ __device__ void init(int N, int nsl, int pm0_, int G_, int c_) { nN = N / BM; np = nN * nsl; G = G_; c = c_; pm0 = pm0_; }
    __host__ __device__ bool next(int i, Unit& u) const { const long L = (long)i * G + c; if (L >= np) return false; u.pm = pm0; u.pn = (int)(L % nN); u.pk = (int)(L / nN); return true; }
    __device__ __forceinline__ void a_ready(const Unit&) const {}
    __device__ __forceinline__ void done(const Unit&) const {}
};
template <class Epi, class Sched, bool ALIGN_EPI = false, bool SP2 = false>
__device__ __forceinline__ void gemm_phase(PG8_LAS unsigned char* lds, const Gemm g, const Sched& S, const Epi& E, const int wv) {
    const int tid = opaque_tid(wv), wid = __builtin_amdgcn_readfirstlane(tid >> 6), lane = tid & 63, wr = wid >> 2, wc = wid & 3, fr = lane & 15, fq = lane >> 4;
    const int K = g.K, nt = K / BK;
    unsigned voffA[2], voffB[2];
#pragma unroll
    for (int i = 0; i < 2; ++i) { int R, C; stage_rc(tid * 16 + i * 8192, R, C); const int Rb = Epi::PERM ? ((R & ~31) + perm32(R & 31)) : R;
        voffA[i] = (unsigned)(R * g.ld + C) * 2u; voffB[i] = (unsigned)(Rb * g.ld + C) * 2u; }
    const size_t kstep = (size_t)(BK * 2);
    const size_t hstep = (size_t)HALF * g.ld * 2;
    const size_t tstep = 2 * hstep;
    const unsigned ldsw = (unsigned)wid * 1024u;
    const int aoff = lds_byte(wr * 64 + fr, fq * 8), boff = lds_byte(wc * 32 + fr, fq * 8);
#define PG8_SA(b, h) (((b) * 2 + (h)) * HTB)
#define PG8_SB(b, h) ((4 + (b) * 2 + (h)) * HTB)
#define PG8_STAGE(bufoff, gbase, voff) do { _Pragma("unroll") for (int _i = 0; _i < 2; ++_i) \
        __builtin_amdgcn_global_load_lds((const unsigned*)((const char*)(gbase) + (voff)[_i]), (PG8_LAS unsigned*)(lds + (bufoff) + ldsw + _i * 8192), 16, 0, 0); } while (0)
#define PG8_LDA(dst, b, h) do { _Pragma("unroll") for (int m = 0; m < 4; ++m) _Pragma("unroll") for (int k = 0; k < 2; ++k) dst[m][k] = *(const PG8_LAS bf16x8*)(lds + PG8_SA(b, h) + aoff + m * 2048 + k * 1024); } while (0)
#define PG8_LDB(dst, b, h) do { _Pragma("unroll") for (int n = 0; n < 2; ++n) _Pragma("unroll") for (int k = 0; k < 2; ++k) dst[n][k] = *(const PG8_LAS bf16x8*)(lds + PG8_SB(b, h) + boff + n * 2048 + k * 1024); } while (0)
#define PG8_MMA(ai, bj, At, Bt) do { __builtin_amdgcn_s_setprio(1); _Pragma("unroll") for (int m = 0; m < 4; ++m) _Pragma("unroll") for (int n = 0; n < 2; ++n) _Pragma("unroll") for (int k = 0; k < 2; ++k) \
        acc[ai][bj][m][n] = __builtin_amdgcn_mfma_f32_16x16x32_bf16(Bt[n][k], At[m][k], acc[ai][bj][m][n], 0, 0, 0); __builtin_amdgcn_s_setprio(0); } while (0)
#define PG8_WAIT_V(n) asm volatile("s_waitcnt vmcnt(" #n ")" ::: "memory")
#define PG8_WAIT_L(n) asm volatile("s_waitcnt lgkmcnt(" #n ")" ::: "memory")
#define PG8_BAR __builtin_amdgcn_s_barrier()
#define PG8_SCHED __builtin_amdgcn_sched_barrier(0)
    Unit cur, nxt; int ui = 0;
    if (!S.next(0, cur)) return;
    f32x4 acc[2][2][4][2];
#pragma unroll
    for (int a = 0; a < 2; ++a)
#pragma unroll
        for (int b = 0; b < 2; ++b)
#pragma unroll
            for (int m = 0; m < 4; ++m)
#pragma unroll
                for (int n = 0; n < 2; ++n) acc[a][b][m][n] = (f32x4){0.f, 0.f, 0.f, 0.f};
    bf16x8 At[4][2], B0[2][2], B1[2][2];
    const char* cA = (const char*)g.A + (size_t)cur.pm * tstep + (size_t)cur.pk * K * 2; const char* cB = (const char*)g.Bt + (size_t)cur.pn * tstep + (size_t)cur.pk * K * 2;
    S.a_ready(cur);
    if constexpr (SP2) {
        PG8_STAGE(PG8_SB(0, 0), cB, voffB); PG8_STAGE(PG8_SB(0, 1), cB + hstep, voffB); PG8_STAGE(PG8_SA(0, 0), cA, voffA); PG8_STAGE(PG8_SA(0, 1), cA + hstep, voffA);
        if (wr == 1) PG8_BAR;
        PG8_WAIT_V(2); PG8_BAR;
        PG8_STAGE(PG8_SB(1, 0), cB + kstep, voffB); PG8_STAGE(PG8_SA(1, 0), cA + kstep, voffA); PG8_STAGE(PG8_SB(1, 1), cB + hstep + kstep, voffB);
        PG8_WAIT_V(6); PG8_BAR;
    } else {
        PG8_STAGE(PG8_SB(0, 0), cB, voffB); PG8_STAGE(PG8_SA(0, 0), cA, voffA); PG8_STAGE(PG8_SB(0, 1), cB + hstep, voffB); PG8_STAGE(PG8_SA(0, 1), cA + hstep, voffA);
        if (wr == 1) PG8_BAR;
        PG8_WAIT_V(4); PG8_BAR;
        PG8_STAGE(PG8_SB(1, 0), cB + kstep, voffB); PG8_STAGE(PG8_SA(1, 0), cA + kstep, voffA); PG8_STAGE(PG8_SB(1, 1), cB + hstep + kstep, voffB);
        PG8_WAIT_V(6); PG8_BAR;
    }
    for (;;) {
        const bool has_next = S.next(ui + 1, nxt);
        const char* nA = has_next ? (const char*)g.A + (size_t)nxt.pm * tstep + (size_t)nxt.pk * K * 2 : cA; const char* nB = has_next ? (const char*)g.Bt + (size_t)nxt.pn * tstep + (size_t)nxt.pk * K * 2 : cB;
        for (int t = 0; t < nt; t += 2) {
            const bool last = (t == nt - 2);
            const char* a1 = cA + (size_t)(t + 1) * kstep;
            const char* a2 = last ? nA : cA + (size_t)(t + 2) * kstep; const char* b2 = last ? nB : cB + (size_t)(t + 2) * kstep;
            const char* a3 = a2 + kstep; const char* b3 = b2 + kstep;
            if (last && has_next) S.a_ready(nxt);
            if constexpr (SP2) {
            PG8_LDB(B0, 0, 0); PG8_LDB(B1, 0, 1); PG8_SCHED; PG8_LDA(At, 0, 0); PG8_STAGE(PG8_SA(1, 1), a1 + hstep, voffA);
            PG8_WAIT_V(8); PG8_WAIT_L(0); PG8_BAR; PG8_MMA(0, 0, At, B0); PG8_MMA(0, 1, At, B1); PG8_BAR; PG8_SCHED;
            PG8_LDA(At, 0, 1); PG8_STAGE(PG8_SB(0, 0), b2, voffB); PG8_STAGE(PG8_SB(0, 1), b2 + hstep, voffB); PG8_STAGE(PG8_SA(0, 0), a2, voffA);
            PG8_WAIT_V(8); PG8_WAIT_L(0); PG8_BAR; PG8_MMA(1, 0, At, B0); PG8_MMA(1, 1, At, B1); PG8_BAR; PG8_SCHED;
            PG8_LDB(B0, 1, 0); PG8_LDB(B1, 1, 1); PG8_SCHED; PG8_LDA(At, 1, 0); PG8_STAGE(PG8_SA(0, 1), a2 + hstep, voffA);
            PG8_WAIT_V(8); PG8_WAIT_L(0); PG8_BAR; PG8_MMA(0, 0, At, B0); PG8_MMA(0, 1, At, B1); PG8_BAR; PG8_SCHED;
            PG8_LDA(At, 1, 1); PG8_STAGE(PG8_SB(1, 0), b3, voffB); PG8_STAGE(PG8_SB(1, 1), b3 + hstep, voffB); PG8_STAGE(PG8_SA(1, 0), a3, voffA);
            PG8_WAIT_V(8); PG8_WAIT_L(0); PG8_BAR; PG8_MMA(1, 0, At, B0); PG8_MMA(1, 1, At, B1); PG8_BAR; PG8_SCHED;
            } else {
            PG8_LDB(B0, 0, 0); PG8_SCHED; PG8_LDA(At, 0, 0); PG8_STAGE(PG8_SA(1, 1), a1 + hstep, voffA);
            PG8_WAIT_L(8); PG8_BAR; PG8_WAIT_L(0); PG8_MMA(0, 0, At, B0); PG8_BAR; PG8_SCHED;
            PG8_LDB(B1, 0, 1); PG8_STAGE(PG8_SB(0, 0), b2, voffB);
            PG8_BAR; PG8_WAIT_L(0); PG8_MMA(0, 1, At, B1); PG8_BAR;
            PG8_LDA(At, 0, 1); PG8_STAGE(PG8_SA(0, 0), a2, voffA);
            PG8_BAR; PG8_WAIT_L(0); PG8_MMA(1, 0, At, B0); PG8_BAR; PG8_SCHED;
            PG8_STAGE(PG8_SB(0, 1), b2 + hstep, voffB);
            PG8_WAIT_V(6); PG8_BAR; PG8_MMA(1, 1, At, B1); PG8_BAR;
            PG8_LDB(B0, 1, 0); PG8_SCHED; PG8_LDA(At, 1, 0); PG8_STAGE(PG8_SA(0, 1), a2 + hstep, voffA);
            PG8_WAIT_L(8); PG8_BAR; PG8_WAIT_L(0); PG8_MMA(0, 0, At, B0); PG8_BAR; PG8_SCHED;
            PG8_LDB(B1, 1, 1); PG8_STAGE(PG8_SB(1, 0), b3, voffB);
            PG8_BAR; PG8_WAIT_L(0); PG8_MMA(0, 1, At, B1); PG8_BAR;
            PG8_LDA(At, 1, 1); PG8_STAGE(PG8_SA(1, 0), a3, voffA);
            PG8_BAR; PG8_WAIT_L(0); PG8_MMA(1, 0, At, B0); PG8_BAR; PG8_SCHED;
            PG8_STAGE(PG8_SB(1, 1), b3 + hstep, voffB);
            PG8_WAIT_V(6); PG8_BAR; PG8_MMA(1, 1, At, B1); PG8_BAR;
            }
        }
        if constexpr (ALIGN_EPI) { if (wr == 0) PG8_BAR; }
        if constexpr (!Epi::AFTER_DRAIN) { E(acc, cur, wr, wc, fr, fq); S.done(cur); }
        if (!has_next) break;
#pragma unroll
        for (int a = 0; a < 2; ++a)
#pragma unroll
            for (int b = 0; b < 2; ++b)
#pragma unroll
                for (int m = 0; m < 4; ++m)
#pragma unroll
                    for (int n = 0; n < 2; ++n) acc[a][b][m][n] = (f32x4){0.f, 0.f, 0.f, 0.f};
        cur = nxt; cA = nA; cB = nB; ++ui;
        if constexpr (ALIGN_EPI) { if (wr == 1) PG8_BAR; }
    }
    PG8_WAIT_V(0);
    if constexpr (!ALIGN_EPI) { if (wr == 0) PG8_BAR; }
    PG8_BAR;
    if constexpr (Epi::AFTER_DRAIN) { E.fused(acc, cur, wr, wc, fr, fq, lds, wid, lane); S.done(cur); }
#undef PG8_SA
#undef PG8_SB
#undef PG8_STAGE
#undef PG8_LDA
#undef PG8_LDB
#undef PG8_MMA
#undef PG8_WAIT_V
#undef PG8_WAIT_L
#undef PG8_BAR
#undef PG8_SCHED
}
}

struct EpiIn {
    static constexpr bool PERM = true, AFTER_DRAIN = false;
    bf16_t* P; float* G; float* lfT; float* lfS; const float* bg; float* kp; float* vp; float* ks; float* vs; float* lfp; float* lfs;
    __device__ __forceinline__ void operator()(const f32x4 (&acc)[2][2][4][2], const pg8::Unit& u, int wr, int wc, int fr, int fq) const {
        const int pn = u.pn, row0 = u.pm * 256 + wr * 64 + fr;
        if (pn < 24) {
            float sc = 1.f; if (pn < 2) sc = QA_SCALE; else if (pn >= 12 && pn < 16) sc = QB_SCALE;
            const int col0 = pn * 256 + wc * 32 + 8 * fq;
            const bool kv = pn >= 16; const bool isv = pn >= 20; const int fcol0 = (pn - (isv ? 20 : 16)) * 256 + wc * 32 + 8 * fq;
#pragma unroll
            for (int ai = 0; ai < 2; ++ai)
#pragma unroll
                for (int m = 0; m < 4; ++m) { const int row = row0 + ai * 128 + m * 16;
#pragma unroll
                    for (int bj = 0; bj < 2; ++bj) { const f32x4 v0 = acc[ai][bj][m][0] * sc, v1 = acc[ai][bj][m][1] * sc;
                        u32x4 w; w.x = pkbf(v0[0], v0[1]); w.y = pkbf(v0[2], v0[3]); w.z = pkbf(v1[0], v1[1]); w.w = pkbf(v1[2], v1[3]);
                        *(GAS u32x4*)(P + (size_t)row * NP + col0 + bj * 128) = w;
                        if (kv && row < MT) { float* dst = row < MP ? (isv ? vp : kp) + (size_t)row * 1024 : (isv ? vs : ks) + (size_t)(row - MP) * 1024;
                            dst += fcol0 + bj * 128; *(GAS f32x4*)dst = v0; *(GAS f32x4*)(dst + 4) = v1; } } }
        } else if (wc == 0 && fq < 2) {
#pragma unroll
            for (int ai = 0; ai < 2; ++ai)
#pragma unroll
                for (int m = 0; m < 4; ++m) { const int row = row0 + ai * 128 + m * 16;
                    if (row < MT) {
#pragma unroll
                        for (int n = 0; n < 2; ++n)
#pragma unroll
                            for (int i = 0; i < 4; ++i) { const int c = 8 * fq + 4 * n + i; float gt = acc[ai][0][m][n][i] + ((const GAS float*)bg)[c];
                                if (c >= 4) gt = log_sigmoid(gt);
                                ((GAS float*)G)[(size_t)row * 16 + c] = gt;
                                if (c >= 8) { const int h = c - 8;
                                    if (row < MP) { ((GAS float*)lfp)[(size_t)row * 8 + h] = gt; ((GAS float*)lfT)[(size_t)((row >> 12) * 8 + h) * 4096 + (row & 4095)] = gt; }
                                    else { const int rs = row - MP; ((GAS float*)lfs)[(size_t)rs * 8 + h] = gt; ((GAS float*)lfS)[((rs >> 4) * 8 + h) * 16 + (rs & 15)] = gt; } } } } }
        }
    }
};
struct EpiRes {
    static constexpr bool PERM = true, AFTER_DRAIN = false;
    const bf16_t* R; bf16_t* Z;
    __device__ __forceinline__ void operator()(const f32x4 (&acc)[2][2][4][2], const pg8::Unit& u, int wr, int wc, int fr, int fq) const {
        const int row0 = u.pm * 256 + wr * 64 + fr, col0 = u.pn * 256 + wc * 32 + 8 * fq;
#pragma unroll
        for (int ai = 0; ai < 2; ++ai)
#pragma unroll
            for (int m = 0; m < 4; ++m) { const size_t off = (size_t)(row0 + ai * 128 + m * 16) * DM + col0;
#pragma unroll
                for (int bj = 0; bj < 2; ++bj) { const u32x4 r = *(const GAS u32x4*)(R + off + bj * 128);
                    f32x4 v0 = acc[ai][bj][m][0], v1 = acc[ai][bj][m][1];
                    v0[0] += ALPHA * bflo(r.x); v0[1] += ALPHA * bfhi(r.x); v0[2] += ALPHA * bflo(r.y); v0[3] += ALPHA * bfhi(r.y);
                    v1[0] += ALPHA * bflo(r.z); v1[1] += ALPHA * bfhi(r.z); v1[2] += ALPHA * bflo(r.w); v1[3] += ALPHA * bfhi(r.w);
                    u32x4 w; w.x = pkbf(v0[0], v0[1]); w.y = pkbf(v0[2], v0[3]); w.z = pkbf(v1[0], v1[1]); w.w = pkbf(v1[2], v1[3]);
                    *(GAS u32x4*)(Z + off + bj * 128) = w; } }
    }
};
struct EpiPart {
    static constexpr bool PERM = true, AFTER_DRAIN = false;
    float* part;
    __device__ __forceinline__ void operator()(const f32x4 (&acc)[2][2][4][2], const pg8::Unit& u, int wr, int wc, int fr, int fq) const {
        const int r0 = wr * 64 + fr, col0 = u.pn * 256 + wc * 32 + 8 * fq;
#pragma unroll
        for (int m = 0; m < 4; ++m) { float* dst = part + ((size_t)u.pk * MS + r0 + m * 16) * DM + col0;
#pragma unroll
            for (int bj = 0; bj < 2; ++bj) { *(GAS f32x4*)(dst + bj * 128) = acc[0][bj][m][0]; *(GAS f32x4*)(dst + bj * 128 + 4) = acc[0][bj][m][1]; } }
    }
};
struct EpiUp {
    static constexpr bool PERM = true, AFTER_DRAIN = false;
    bf16_t* H;
    __device__ __forceinline__ void operator()(const f32x4 (&acc)[2][2][4][2], const pg8::Unit& u, int wr, int wc, int fr, int fq) const {
        const int row0 = u.pm * 256 + wr * 64 + fr, col0 = u.pn * 256 + wc * 32 + 8 * fq;
#pragma unroll
        for (int ai = 0; ai < 2; ++ai)
#pragma unroll
            for (int m = 0; m < 4; ++m) { const size_t off = (size_t)(row0 + ai * 128 + m * 16) * DFF + col0;
#pragma unroll
                for (int bj = 0; bj < 2; ++bj) { f32x4 v0 = acc[ai][bj][m][0], v1 = acc[ai][bj][m][1];
#pragma unroll
                    for (int i = 0; i < 4; ++i) { const float a = fmaxf(v0[i], 0.f), b = fmaxf(v1[i], 0.f); v0[i] = a * a; v1[i] = b * b; }
                    u32x4 w; w.x = pkbf(v0[0], v0[1]); w.y = pkbf(v0[2], v0[3]); w.z = pkbf(v1[0], v1[1]); w.w = pkbf(v1[2], v1[3]);
                    *(GAS u32x4*)(H + off + bj * 128) = w; } }
    }
};

#define LDS_WAIT() asm volatile("s_waitcnt lgkmcnt(0)" ::: "memory")
__device__ __forceinline__ float scan_sum64(float x, int lane) {
#pragma unroll
    for (int o = 1; o < 64; o <<= 1) { const float y = __shfl_up(x, o); if (lane >= o) x += y; }
    return x;
}
__device__ __forceinline__ float scan_max64(float x, int lane) {
#pragma unroll
    for (int o = 1; o < 64; o <<= 1) { const float y = __shfl_up(x, o); if (lane >= o) x = fmaxf(x, y); }
    return x;
}
__device__ __forceinline__ float wave_sum64(float v) {
#pragma unroll
    for (int o = 1; o < 64; o <<= 1) v += __shfl_xor(v, o);
    return v;
}

__device__ __forceinline__ float xsum32(float x) { auto rr = __builtin_amdgcn_permlane32_swap(__float_as_uint(x), __float_as_uint(x), false, false); return __uint_as_float(rr[0]) + __uint_as_float(rr[1]); }
__device__ __forceinline__ float xmax32(float x) { auto rr = __builtin_amdgcn_permlane32_swap(__float_as_uint(x), __float_as_uint(x), false, false); return fmaxf(__uint_as_float(rr[0]), __uint_as_float(rr[1])); }
__device__ __forceinline__ float dpp_f(float x, const int ctrl_sel) {
    const int v = __float_as_int(x); int r;
    if (ctrl_sel == 0) r = __builtin_amdgcn_update_dpp(v, v, 0xB1, 0xF, 0xF, false);
    else if (ctrl_sel == 1) r = __builtin_amdgcn_update_dpp(v, v, 0x4E, 0xF, 0xF, false);
    else r = __builtin_amdgcn_update_dpp(v, v, 0x141, 0xF, 0xF, false);
    return __int_as_float(r);
}
__device__ __forceinline__ float bperm_f(int srclane, float x) { return __int_as_float(__builtin_amdgcn_ds_bpermute(srclane << 2, __float_as_int(x))); }
__device__ __forceinline__ float scan_sum64l(float x, int lane) {
#pragma unroll
    for (int o = 1; o < 64; o <<= 1) { const float y = bperm_f(lane - o, x); if (lane >= o) x += y; }
    return x;
}
__device__ __forceinline__ float scan_max64l(float x, int lane) {
#pragma unroll
    for (int o = 1; o < 64; o <<= 1) { const float y = bperm_f(lane - o, x); if (lane >= o) x = fmaxf(x, y); }
    return x;
}
__device__ __forceinline__ f32x16 mfma32(bf16x8 a, bf16x8 b, f32x16 c) { return __builtin_amdgcn_mfma_f32_32x32x16_bf16(a, b, c, 0, 0, 0); }
__device__ __forceinline__ f32x4 mfma16(bf16x8 a, bf16x8 b, f32x4 c) { return __builtin_amdgcn_mfma_f32_16x16x32_bf16(a, b, c, 0, 0, 0); }
__device__ __forceinline__ float fexp2(float x) { return __builtin_amdgcn_exp2f(x); }

struct Args { const float* in[18]; float* out; unsigned char* ws; int ph_lo, ph_hi; };
struct TItem { const float* W; bf16_t* WT; int Nsrc, K, nblk, r; bool inmap; };
__device__ __forceinline__ TItem ti_decode(const Args& a, int layer, int it) {
    unsigned char* ws = as_global(a.ws);
    constexpr int I_IN = 32 * 200, I_OUT = 32 * 64, I_UP = 32 * 256;
    TItem t; int r = it;
    if (r < I_IN) { t.W = as_global(a.in[8]) + (size_t)layer * DM * NINSRC; t.WT = (bf16_t*)(ws + WS_WIN); t.Nsrc = NINSRC; t.K = DM; t.nblk = 200; t.r = r; t.inmap = true; return t; } r -= I_IN;
    if (r < I_OUT) { t.W = as_global(a.in[11]) + (size_t)layer * DM * DM; t.WT = (bf16_t*)(ws + (layer ? WS_WOUT2 : WS_WOUT)); t.Nsrc = DM; t.K = DM; t.nblk = 64; t.r = r; t.inmap = false; return t; } r -= I_OUT;
    if (r < I_UP) { t.W = as_global(a.in[14]) + (size_t)layer * DM * DFF; t.WT = (bf16_t*)(ws + (layer ? WS_WUP2 : WS_WUP)); t.Nsrc = DFF; t.K = DM; t.nblk = 256; t.r = r; t.inmap = false; return t; } r -= I_UP;
    t.W = as_global(a.in[15]) + (size_t)layer * DFF * DM; t.WT = (bf16_t*)(ws + WS_WDN); t.Nsrc = DM; t.K = DFF; t.nblk = 64; t.r = r; t.inmap = false; return t;
}
__device__ __forceinline__ int ti_srccol(const TItem& t, int lane) { const int nd = 32 * (t.r % t.nblk) + (lane & 31);
    return t.inmap ? (nd < 3072 ? nd : (nd < 6144 ? nd + 8 : (nd < 6152 ? nd - 3072 : (nd < 6160 ? nd : -1)))) : nd; }
__device__ __forceinline__ void ti_load(const TItem& t, int lane, float (&v)[32]) {
    const int k0 = 64 * (t.r / t.nblk), sc = ti_srccol(t, lane);
    const GAS float* wp = (const GAS float*)t.W + (size_t)(k0 + (lane >> 5)) * t.Nsrc + (sc >= 0 ? sc : 0);
#pragma unroll
    for (int i = 0; i < 32; ++i) v[i] = wp[(size_t)(2 * i) * t.Nsrc];
}
__device__ __forceinline__ void ti_finish(const TItem& t, int lane, LAS float* scr, const float (&v)[32]) {
    const int k0 = 64 * (t.r / t.nblk), n0 = 32 * (t.r % t.nblk), sc = ti_srccol(t, lane);
#pragma unroll
    for (int i = 0; i < 32; ++i) scr[(2 * i + (lane >> 5)) * 33 + (lane & 31)] = sc >= 0 ? v[i] : 0.f;
    LDS_WAIT();
    const int c = lane & 7;
#pragma unroll
    for (int j = 0; j < 4; ++j) { const int n = (lane >> 3) + 8 * j; const LAS float* s = scr + (8 * c) * 33 + n;
        u32x4 o; o.x = pkbf(s[0 * 33], s[1 * 33]); o.y = pkbf(s[2 * 33], s[3 * 33]); o.z = pkbf(s[4 * 33], s[5 * 33]); o.w = pkbf(s[6 * 33], s[7 * 33]);
        *(GAS u32x4*)(t.WT + (size_t)(n0 + n) * t.K + k0 + 8 * c) = o; }
    LDS_WAIT();
}
__device__ __forceinline__ void convert_weights(const Args& a, int layer, LAS float* scr, int gw, int NGW, int lane, int it_end = 1 << 30) {
    constexpr int I_ALL = 32 * 200 + 32 * 64 + 32 * 256 + 128 * 64;
    const int it_stop = it_end < I_ALL ? it_end : I_ALL;
    if (gw >= it_stop) return;
    float va[32], vb[32];
    TItem cur = ti_decode(a, layer, gw); ti_load(cur, lane, va);
    for (int it = gw; it < it_stop; it += NGW) {
        const bool more = it + NGW < it_stop; TItem nxt = cur;
        if (more) { nxt = ti_decode(a, layer, it + NGW); ti_load(nxt, lane, vb); }
        ti_finish(cur, lane, scr, va);
        if (more) {
#pragma unroll
            for (int i = 0; i < 32; ++i) va[i] = vb[i]; }
        cur = nxt;
    }
}
__device__ __forceinline__ void convert_x(const Args& a, int gw, int NGW, int lane) {
    bf16_t* XB = (bf16_t*)(as_global(a.ws) + WS_XB);
    f32x4 xr[8];
#define CX_LOAD(row_) do { const GAS f32x4* x_ = (const GAS f32x4*)((row_) < MP ? as_global(a.in[0]) + (size_t)(row_) * DM : as_global(a.in[1]) + (size_t)((row_) - MP) * DM) + lane; _Pragma("unroll") for (int j = 0; j < 8; ++j) xr[j] = x_[64 * j]; } while (0)
    if (gw < MT) CX_LOAD(gw);
    for (int row = gw; row < MPAD; row += NGW) {
        GAS u32x2* o = (GAS u32x2*)(XB + (size_t)row * DM) + lane;
        if (row < MT) { u32x2 w[8];
#pragma unroll
            for (int j = 0; j < 8; ++j) { w[j].x = pkbf(xr[j][0], xr[j][1]); w[j].y = pkbf(xr[j][2], xr[j][3]); }
            if (row + NGW < MT) CX_LOAD(row + NGW);
#pragma unroll
            for (int j = 0; j < 8; ++j) o[64 * j] = w[j]; }
        else {
#pragma unroll
            for (int j = 0; j < 8; ++j) o[64 * j] = (u32x2){0u, 0u}; }
    }
#undef CX_LOAD
}
__device__ __forceinline__ void ln_phase(const bf16_t* Z, const bf16_t* RES, const float* part, int nsl, const float* g, const float* b, bf16_t* XB, float* outp, float* outs, int gw, int NGW, int lane) {
    f32x4 gv[8], bv[8];
#pragma unroll
    for (int j = 0; j < 8; ++j) { gv[j] = ((const GAS f32x4*)g)[lane + 64 * j]; bv[j] = ((const GAS f32x4*)b)[lane + 64 * j]; }
    u32x2 zr[8];
#define LN_LOAD(row_) do { const GAS u32x2* z_ = (const GAS u32x2*)(((row_) < MP ? Z : RES) + (size_t)(row_) * DM) + lane; _Pragma("unroll") for (int j = 0; j < 8; ++j) zr[j] = z_[64 * j]; } while (0)
    if (gw < MT) LN_LOAD(gw);
    for (int row = gw; row < MT; row += NGW) {
        f32x4 v[8]; float s = 0.f;
        const float sc = row < MP ? 1.0f : ALPHA;
#pragma unroll
        for (int j = 0; j < 8; ++j) v[j] = (f32x4){sc * bflo(zr[j].x), sc * bfhi(zr[j].x), sc * bflo(zr[j].y), sc * bfhi(zr[j].y)};
        if (row + NGW < MT) LN_LOAD(row + NGW);
        if (row >= MP) {
            for (int sl = 0; sl < nsl; ++sl) { const GAS f32x4* p = (const GAS f32x4*)(part + ((size_t)sl * MS + (row - MP)) * DM) + lane;
#pragma unroll
                for (int j = 0; j < 8; ++j) v[j] += p[64 * j]; } }
#pragma unroll
        for (int j = 0; j < 8; ++j) s += (v[j][0] + v[j][1]) + (v[j][2] + v[j][3]);
        const float mean = wave_sum64(s) * (1.f / DM); float s2 = 0.f;
#pragma unroll
        for (int j = 0; j < 8; ++j) { v[j] = v[j] - mean; s2 += (v[j][0] * v[j][0] + v[j][1] * v[j][1]) + (v[j][2] * v[j][2] + v[j][3] * v[j][3]); }
        const float rstd = 1.0f / sqrtf(wave_sum64(s2) * (1.f / DM) + LN_EPS);
#pragma unroll
        for (int j = 0; j < 8; ++j) v[j] = v[j] * rstd * gv[j] + bv[j];
        if (XB) { GAS u32x2* o = (GAS u32x2*)(XB + (size_t)row * DM) + lane;
#pragma unroll
            for (int j = 0; j < 8; ++j) { u32x2 w; w.x = pkbf(v[j][0], v[j][1]); w.y = pkbf(v[j][2], v[j][3]); o[64 * j] = w; } }
        if (outp) { GAS f32x4* o = (GAS f32x4*)(row < MP ? outp + (size_t)row * DM : outs + (size_t)(row - MP) * DM) + lane;
#pragma unroll
            for (int j = 0; j < 8; ++j) o[64 * j] = v[j]; }
    }
#undef LN_LOAD
}

constexpr int AT_K = 0, AT_V = 34816, AT_NF = 75776, AT_SCR = 92160, AVP = 320;
__device__ __forceinline__ void fox_prompt_unit(LAS char* L, const bf16_t* P, const float* lfT, bf16_t* MIX, int b, int h, int qb, const int wv) {
    const int tid = opaque_tid(wv), lane = tid & 63, wid = __builtin_amdgcn_readfirstlane(tid >> 6), r32 = lane & 31, hi = lane >> 5, i16 = lane & 15, cb = (lane >> 4) & 1;
    const int qend = 256 * (qb + 1), NT = 4 * (qb + 1);
    const size_t rowb = (size_t)b * SEQ;
    LAS float* nfk = (LAS float*)(L + AT_NF); LAS float* scr = (LAS float*)(L + AT_SCR);
    {
        float v[8]; const bool act = 8 * tid < qend;
        if (act) { const GAS f32x4* src = (const GAS f32x4*)(lfT + (size_t)(b * 8 + h) * 4096 + 8 * tid); const f32x4 a = src[0], c = src[1];
            v[0] = a[0]; v[1] = a[1]; v[2] = a[2]; v[3] = a[3]; v[4] = c[0]; v[5] = c[1]; v[6] = c[2]; v[7] = c[3]; }
        else {
#pragma unroll
            for (int i = 0; i < 8; ++i) v[i] = 0.f; }
#pragma unroll
        for (int i = 1; i < 8; ++i) v[i] += v[i - 1];
        const float tot = v[7]; const float x = scan_sum64(tot, lane);
        if (lane == 63) scr[wid] = x;
        __syncthreads();
        float off = 0.f;
        for (int w = 0; w < wid; ++w) off += scr[w];
        const float base = off + x - tot;
        if (act) {
#pragma unroll
            for (int i = 0; i < 8; ++i) nfk[8 * tid + i] = -(base + v[i]) * LOG2E; }
    }
    const bf16_t* Kg = P + rowb * NP + PC_KB + h * 128; const bf16_t* Vg = P + rowb * NP + PC_VB + h * 128;
    u32x4 kr[2], vr[2];
#define AT_LOAD(t) do { _Pragma("unroll") for (int i_ = 0; i_ < 2; ++i_) { const int c_ = tid + 512 * i_, row_ = c_ >> 4, ch_ = c_ & 15; \
        kr[i_] = *(const GAS u32x4*)(Kg + (size_t)(64 * (t) + row_) * NP + ch_ * 8); vr[i_] = *(const GAS u32x4*)(Vg + (size_t)(64 * (t) + row_) * NP + ch_ * 8); } } while (0)
#define AT_STORE(buf) do { _Pragma("unroll") for (int i_ = 0; i_ < 2; ++i_) { const int c_ = tid + 512 * i_, row_ = c_ >> 4, ch_ = c_ & 15; \
        *(LAS u32x4*)(L + AT_K + (buf) * 17408 + row_ * 272 + ch_ * 16) = kr[i_]; *(LAS u32x4*)(L + AT_V + (buf) * 20480 + row_ * AVP + ch_ * 16) = vr[i_]; } } while (0)
    bf16x8 qf[8];
    { const bf16_t* Qg = P + (rowb + 256 * qb + 32 * wid + r32) * NP + PC_QB + h * 128 + 8 * hi;
#pragma unroll
        for (int kk = 0; kk < 8; ++kk) qf[kk] = *(const GAS bf16x8*)(Qg + 16 * kk); }
    f32x16 o[4];
#pragma unroll
    for (int d = 0; d < 4; ++d)
#pragma unroll
        for (int r = 0; r < 16; ++r) o[d][r] = 0.f;
    float m = -INFINITY, l = 0.f;
    AT_LOAD(0); AT_STORE(0);
    __syncthreads();
    for (int t = 0; t < NT; ++t) {
        if (t + 1 < NT) AT_LOAD(t + 1);
        const int jb = t - (NT - 4);
        if (!(jb >= 0 && 64 * jb > 32 * wid + 31)) {
            LAS const char* Kb = L + AT_K + (t & 1) * 17408; LAS const char* Vb = L + AT_V + (t & 1) * 20480;
            LAS const float* nf = nfk + 64 * t;
            f32x16 s0, s1;
#pragma unroll
            for (int g = 0; g < 4; ++g) { const f32x4 a = *(LAS const f32x4*)(nf + 8 * g + 4 * hi), c = *(LAS const f32x4*)(nf + 32 + 8 * g + 4 * hi);
                s0[4 * g] = a[0]; s0[4 * g + 1] = a[1]; s0[4 * g + 2] = a[2]; s0[4 * g + 3] = a[3]; s1[4 * g] = c[0]; s1[4 * g + 1] = c[1]; s1[4 * g + 2] = c[2]; s1[4 * g + 3] = c[3]; }
            {
                bf16x8 ka[16];
#pragma unroll
                for (int kk = 0; kk < 8; ++kk) { ka[2 * kk] = *(LAS const bf16x8*)(Kb + r32 * 272 + kk * 32 + hi * 16); ka[2 * kk + 1] = *(LAS const bf16x8*)(Kb + (32 + r32) * 272 + kk * 32 + hi * 16); }
                __builtin_amdgcn_sched_barrier(0);
#pragma unroll
                for (int kk = 0; kk < 8; ++kk) { s0 = mfma32(ka[2 * kk], qf[kk], s0); s1 = mfma32(ka[2 * kk + 1], qf[kk], s1); }
                __builtin_amdgcn_sched_barrier(0);
            }
            if (jb >= 0 && 64 * jb + 63 > 32 * wid) { const int q = 32 * wid + r32;
#pragma unroll
                for (int r = 0; r < 16; ++r) { const int kv = 64 * jb + crow(r, hi); if (kv > q) s0[r] = -INFINITY; if (kv + 32 > q) s1[r] = -INFINITY; } }
            float mx = fmaxf(s0[0], s1[0]);
#pragma unroll
            for (int r = 1; r < 16; ++r) mx = fmaxf(mx, fmaxf(s0[r], s1[r]));
            mx = xmax32(mx);
            const float mn = fmaxf(m, mx), alpha = fexp2(m - mn); m = mn;
            float ls = 0.f;
#pragma unroll
            for (int r = 0; r < 16; ++r) { s0[r] = fexp2(s0[r] - mn); s1[r] = fexp2(s1[r] - mn); ls += s0[r] + s1[r]; }
            l = l * alpha + ls;
#pragma unroll
            for (int d = 0; d < 4; ++d)
#pragma unroll
                for (int r = 0; r < 16; ++r) o[d][r] *= alpha;
            bf16x8 pf[4];
            { u32x4 w;
              w.x = pkbf(s0[0], s0[1]); w.y = pkbf(s0[2], s0[3]); w.z = pkbf(s0[4], s0[5]); w.w = pkbf(s0[6], s0[7]); pf[0] = __builtin_bit_cast(bf16x8, w);
              w.x = pkbf(s0[8], s0[9]); w.y = pkbf(s0[10], s0[11]); w.z = pkbf(s0[12], s0[13]); w.w = pkbf(s0[14], s0[15]); pf[1] = __builtin_bit_cast(bf16x8, w);
              w.x = pkbf(s1[0], s1[1]); w.y = pkbf(s1[2], s1[3]); w.z = pkbf(s1[4], s1[5]); w.w = pkbf(s1[6], s1[7]); pf[2] = __builtin_bit_cast(bf16x8, w);
              w.x = pkbf(s1[8], s1[9]); w.y = pkbf(s1[10], s1[11]); w.z = pkbf(s1[12], s1[13]); w.w = pkbf(s1[14], s1[15]); pf[3] = __builtin_bit_cast(bf16x8, w); }
#pragma unroll
            for (int ss = 0; ss < 4; ++ss)
#pragma unroll
                for (int d = 0; d < 4; ++d) { LAS const char* vp = Vb + (16 * ss + 4 * hi + (i16 >> 2)) * AVP + (32 * d + 16 * cb + 4 * (i16 & 3)) * 2;
                    o[d] = mfma32(cat44(lds_tr(vp), lds_tr(vp + 8 * AVP)), pf[ss], o[d]); }
        }
        if (t + 1 < NT) AT_STORE((t + 1) & 1);
        __syncthreads();
    }
    l = xsum32(l);
    const float inv = 1.0f / l;
    bf16_t* Og = MIX + (rowb + 256 * qb + 32 * wid + r32) * DM + 1024 + h * 128 + 4 * hi;
#pragma unroll
    for (int d = 0; d < 4; ++d)
#pragma unroll
        for (int g = 0; g < 4; ++g) { u32x2 w; w.x = pkbf(o[d][4 * g] * inv, o[d][4 * g + 1] * inv); w.y = pkbf(o[d][4 * g + 2] * inv, o[d][4 * g + 3] * inv);
            *(GAS u32x2*)(Og + 32 * d + 8 * g) = w; }
#undef AT_LOAD
#undef AT_STORE
}

constexpr int FS_Q = 0, FS_NF = 8448, FS_SC = 12672, FS_TL = 80512, FS_LI = 97408, FS_SCP = 1060;
__device__ __forceinline__ void fox_sample_item(LAS char* L, const bf16_t* P, const float* lfS, const float* ck, const float* cv, const float* clf, bf16_t* MIX, int sb, int h, const int wv) {
    const int tid = opaque_tid(wv), lane = tid & 63, wid = __builtin_amdgcn_readfirstlane(tid >> 6);
    LAS float* QF = (LAS float*)(L + FS_Q); LAS float* NF = (LAS float*)(L + FS_NF); LAS float* SC = (LAS float*)(L + FS_SC); LAS float* TL = (LAS float*)(L + FS_TL); LAS float* LI = (LAS float*)(L + FS_LI);
    const size_t srow = (size_t)MP + sb * 16;
    for (int e = tid; e < 16 * 128; e += 512) { const int q = e >> 7, d = e & 127; QF[q * 132 + d] = bf2f(((const GAS bf16_t*)P)[(srow + q) * NP + PC_QB + h * 128 + d]); }
    if (wid == 0) {
        float v[17];
#pragma unroll
        for (int i = 0; i < 17; ++i) { const int idx = 17 * lane + i; float x = 0.f;
            if (idx < PAST) x = ((const GAS float*)clf)[((size_t)sb * PAST + idx) * 8 + h]; else if (idx < PAST + 16) x = ((const GAS float*)lfS)[(sb * 8 + h) * 16 + idx - PAST];
            v[i] = x; }
#pragma unroll
        for (int i = 1; i < 17; ++i) v[i] += v[i - 1];
        const float tot = v[16], x = scan_sum64(tot, lane), base = x - tot;
#pragma unroll
        for (int i = 0; i < 17; ++i) { const int idx = 17 * lane + i; if (idx < 1056) NF[idx] = -(base + v[i]) * LOG2E; }
    }
    f32x4 ta[2], tb2[2], tc[2];
#define FS_LOAD(R, src, pcol, tile) do { _Pragma("unroll") for (int i_ = 0; i_ < 2; ++i_) { const int c_ = tid + 512 * i_, row_ = c_ >> 5, ch_ = c_ & 31, kv_ = 32 * (tile) + row_; \
        if (kv_ < PAST) R[i_] = *(const GAS f32x4*)((src) + (((size_t)sb * PAST + kv_) * 8 + h) * 128 + 4 * ch_); \
        else if (kv_ < PAST + 16) { const u32x2 w_ = *(const GAS u32x2*)(P + (srow + kv_ - PAST) * NP + (pcol) + h * 128 + 4 * ch_); R[i_] = (f32x4){bflo(w_.x), bfhi(w_.x), bflo(w_.y), bfhi(w_.y)}; } \
        else R[i_] = (f32x4){0.f, 0.f, 0.f, 0.f}; } } while (0)
#define FS_STORE(R) do { _Pragma("unroll") for (int i_ = 0; i_ < 2; ++i_) { const int c_ = tid + 512 * i_, row_ = c_ >> 5, ch_ = c_ & 31; *(LAS f32x4*)(TL + row_ * 132 + 4 * ch_) = R[i_]; } } while (0)
    FS_LOAD(ta, ck, PC_KB, 0); FS_LOAD(tb2, ck, PC_KB, 1); FS_LOAD(tc, ck, PC_KB, 2);
    __syncthreads();
    {
        const int q = tid & 15, kl = tid >> 4;
#define FS_SC_STEP(R, tile_) do { const int tile = (tile_); FS_STORE(R); __syncthreads(); if (tile + 3 < 33) FS_LOAD(R, ck, PC_KB, tile + 3); \
            float acc = 0.f; \
            _Pragma("unroll 8") for (int i = 0; i < 32; ++i) { const f32x4 a = *(LAS const f32x4*)(QF + q * 132 + 4 * i), k = *(LAS const f32x4*)(TL + kl * 132 + 4 * i); acc += a[0] * k[0] + a[1] * k[1] + a[2] * k[2] + a[3] * k[3]; } \
            const int kv = 32 * tile + kl; float s = acc + NF[kv]; \
            if (kv >= PAST + 16 || (kv >= PAST && kv - PAST > q)) s = -INFINITY; \
            SC[q * FS_SCP + kv] = s; __syncthreads(); } while (0)
        for (int t3 = 0; t3 < 33; t3 += 3) { FS_SC_STEP(ta, t3); FS_SC_STEP(tb2, t3 + 1); FS_SC_STEP(tc, t3 + 2); }
#undef FS_SC_STEP
    }
    FS_LOAD(ta, cv, PC_VB, 0); FS_LOAD(tb2, cv, PC_VB, 1); FS_LOAD(tc, cv, PC_VB, 2);
    {
#pragma unroll
        for (int qq = 0; qq < 2; ++qq) { const int q = 2 * wid + qq; float mx = -INFINITY;
            for (int kv = lane; kv < 1056; kv += 64) mx = fmaxf(mx, SC[q * FS_SCP + kv]);
#pragma unroll
            for (int o = 1; o < 64; o <<= 1) mx = fmaxf(mx, __shfl_xor(mx, o));
            float sm = 0.f;
            for (int kv = lane; kv < 1056; kv += 64) { const float p = fexp2(SC[q * FS_SCP + kv] - mx); SC[q * FS_SCP + kv] = p; sm += p; }
            sm = wave_sum64(sm);
            if (lane == 0) LI[q] = 1.0f / sm; }
    }
    __syncthreads();
    {
        const int d = tid & 127, qg = tid >> 7; float o0 = 0.f, o1 = 0.f, o2 = 0.f, o3 = 0.f;
#define FS_PV_STEP(R, tile_) do { const int tile = (tile_); FS_STORE(R); __syncthreads(); if (tile + 3 < 33) FS_LOAD(R, cv, PC_VB, tile + 3); \
            _Pragma("unroll 8") for (int kl = 0; kl < 32; ++kl) { const float v = TL[kl * 132 + d]; const int kv = 32 * tile + kl; LAS const float* sp = SC + (4 * qg) * FS_SCP + kv; \
                o0 += sp[0] * v; o1 += sp[FS_SCP] * v; o2 += sp[2 * FS_SCP] * v; o3 += sp[3 * FS_SCP] * v; } \
            __syncthreads(); } while (0)
        for (int t3 = 0; t3 < 33; t3 += 3) { FS_PV_STEP(ta, t3); FS_PV_STEP(tb2, t3 + 1); FS_PV_STEP(tc, t3 + 2); }
#undef FS_PV_STEP
        GAS bf16_t* Og = (GAS bf16_t*)MIX + (srow + 4 * qg) * DM + 1024 + h * 128 + d;
        Og[0] = (bf16_t)(pkbf(o0 * LI[4 * qg], 0.f) & 0xffffu); Og[DM] = (bf16_t)(pkbf(o1 * LI[4 * qg + 1], 0.f) & 0xffffu);
        Og[2 * DM] = (bf16_t)(pkbf(o2 * LI[4 * qg + 2], 0.f) & 0xffffu); Og[3 * DM] = (bf16_t)(pkbf(o3 * LI[4 * qg + 3], 0.f) & 0xffffu);
    }
#undef FS_LOAD
#undef FS_STORE
}

constexpr int ML_Q = 0, ML_K = 17408, ML_KT = 34816, ML_V = 55296, ML_S = 92160, ML_FA = 101376, ML_N = 102656, ML_SSQ = 103168, ML_GH = 105216, ML_GP = 106240, ML_NP = 139008, ML_RS = 143104;
constexpr int KTP = 320, VP = 576;
__device__ __forceinline__ void mlstm_item(LAS char* L, const bf16_t* P, const float* G, bf16_t* MIX, const float* ghead, size_t row0, int hh, int nch, int Lv,
                                           const float* c0, const float* n0, const float* m0, float* cout, float* nout, float* mout, const int wv) {
    const int tid = opaque_tid(wv), lane = tid & 63, wid = __builtin_amdgcn_readfirstlane(tid >> 6), r32 = lane & 31, hi = lane >> 5, i16 = lane & 15, cb = (lane >> 4) & 1;
    LAS float* FA = (LAS float*)(L + ML_FA); LAS float* ROWT = FA, *COLS = FA + 64, *WINT = FA + 128, *EMT = FA + 192, *NQ = FA + 256;
    LAS float* NST = (LAS float*)(L + ML_N); LAS float* SSQ = (LAS float*)(L + ML_SSQ); LAS float* RS = (LAS float*)(L + ML_RS);
    f32x16 cT[4];
#pragma unroll
    for (int kb = 0; kb < 4; ++kb)
#pragma unroll
        for (int r = 0; r < 16; ++r) cT[kb][r] = c0 ? ((const GAS float*)c0)[(size_t)(32 * wid + r32) * 128 + 32 * kb + crow(r, hi)] : 0.f;
    if (tid < 128) NST[tid] = n0 ? ((const GAS float*)n0)[tid] : 0.f;
    float m = m0 ? ((const GAS float*)m0)[0] : 0.f;
    LAS float* GH = (LAS float*)(L + ML_GH);
    if (tid < 256) GH[tid] = ((const GAS float*)ghead)[hh * 256 + tid];
    u32x4 qr[2], kr[2], vr[4]; float igr;
#define ML_LOADQK(j) do { const size_t rb_ = row0 + 64 * (size_t)(j); \
        _Pragma("unroll") for (int i_ = 0; i_ < 2; ++i_) { const int c_ = tl_ + 512 * i_, row_ = c_ >> 4, ch_ = c_ & 15; \
            if (row_ < Lv) { qr[i_] = *(const GAS u32x4*)(P + (rb_ + row_) * NP + PC_QA + hh * 128 + ch_ * 8); kr[i_] = *(const GAS u32x4*)(P + (rb_ + row_) * NP + PC_KA + hh * 128 + ch_ * 8); } \
            else { qr[i_] = (u32x4){0u, 0u, 0u, 0u}; kr[i_] = (u32x4){0u, 0u, 0u, 0u}; } } \
        if ((tl_ & 63) < Lv) { igr = ((const GAS float*)G)[(rb_ + (tl_ & 63)) * 16 + hh]; } else { igr = -INFINITY; } } while (0)
#define ML_LOADV(j) do { const size_t rb_ = row0 + 64 * (size_t)(j); \
        _Pragma("unroll") for (int i_ = 0; i_ < 4; ++i_) { const int c_ = tl_ + 512 * i_, row_ = c_ >> 5, ch_ = c_ & 31; \
            if (row_ < Lv) vr[i_] = *(const GAS u32x4*)(P + (rb_ + row_) * NP + PC_VA + hh * 256 + ch_ * 8); else vr[i_] = (u32x4){0u, 0u, 0u, 0u}; } } while (0)
    { int tl_ = tid; ML_LOADQK(0); ML_LOADV(0); }
    LAS float* BCS = (LAS float*)(L + ML_GP); LAS float* PMX = BCS + 4096; LAS float* NPART = (LAS float*)(L + ML_NP);
    for (int jj = wid; jj < nch; jj += 8) {
        float ig0 = -INFINITY, lf0 = 0.f;
        if (lane < Lv) { ig0 = ((const GAS float*)G)[(row0 + 64 * (size_t)jj + lane) * 16 + hh]; lf0 = ((const GAS float*)G)[(row0 + 64 * (size_t)jj + lane) * 16 + 4 + hh]; }
        const float bc = scan_sum64l(lf0, lane), pmx = scan_max64l(ig0 - bc, lane);
        BCS[jj * 64 + lane] = bc; PMX[jj * 64 + lane] = pmx;
    }
    __syncthreads();
    for (int j = 0; j < nch; ++j) {
        int tl_ = tid; asm volatile("" : "+v"(tl_));
        const int r32j = tl_ & 31, hij = (tl_ >> 5) & 1;
        const int lj = tl_ & 63;
        const float bcs = BCS[j * 64 + lj], pm = PMX[j * 64 + lj], u = igr - bcs;
        const float mt = bcs + fmaxf(m, pm);
        const float b63 = __int_as_float(__builtin_amdgcn_readlane(__float_as_int(bcs), 63)), mnew = __int_as_float(__builtin_amdgcn_readlane(__float_as_int(mt), 63));
        const float av = __expf(b63 + u - mnew), decay = __expf(b63 + m - mnew);
        if (wid == 0) { ROWT[lane] = bcs - mt; COLS[lane] = u; WINT[lane] = __expf(bcs + m - mt); EMT[lane] = __expf(-mt); }
        m = mnew;
#pragma unroll
        for (int i = 0; i < 2; ++i) { const int c = tid + 512 * i, row = c >> 4, ch = c & 15;
            *(LAS u32x4*)(L + ML_Q + row * 272 + ch * 16) = qr[i]; *(LAS u32x4*)(L + ML_K + row * 272 + ch * 16) = kr[i];
            const float as = bperm_f(row, av); u32x4 w;
            w.x = pkbf(bflo(kr[i].x) * as, bfhi(kr[i].x) * as); w.y = pkbf(bflo(kr[i].y) * as, bfhi(kr[i].y) * as);
            w.z = pkbf(bflo(kr[i].z) * as, bfhi(kr[i].z) * as); w.w = pkbf(bflo(kr[i].w) * as, bfhi(kr[i].w) * as);
            *(LAS u32x4*)(L + ML_KT + row * KTP + ch * 16) = w; }
        __syncthreads();
        const size_t rb = row0 + 64 * (size_t)j;
        if (j + 1 < nch) ML_LOADQK(j + 1);
        u32x2 og[2][4];
#pragma unroll
        for (int tb = 0; tb < 2; ++tb)
#pragma unroll
            for (int g = 0; g < 4; ++g) og[tb][g] = *(const GAS u32x2*)(P + (rb + 32 * tb + r32j) * NP + PC_OA + hh * 256 + 32 * wid + 8 * g + 4 * hij);
        {
            const int fr = lane & 15, fq = lane >> 4;
#pragma unroll
            for (int bi = 0; bi < 2; ++bi) { const int id = 2 * wid + bi, sb = id >> 2, tb = id & 3; const int t = 16 * tb + fr, s0 = 16 * sb + 4 * fq;
                u32x2 ow = (u32x2){0u, 0u};
                if (sb <= tb) { f32x4 acc = (f32x4){0.f, 0.f, 0.f, 0.f}; bf16x8 a4[4], q4[4];
#pragma unroll
                    for (int kk = 0; kk < 4; ++kk) { a4[kk] = *(LAS const bf16x8*)(L + ML_K + (16 * sb + fr) * 272 + kk * 64 + fq * 16); q4[kk] = *(LAS const bf16x8*)(L + ML_Q + (16 * tb + fr) * 272 + kk * 64 + fq * 16); }
                    __builtin_amdgcn_sched_barrier(0);
#pragma unroll
                    for (int kk = 0; kk < 4; ++kk) acc = mfma16(a4[kk], q4[kk], acc);
                    const float rt = ROWT[t]; const f32x4 cs = *(LAS const f32x4*)(COLS + s0); float v[4];
#pragma unroll
                    for (int i = 0; i < 4; ++i) v[i] = (s0 + i <= t) ? acc[i] * __expf(rt + cs[i]) : 0.f;
                    ow.x = pkbf(v[0], v[1]); ow.y = pkbf(v[2], v[3]); }
                *(LAS u32x2*)(L + ML_S + t * 144 + s0 * 2) = ow;
                float ps = (bflo(ow.x) + bfhi(ow.x)) + (bflo(ow.y) + bfhi(ow.y));
                { auto r1 = __builtin_amdgcn_permlane16_swap(__float_as_uint(ps), __float_as_uint(ps), false, false); ps = __uint_as_float(r1[0]) + __uint_as_float(r1[1]); }
                ps = xsum32(ps);
                if (fq == 0) RS[sb * 64 + t] = ps; }
            const int t = 8 * wid + (lane >> 3), kp = lane & 7;
            const u32x4 q0 = *(LAS const u32x4*)(L + ML_Q + t * 272 + kp * 32), q1 = *(LAS const u32x4*)(L + ML_Q + t * 272 + kp * 32 + 16);
            const f32x4 n0v = *(LAS const f32x4*)(NST + 16 * kp), n1v = *(LAS const f32x4*)(NST + 16 * kp + 4), n2v = *(LAS const f32x4*)(NST + 16 * kp + 8), n3v = *(LAS const f32x4*)(NST + 16 * kp + 12);
            float d = bflo(q0.x) * n0v[0] + bfhi(q0.x) * n0v[1] + bflo(q0.y) * n0v[2] + bfhi(q0.y) * n0v[3] + bflo(q0.z) * n1v[0] + bfhi(q0.z) * n1v[1] + bflo(q0.w) * n1v[2] + bfhi(q0.w) * n1v[3]
                    + bflo(q1.x) * n2v[0] + bfhi(q1.x) * n2v[1] + bflo(q1.y) * n2v[2] + bfhi(q1.y) * n2v[3] + bflo(q1.z) * n3v[0] + bfhi(q1.z) * n3v[1] + bflo(q1.w) * n3v[2] + bfhi(q1.w) * n3v[3];
            d += dpp_f(d, 0); d += dpp_f(d, 1); d += dpp_f(d, 2);
            if (kp == 0) NQ[t] = d;
        }
#pragma unroll
        for (int i = 0; i < 4; ++i) { const int c = tid + 512 * i, row = c >> 5, ch = c & 31; *(LAS u32x4*)(L + ML_V + row * VP + ch * 16) = vr[i]; }
        __syncthreads();
        bf16x8 vf[4];
#pragma unroll
        for (int ss = 0; ss < 4; ++ss) { LAS const char* vp = L + ML_V + (16 * ss + 8 * hi + (i16 >> 2)) * VP + (32 * wid + 16 * cb + 4 * (i16 & 3)) * 2; vf[ss] = cat44(lds_tr(vp), lds_tr(vp + 4 * VP)); }
        f32x16 oa[2];
#pragma unroll
        for (int tb = 0; tb < 2; ++tb)
#pragma unroll
            for (int r = 0; r < 16; ++r) oa[tb][r] = 0.f;
        {
            u32x2 qbuf[2][2][2];
#define ML_LDQ(buf, st_) do { _Pragma("unroll") for (int tb = 0; tb < 2; ++tb) { LAS const char* qp = L + ML_Q + (32 * tb + r32) * 272 + (16 * (st_) + 4 * hi) * 2; qbuf[buf][tb][0] = *(LAS const u32x2*)qp; qbuf[buf][tb][1] = *(LAS const u32x2*)(qp + 16); } } while (0)
            ML_LDQ(0, 0);
#pragma unroll
            for (int st = 0; st < 8; ++st) { const int kb = st >> 1, s2 = st & 1;
                if (st < 7) ML_LDQ((st + 1) & 1, st + 1);
                u32x4 w; w.x = pkbf(cT[kb][8 * s2], cT[kb][8 * s2 + 1]); w.y = pkbf(cT[kb][8 * s2 + 2], cT[kb][8 * s2 + 3]); w.z = pkbf(cT[kb][8 * s2 + 4], cT[kb][8 * s2 + 5]); w.w = pkbf(cT[kb][8 * s2 + 6], cT[kb][8 * s2 + 7]);
                const bf16x8 af = __builtin_bit_cast(bf16x8, w);
#pragma unroll
                for (int tb = 0; tb < 2; ++tb) { const u32x4 bw = (u32x4){qbuf[st & 1][tb][0].x, qbuf[st & 1][tb][0].y, qbuf[st & 1][tb][1].x, qbuf[st & 1][tb][1].y}; oa[tb] = mfma32(af, __builtin_bit_cast(bf16x8, bw), oa[tb]); }
                __builtin_amdgcn_sched_barrier(0); }
#undef ML_LDQ
        }
#pragma unroll
        for (int tb = 0; tb < 2; ++tb) { const float w = WINT[32 * tb + r32];
#pragma unroll
            for (int r = 0; r < 16; ++r) oa[tb][r] *= w;
#pragma unroll
            for (int ss = 0; ss < 4; ++ss) if (tb == 1 || ss < 2) { const u32x4 sw = *(LAS const u32x4*)(L + ML_S + (32 * tb + r32) * 144 + (16 * ss + 8 * hi) * 2);
                oa[tb] = mfma32(vf[ss], __builtin_bit_cast(bf16x8, sw), oa[tb]); } }
#pragma unroll
        for (int tb = 0; tb < 2; ++tb) { const int t = 32 * tb + r32; const float rs = (RS[t] + RS[64 + t]) + (RS[128 + t] + RS[192 + t]);
            const float den = WINT[t] * NQ[t] + rs, dn = fmaxf(fabsf(den), EMT[t]), inv = __builtin_amdgcn_rcpf(dn); float sq = 0.f;
#pragma unroll
            for (int r = 0; r < 16; ++r) { oa[tb][r] *= inv; sq += oa[tb][r] * oa[tb][r]; }
            sq = xsum32(sq);
            if (hi == 0) SSQ[wid * 64 + t] = sq; }
#pragma unroll
        for (int kb = 0; kb < 4; ++kb)
#pragma unroll
            for (int r = 0; r < 16; ++r) cT[kb][r] *= decay;
        {
            s16x4 ktb[2][2][2];
#define ML_LDK(buf, st_) do { _Pragma("unroll") for (int k2 = 0; k2 < 2; ++k2) { LAS const char* kp = L + ML_KT + (16 * ((st_) >> 1) + 8 * hi + (i16 >> 2)) * KTP + (32 * (2 * ((st_) & 1) + k2) + 16 * cb + 4 * (i16 & 3)) * 2; ktb[buf][k2][0] = lds_tr(kp); ktb[buf][k2][1] = lds_tr(kp + 4 * KTP); } } while (0)
            ML_LDK(0, 0);
#pragma unroll
            for (int st = 0; st < 8; ++st) {
                if (st < 7) ML_LDK((st + 1) & 1, st + 1);
#pragma unroll
                for (int k2 = 0; k2 < 2; ++k2) cT[2 * (st & 1) + k2] = mfma32(cat44(ktb[st & 1][k2][0], ktb[st & 1][k2][1]), vf[st >> 1], cT[2 * (st & 1) + k2]);
                __builtin_amdgcn_sched_barrier(0); }
#undef ML_LDK
        }
        { float a0 = 0.f, a1 = 0.f;
#pragma unroll
            for (int s = 0; s < 8; ++s) { a0 += bf2f(*(LAS const bf16_t*)(L + ML_KT + (8 * wid + s) * KTP + lane * 2)); a1 += bf2f(*(LAS const bf16_t*)(L + ML_KT + (8 * wid + s) * KTP + 128 + lane * 2)); }
            NPART[wid * 128 + lane] = a0; NPART[wid * 128 + 64 + lane] = a1; }
        __syncthreads();
        if (j + 1 < nch) ML_LOADV(j + 1);
        if (tid < 128) { float acc = 0.f;
#pragma unroll
            for (int w = 0; w < 8; ++w) acc += NPART[w * 128 + tid];
            NST[tid] = decay * NST[tid] + acc; }
#pragma unroll
        for (int tb = 0; tb < 2; ++tb) { const int t = 32 * tb + r32; float tot = 0.f;
#pragma unroll
            for (int w = 0; w < 8; ++w) tot += SSQ[w * 64 + t];
            const float rsn = __builtin_amdgcn_rsqf(tot * (1.0f / 256.0f) + HN_EPS);
            if (t < Lv) { bf16_t* op = MIX + (rb + 32 * tb + r32j) * DM + hh * 256 + 32 * wid + 4 * hij;
#pragma unroll
                for (int g = 0; g < 4; ++g) { const u32x2 ov = og[tb][g]; const float o0 = bflo(ov.x), o1 = bfhi(ov.x), o2 = bflo(ov.y), o3 = bfhi(ov.y);
                    const f32x4 gh = *(LAS const f32x4*)(GH + 32 * wid + 8 * g + 4 * hi);
                    const float v0 = oa[tb][4 * g] * (rsn * gh[0]) * __builtin_amdgcn_rcpf(1.0f + __expf(-o0)), v1 = oa[tb][4 * g + 1] * (rsn * gh[1]) * __builtin_amdgcn_rcpf(1.0f + __expf(-o1));
                    const float v2 = oa[tb][4 * g + 2] * (rsn * gh[2]) * __builtin_amdgcn_rcpf(1.0f + __expf(-o2)), v3 = oa[tb][4 * g + 3] * (rsn * gh[3]) * __builtin_amdgcn_rcpf(1.0f + __expf(-o3));
                    u32x2 w; w.x = pkbf(v0, v1); w.y = pkbf(v2, v3); *(GAS u32x2*)(op + 8 * g) = w; } } }
    }
#pragma unroll
    for (int kb = 0; kb < 4; ++kb)
#pragma unroll
        for (int g = 0; g < 4; ++g) { const f32x4 st = (f32x4){cT[kb][4 * g], cT[kb][4 * g + 1], cT[kb][4 * g + 2], cT[kb][4 * g + 3]};
            *(GAS f32x4*)(cout + (size_t)(32 * wid + r32) * 128 + 32 * kb + 8 * g + 4 * hi) = st; }
    __syncthreads();
    if (tid < 128) ((GAS float*)nout)[tid] = NST[tid];
    if (tid == 0) ((GAS float*)mout)[0] = m;
#undef ML_LOADQK
#undef ML_LOADV
}

__device__ __forceinline__ void mlstm_passA(LAS char* L, const bf16_t* P, const float* G, bf16_t* UC, float* GS, float* NL, int ci, size_t rb, int hh, const int wv) {
    const int tid = opaque_tid(wv), lane = tid & 63, wid = __builtin_amdgcn_readfirstlane(tid >> 6), r32 = lane & 31, hi = lane >> 5, i16 = lane & 15, cb = (lane >> 4) & 1;
    LAS float* NPART = (LAS float*)(L + ML_NP);
    const float ig = ((const GAS float*)G)[(rb + lane) * 16 + hh], lf = ((const GAS float*)G)[(rb + lane) * 16 + 4 + hh];
    const float bcs = scan_sum64l(lf, lane), u = ig - bcs, pm = scan_max64l(u, lane);
    const float pm63 = __int_as_float(__builtin_amdgcn_readlane(__float_as_int(pm), 63));
    const float av = __expf(u - pm63);
    if (wid == 0) { ((GAS float*)GS)[(size_t)ci * 128 + lane] = bcs; ((GAS float*)GS)[(size_t)ci * 128 + 64 + lane] = pm; }
#pragma unroll
    for (int i = 0; i < 2; ++i) { const int c = tid + 512 * i, row = c >> 4, ch = c & 15;
        const u32x4 kr = *(const GAS u32x4*)(P + (rb + row) * NP + PC_KA + hh * 128 + ch * 8);
        const float as = bperm_f(row, av); u32x4 w;
        w.x = pkbf(bflo(kr.x) * as, bfhi(kr.x) * as); w.y = pkbf(bflo(kr.y) * as, bfhi(kr.y) * as);
        w.z = pkbf(bflo(kr.z) * as, bfhi(kr.z) * as); w.w = pkbf(bflo(kr.w) * as, bfhi(kr.w) * as);
        *(LAS u32x4*)(L + ML_KT + row * KTP + ch * 16) = w; }
#pragma unroll
    for (int i = 0; i < 4; ++i) { const int c = tid + 512 * i, row = c >> 5, ch = c & 31;
        *(LAS u32x4*)(L + ML_V + row * VP + ch * 16) = *(const GAS u32x4*)(P + (rb + row) * NP + PC_VA + hh * 256 + ch * 8); }
    __syncthreads();
    bf16x8 vf[4];
#pragma unroll
    for (int ss = 0; ss < 4; ++ss) { LAS const char* vp = L + ML_V + (16 * ss + 8 * hi + (i16 >> 2)) * VP + (32 * wid + 16 * cb + 4 * (i16 & 3)) * 2; vf[ss] = cat44(lds_tr(vp), lds_tr(vp + 4 * VP)); }
    f32x16 cT[4];
#pragma unroll
    for (int kb = 0; kb < 4; ++kb)
#pragma unroll
        for (int r = 0; r < 16; ++r) cT[kb][r] = 0.f;
    {   s16x4 kt[16][2];
#pragma unroll
        for (int ss = 0; ss < 4; ++ss)
#pragma unroll
            for (int kb = 0; kb < 4; ++kb) { LAS const char* kp = L + ML_KT + (16 * ss + 8 * hi + (i16 >> 2)) * KTP + (32 * kb + 16 * cb + 4 * (i16 & 3)) * 2; kt[4 * ss + kb][0] = lds_tr(kp); kt[4 * ss + kb][1] = lds_tr(kp + 4 * KTP); }
        __builtin_amdgcn_sched_barrier(0);
#pragma unroll
        for (int ss = 0; ss < 4; ++ss)
#pragma unroll
            for (int kb = 0; kb < 4; ++kb) cT[kb] = mfma32(cat44(kt[4 * ss + kb][0], kt[4 * ss + kb][1]), vf[ss], cT[kb]);
        __builtin_amdgcn_sched_barrier(0); }
    { float a0 = 0.f, a1 = 0.f;
#pragma unroll
        for (int s = 0; s < 8; ++s) { a0 += bf2f(*(LAS const bf16_t*)(L + ML_KT + (8 * wid + s) * KTP + lane * 2)); a1 += bf2f(*(LAS const bf16_t*)(L + ML_KT + (8 * wid + s) * KTP + 128 + lane * 2)); }
        NPART[wid * 128 + lane] = a0; NPART[wid * 128 + 64 + lane] = a1; }
    GAS bf16_t* uo = (GAS bf16_t*)UC + (size_t)ci * 32768 + (size_t)wid * 4096 + lane * 8;
#pragma unroll
    for (int kb = 0; kb < 4; ++kb)
#pragma unroll
        for (int s2 = 0; s2 < 2; ++s2) { u32x4 w; w.x = pkbf(cT[kb][8 * s2], cT[kb][8 * s2 + 1]); w.y = pkbf(cT[kb][8 * s2 + 2], cT[kb][8 * s2 + 3]); w.z = pkbf(cT[kb][8 * s2 + 4], cT[kb][8 * s2 + 5]); w.w = pkbf(cT[kb][8 * s2 + 6], cT[kb][8 * s2 + 7]);
            *(GAS u32x4*)(uo + (kb * 2 + s2) * 512) = w; }
    __syncthreads();
    if (tid < 128) { float acc = 0.f;
#pragma unroll
        for (int w = 0; w < 8; ++w) acc += NPART[w * 128 + tid];
        ((GAS float*)NL)[(size_t)ci * 128 + tid] = acc; }
}

__device__ __forceinline__ void mlstm_passB(bf16_t* UC, const float* GS, const float* NL, float* NSV, float* MSV, float* out_c, float* out_n, float* out_m, int gtid, int nthreads) {
    const GAS float* gs = (const GAS float*)GS;
    for (int e = gtid; e < 16 * 4096; e += nthreads) {
        const int chain = e >> 12, f = e & 4095;
        float c[8]; float m = 0.f;
#pragma unroll
        for (int i = 0; i < 8; ++i) c[i] = 0.f;
        GAS u32x4* up = (GAS u32x4*)((GAS bf16_t*)UC + (size_t)chain * 64 * 32768 + (size_t)f * 8);
        for (int j0 = 0; j0 < 64; j0 += 8) {
            u32x4 uw8[8]; float b8[8], p8[8];
#pragma unroll
            for (int jj = 0; jj < 8; ++jj) { const int ci = chain * 64 + j0 + jj; uw8[jj] = up[(size_t)(j0 + jj) * 4096]; b8[jj] = gs[(size_t)ci * 128 + 63]; p8[jj] = gs[(size_t)ci * 128 + 127]; }
#pragma unroll
            for (int jj = 0; jj < 8; ++jj) { const float b63 = b8[jj], pm63 = p8[jj];
                const float mn = b63 + fmaxf(m, pm63), dec = __expf(b63 + m - mn), w = __expf(b63 + pm63 - mn); m = mn;
                const u32x4 uw = uw8[jj];
                c[0] = dec * c[0] + w * bflo(uw.x); c[1] = dec * c[1] + w * bfhi(uw.x); c[2] = dec * c[2] + w * bflo(uw.y); c[3] = dec * c[3] + w * bfhi(uw.y);
                c[4] = dec * c[4] + w * bflo(uw.z); c[5] = dec * c[5] + w * bfhi(uw.z); c[6] = dec * c[6] + w * bflo(uw.w); c[7] = dec * c[7] + w * bfhi(uw.w);
                u32x4 o; o.x = pkbf(c[0], c[1]); o.y = pkbf(c[2], c[3]); o.z = pkbf(c[4], c[5]); o.w = pkbf(c[6], c[7]); uw8[jj] = o; }
#pragma unroll
            for (int jj = 0; jj < 8; ++jj) up[(size_t)(j0 + jj) * 4096] = uw8[jj]; }
        const int ln = f & 63, ks = (f >> 6) & 7, w8 = f >> 9;
        const int v = 32 * w8 + (ln & 31), k = 32 * (ks >> 1) + 16 * (ks & 1) + 4 * (ln >> 5);
        GAS float* oc = (GAS float*)out_c + (size_t)chain * 32768 + (size_t)v * 128 + k;
        *(GAS f32x4*)oc = (f32x4){c[0], c[1], c[2], c[3]}; *(GAS f32x4*)(oc + 8) = (f32x4){c[4], c[5], c[6], c[7]};
    }
    const int nt = gtid - 16 * 4096;
    if (nt >= 0 && nt < 16 * 128) { const int chain = nt >> 7, k = nt & 127; float n = 0.f, m = 0.f;
        for (int j0 = 0; j0 < 64; j0 += 8) { float b8[8], p8[8], l8[8];
#pragma unroll
            for (int jj = 0; jj < 8; ++jj) { const int ci = chain * 64 + j0 + jj; b8[jj] = gs[(size_t)ci * 128 + 63]; p8[jj] = gs[(size_t)ci * 128 + 127]; l8[jj] = ((const GAS float*)NL)[(size_t)ci * 128 + k]; }
#pragma unroll
            for (int jj = 0; jj < 8; ++jj) { const int ci = chain * 64 + j0 + jj;
                const float mn = b8[jj] + fmaxf(m, p8[jj]), dec = __expf(b8[jj] + m - mn), w = __expf(b8[jj] + p8[jj] - mn); m = mn;
                n = dec * n + w * l8[jj];
                ((GAS float*)NSV)[(size_t)ci * 128 + k] = n; if (k == 0) ((GAS float*)MSV)[ci] = m; } }
        ((GAS float*)out_n)[chain * 128 + k] = n; if (k == 0) ((GAS float*)out_m)[chain] = m; }
}

__device__ __forceinline__ void mlstm_passC(LAS char* L, const bf16_t* P, const float* G, const bf16_t* UC, const float* GS, const float* NSV, const float* MSV, bf16_t* MIX, const float* ghead,
                                            int ci, int j, size_t rb, int hh, const int wv) {
    const int tid = opaque_tid(wv), lane = tid & 63, wid = __builtin_amdgcn_readfirstlane(tid >> 6), r32 = lane & 31, hi = lane >> 5, i16 = lane & 15, cb = (lane >> 4) & 1;
    LAS float* FA = (LAS float*)(L + ML_FA); LAS float* ROWT = FA, *COLS = FA + 64, *WINT = FA + 128, *EMT = FA + 192, *NQ = FA + 256;
    LAS float* NST = (LAS float*)(L + ML_N); LAS float* SSQ = (LAS float*)(L + ML_SSQ); LAS float* RS = (LAS float*)(L + ML_RS); LAS float* GH = (LAS float*)(L + ML_GH);
    {
        const float ig = ((const GAS float*)G)[(rb + lane) * 16 + hh], bcs = ((const GAS float*)GS)[(size_t)ci * 128 + lane], pm = ((const GAS float*)GS)[(size_t)ci * 128 + 64 + lane];
        const float m = j > 0 ? ((const GAS float*)MSV)[ci - 1] : 0.f, mt = bcs + fmaxf(m, pm);
        if (wid == 0) { ROWT[lane] = bcs - mt; COLS[lane] = ig - bcs; WINT[lane] = __expf(bcs + m - mt); EMT[lane] = __expf(-mt); }
    }
    u32x2 og[2][4];
#pragma unroll
    for (int tb = 0; tb < 2; ++tb)
#pragma unroll
        for (int g = 0; g < 4; ++g) og[tb][g] = *(const GAS u32x2*)(P + (rb + 32 * tb + r32) * NP + PC_OA + hh * 256 + 32 * wid + 8 * g + 4 * hi);
    u32x4 af[8];
    if (j > 0) { const GAS bf16_t* ui = (const GAS bf16_t*)UC + (size_t)(ci - 1) * 32768 + (size_t)wid * 4096 + lane * 8;
#pragma unroll
        for (int st = 0; st < 8; ++st) af[st] = *(const GAS u32x4*)(ui + st * 512); }
    if (tid < 128) NST[tid] = j > 0 ? ((const GAS float*)NSV)[(size_t)(ci - 1) * 128 + tid] : 0.f;
    if (tid < 256) GH[tid] = ((const GAS float*)ghead)[hh * 256 + tid];
#pragma unroll
    for (int i = 0; i < 2; ++i) { const int c = tid + 512 * i, row = c >> 4, ch = c & 15;
        *(LAS u32x4*)(L + ML_Q + row * 272 + ch * 16) = *(const GAS u32x4*)(P + (rb + row) * NP + PC_QA + hh * 128 + ch * 8);
        *(LAS u32x4*)(L + ML_K + row * 272 + ch * 16) = *(const GAS u32x4*)(P + (rb + row) * NP + PC_KA + hh * 128 + ch * 8); }
#pragma unroll
    for (int i = 0; i < 4; ++i) { const int c = tid + 512 * i, row = c >> 5, ch = c & 31;
        *(LAS u32x4*)(L + ML_V + row * VP + ch * 16) = *(const GAS u32x4*)(P + (rb + row) * NP + PC_VA + hh * 256 + ch * 8); }
    __syncthreads();
    {
        const int fr = lane & 15, fq = lane >> 4;
#pragma unroll
        for (int bi = 0; bi < 2; ++bi) { const int id = 2 * wid + bi, sb = id >> 2, tb = id & 3; const int t = 16 * tb + fr, s0 = 16 * sb + 4 * fq;
            u32x2 ow = (u32x2){0u, 0u};
            if (sb <= tb) { f32x4 acc = (f32x4){0.f, 0.f, 0.f, 0.f};
#pragma unroll
                for (int kk = 0; kk < 4; ++kk) { const bf16x8 a = *(LAS const bf16x8*)(L + ML_K + (16 * sb + fr) * 272 + kk * 64 + fq * 16), q = *(LAS const bf16x8*)(L + ML_Q + (16 * tb + fr) * 272 + kk * 64 + fq * 16);
                    acc = mfma16(a, q, acc); }
                const float rt = ROWT[t]; const f32x4 cs = *(LAS const f32x4*)(COLS + s0); float v[4];
#pragma unroll
                for (int i = 0; i < 4; ++i) v[i] = (s0 + i <= t) ? acc[i] * __expf(rt + cs[i]) : 0.f;
                ow.x = pkbf(v[0], v[1]); ow.y = pkbf(v[2], v[3]); }
            *(LAS u32x2*)(L + ML_S + t * 144 + s0 * 2) = ow;
            float ps = (bflo(ow.x) + bfhi(ow.x)) + (bflo(ow.y) + bfhi(ow.y));
            { auto r1 = __builtin_amdgcn_permlane16_swap(__float_as_uint(ps), __float_as_uint(ps), false, false); ps = __uint_as_float(r1[0]) + __uint_as_float(r1[1]); }
            ps = xsum32(ps);
            if (fq == 0) RS[sb * 64 + t] = ps; }
        const int t = 8 * wid + (lane >> 3), kp = lane & 7;
        const u32x4 q0 = *(LAS const u32x4*)(L + ML_Q + t * 272 + kp * 32), q1 = *(LAS const u32x4*)(L + ML_Q + t * 272 + kp * 32 + 16);
        const f32x4 n0v = *(LAS const f32x4*)(NST + 16 * kp), n1v = *(LAS const f32x4*)(NST + 16 * kp + 4), n2v = *(LAS const f32x4*)(NST + 16 * kp + 8), n3v = *(LAS const f32x4*)(NST + 16 * kp + 12);
        float d = bflo(q0.x) * n0v[0] + bfhi(q0.x) * n0v[1] + bflo(q0.y) * n0v[2] + bfhi(q0.y) * n0v[3] + bflo(q0.z) * n1v[0] + bfhi(q0.z) * n1v[1] + bflo(q0.w) * n1v[2] + bfhi(q0.w) * n1v[3]
                + bflo(q1.x) * n2v[0] + bfhi(q1.x) * n2v[1] + bflo(q1.y) * n2v[2] + bfhi(q1.y) * n2v[3] + bflo(q1.z) * n3v[0] + bfhi(q1.z) * n3v[1] + bflo(q1.w) * n3v[2] + bfhi(q1.w) * n3v[3];
        d += dpp_f(d, 0); d += dpp_f(d, 1); d += dpp_f(d, 2);
        if (kp == 0) NQ[t] = d;
    }
    __syncthreads();
    bf16x8 vf[4];
#pragma unroll
    for (int ss = 0; ss < 4; ++ss) { LAS const char* vp = L + ML_V + (16 * ss + 8 * hi + (i16 >> 2)) * VP + (32 * wid + 16 * cb + 4 * (i16 & 3)) * 2; vf[ss] = cat44(lds_tr(vp), lds_tr(vp + 4 * VP)); }
    f32x16 oa[2];
#pragma unroll
    for (int tb = 0; tb < 2; ++tb)
#pragma unroll
        for (int r = 0; r < 16; ++r) oa[tb][r] = 0.f;
    if (j > 0) {
        u32x2 qw[16][2];
#pragma unroll
        for (int st = 0; st < 8; ++st)
#pragma unroll
            for (int tb = 0; tb < 2; ++tb) { LAS const char* qp = L + ML_Q + (32 * tb + r32) * 272 + (16 * st + 4 * hi) * 2; qw[2 * st + tb][0] = *(LAS const u32x2*)qp; qw[2 * st + tb][1] = *(LAS const u32x2*)(qp + 16); }
        __builtin_amdgcn_sched_barrier(0);
#pragma unroll
        for (int st = 0; st < 8; ++st)
#pragma unroll
            for (int tb = 0; tb < 2; ++tb) { const u32x4 bw = (u32x4){qw[2 * st + tb][0].x, qw[2 * st + tb][0].y, qw[2 * st + tb][1].x, qw[2 * st + tb][1].y};
                oa[tb] = mfma32(__builtin_bit_cast(bf16x8, af[st]), __builtin_bit_cast(bf16x8, bw), oa[tb]); }
        __builtin_amdgcn_sched_barrier(0);
    }
#pragma unroll
    for (int tb = 0; tb < 2; ++tb) { const float w = WINT[32 * tb + r32];
#pragma unroll
        for (int r = 0; r < 16; ++r) oa[tb][r] *= w;
#pragma unroll
        for (int ss = 0; ss < 4; ++ss) if (tb == 1 || ss < 2) { const u32x4 sw = *(LAS const u32x4*)(L + ML_S + (32 * tb + r32) * 144 + (16 * ss + 8 * hi) * 2);
            oa[tb] = mfma32(vf[ss], __builtin_bit_cast(bf16x8, sw), oa[tb]); } }
#pragma unroll
    for (int tb = 0; tb < 2; ++tb) { const int t = 32 * tb + r32; const float rs = (RS[t] + RS[64 + t]) + (RS[128 + t] + RS[192 + t]);
        const float den = WINT[t] * NQ[t] + rs, dn = fmaxf(fabsf(den), EMT[t]), inv = __builtin_amdgcn_rcpf(dn); float sq = 0.f;
#pragma unroll
        for (int r = 0; r < 16; ++r) { oa[tb][r] *= inv; sq += oa[tb][r] * oa[tb][r]; }
        sq = xsum32(sq);
        if (hi == 0) SSQ[wid * 64 + t] = sq; }
    __syncthreads();
#pragma unroll
    for (int tb = 0; tb < 2; ++tb) { const int t = 32 * tb + r32; float tot = 0.f;
#pragma unroll
        for (int w = 0; w < 8; ++w) tot += SSQ[w * 64 + t];
        const float rsn = __builtin_amdgcn_rsqf(tot * (1.0f / 256.0f) + HN_EPS);
        GAS bf16_t* op = (GAS bf16_t*)MIX + (rb + t) * DM + hh * 256 + 32 * wid + 4 * hi;
#pragma unroll
        for (int g = 0; g < 4; ++g) { const u32x2 ov = og[tb][g]; const float o0 = bflo(ov.x), o1 = bfhi(ov.x), o2 = bflo(ov.y), o3 = bfhi(ov.y);
            const f32x4 gh = *(LAS const f32x4*)(GH + 32 * wid + 8 * g + 4 * hi);
            const float v0 = oa[tb][4 * g] * (rsn * gh[0]) * __builtin_amdgcn_rcpf(1.0f + __expf(-o0)), v1 = oa[tb][4 * g + 1] * (rsn * gh[1]) * __builtin_amdgcn_rcpf(1.0f + __expf(-o1));
            const float v2 = oa[tb][4 * g + 2] * (rsn * gh[2]) * __builtin_amdgcn_rcpf(1.0f + __expf(-o2)), v3 = oa[tb][4 * g + 3] * (rsn * gh[3]) * __builtin_amdgcn_rcpf(1.0f + __expf(-o3));
            u32x2 w; w.x = pkbf(v0, v1); w.y = pkbf(v2, v3); *(GAS u32x2*)(op + 8 * g) = w; } }
}

#define XB_TMO      128
#define XB_XCNT(j)  (256  + 64 * (j))
#define XB_XSUB(j)  (1280 + 64 * (j))
#define XB_XGEN(j)  (2304 + 64 * (j))
#define XB_TOP      3328
#define XB_TOPGEN   3392
#define XCD_BAR_WORDS 3456
#define XB_SPIN_CAP (1u << 18)

__device__ __forceinline__ unsigned xb_ld(unsigned* p)              { return __hip_atomic_load(p, __ATOMIC_RELAXED, __HIP_MEMORY_SCOPE_AGENT); }
__device__ __forceinline__ unsigned xb_add(unsigned* p, unsigned v) { return __hip_atomic_fetch_add(p, v, __ATOMIC_RELAXED, __HIP_MEMORY_SCOPE_AGENT); }
__device__ __forceinline__ unsigned xb_xcc_id() { return (unsigned)__builtin_amdgcn_s_getreg((3 << 11) | 20) & 0xFu; }
#define XB_SPIN(cond, bar) do { unsigned _sp = 0; while (cond) { __builtin_amdgcn_s_sleep(1); \
    if ((++_sp & 255u) == 0u) { if (xb_ld(&(bar)[XB_TMO])) break; if (_sp > XB_SPIN_CAP) { atomicAdd(&(bar)[XB_TMO], 1u); break; } } } } while (0)

struct XcdBarrier {
    unsigned* bar; unsigned x;
    volatile LAS unsigned* st;
};

__device__ __forceinline__ XcdBarrier xcd_barrier_post(unsigned* bar, volatile LAS unsigned* st) {
    XcdBarrier b; b.bar = bar; b.x = xb_xcc_id(); b.st = st;
    if (threadIdx.x == 0) (void)xb_add(&bar[XB_XCNT(b.x)], 1u);
    return b;
}
__device__ __forceinline__ void xcd_barrier_complete(unsigned* bar, unsigned x, unsigned& nloc, unsigned& nx) {
    const unsigned G = gridDim.x * gridDim.y * gridDim.z;
    unsigned sum, cnt, mine, sp = 0u;
    for (;;) {
        sum = 0u; cnt = 0u; mine = 0u;
#pragma unroll
        for (unsigned j = 0; j < 16; ++j) { const unsigned c = xb_ld(&bar[XB_XCNT(j)]); sum += c; cnt += (c > 0u) ? 1u : 0u; mine = (j == x) ? c : mine; }
        if (sum == G) break;
        __builtin_amdgcn_s_sleep(1);
        if ((++sp & 255u) == 0u) { if (xb_ld(&bar[XB_TMO])) break; if (sp > XB_SPIN_CAP) { atomicAdd(&bar[XB_TMO], 1u); break; } }
    }
    nloc = mine > 0u ? mine : 1u; nx = cnt > 0u ? cnt : 1u;
}

__device__ __forceinline__ void xcd_barrier(const XcdBarrier& b) {
    asm volatile("s_waitcnt vmcnt(0)" ::: "memory");
    __syncthreads();
    if (threadIdx.x == 0) {
        unsigned* bar = b.bar;
        __builtin_amdgcn_s_waitcnt(0);
        unsigned nloc = b.st[0], nx = b.st[1];
        if (nloc == 0u) { xcd_barrier_complete(bar, b.x, nloc, nx); b.st[0] = nloc; b.st[1] = nx; }
        const unsigned old = xb_add(&bar[XB_XSUB(b.x)], 1u);
        const unsigned gen = old / nloc;
        if (old + 1u == (gen + 1u) * nloc) {
            __builtin_amdgcn_fence(__ATOMIC_RELEASE, "agent");
            asm volatile("s_waitcnt vmcnt(0)" ::: "memory");
            const unsigned og = xb_add(&bar[XB_TOP], 1u);
            const unsigned tg = og / nx;
            if (og + 1u == (tg + 1u) * nx) xb_add(&bar[XB_TOPGEN], 1u);
            else XB_SPIN(xb_ld(&bar[XB_TOPGEN]) == tg, bar);
            __builtin_amdgcn_fence(__ATOMIC_ACQUIRE, "agent");
            xb_add(&bar[XB_XGEN(b.x)], 1u);
            asm volatile("s_waitcnt vmcnt(0)" ::: "memory");
        } else {
            XB_SPIN(xb_ld(&bar[XB_XGEN(b.x)]) == gen, bar);
            __builtin_amdgcn_fence(__ATOMIC_ACQUIRE, "agent");
            asm volatile("s_waitcnt vmcnt(0)" ::: "memory");
        }
    }
    __syncthreads();
}

constexpr int LDS_BYTES = 147456;
constexpr int NPHASE = 15;
constexpr int NCONV_EARLY = 32 * 200 + 32 * 64 + 32 * 256;
constexpr int NCONV_ITEMS = NCONV_EARLY / 16;
#ifndef PH_MASK
#define PH_MASK 0xFFFF
#endif
#define PHON(k) ((PH_MASK >> (k)) & 1)
__global__ void __launch_bounds__(512) fwd_megakernel(Args args) {
    extern __shared__ __attribute__((aligned(16))) unsigned char lds_raw[];
    LAS unsigned char* lds = (LAS unsigned char*)lds_raw;
    cg::grid_group grid = cg::this_grid();
    const int wv = __builtin_amdgcn_readfirstlane((int)threadIdx.x >> 6);
    volatile LAS unsigned* xst = (volatile LAS unsigned*)(lds + LDS_BYTES - 32);
    if (threadIdx.x < 2) xst[threadIdx.x] = 0u;
    __syncthreads();
    const XcdBarrier xbar = xcd_barrier_post((unsigned*)as_global(args.ws) + 4096, xst);
    if (args.ph_lo < 0) grid.sync();
#define GRID_SYNC() xcd_barrier(xbar)
    const int G = gridDim.x, NGW = G * 8, wave = wv, gw = blockIdx.x * 8 + wave;
#define KT_LANE() (opaque_tid(wv) & 63)
#ifndef REP_SUB
#define REP_SUB -1
#define REP_N 0
#endif
    for (int ph = args.ph_lo; ph < args.ph_hi; ++ph) {
      const int nrep = (REP_SUB >= 0 && ph > 0 && (ph - 1) % 7 == REP_SUB) ? 1 + REP_N : 1;
      for (int rep = 0; rep < nrep; ++rep) {
        unsigned char* ws = args.ws; float* out = args.out; asm volatile("" : "+s"(ws), "+s"(out)); ws = as_global(ws); out = as_global(out);
    bf16_t* XB = (bf16_t*)(ws + WS_XB); bf16_t* Pb = (bf16_t*)(ws + WS_P); bf16_t* MIX = (bf16_t*)(ws + WS_MIX); bf16_t* Hb = (bf16_t*)(ws + WS_H);
    float* Gt = (float*)(ws + WS_G); float* lfT = (float*)(ws + WS_LFT); float* lfS = (float*)(ws + WS_LFS); bf16_t* Z = (bf16_t*)(ws + WS_Z);
    unsigned* ctl = (unsigned*)(ws + WS_CTL); float* PART = (float*)(ws + WS_PART);
        const int wave = wv, gw = blockIdx.x * 8 + wave;
#define KT_LANE() (opaque_tid(wv) & 63)
        if (ph == 0) { if (PHON(0)) {
            convert_x(args, gw, NGW, KT_LANE());
            convert_weights(args, 0, (LAS float*)(lds + wave * 16384), gw, NGW, KT_LANE()); }
        } else {
            const int layer = (ph - 1) / 7, sub = (ph - 1) % 7;
            if (sub == 0) { if (PHON(1)) {
                pg8::Gemm g{XB, (const bf16_t*)(ws + WS_WIN), MPAD, NIN, DM, DM}; pg8::StaticOrder S; S.init(MPAD, NIN, G, (int)blockIdx.x);
                EpiIn E{Pb, Gt, lfT, lfS, as_global(args.in[9]) + layer * 16, out + O_KP + (size_t)layer * MP * 1024, out + O_VP + (size_t)layer * MP * 1024,
                        out + O_KS + (size_t)layer * MS * 1024, out + O_VS + (size_t)layer * MS * 1024, out + O_LFP + (size_t)layer * MP * 8, out + O_LFS + (size_t)layer * MS * 8};
                pg8::gemm_phase<EpiIn, pg8::StaticOrder, true, true>(lds, g, S, E, wv); }
            } else if (sub == 1) {
                LAS int* slot = (LAS int*)(lds + LDS_BYTES - 64);
                bf16_t* UC = (bf16_t*)Z; float* GS = (float*)((unsigned char*)Z + 64 * MiB); float* NL = GS + 1024 * 128; float* NSV = NL + 1024 * 128; float* MSV = NSV + 1024 * 128;
#ifndef REP_STAGE
#define REP_STAGE 0
#endif
                for (int r2 = 0; r2 < (REP_STAGE == 1 ? 2 : 1); ++r2) { if (r2) GRID_SYNC();
                for (;;) {
                    __syncthreads();
                    if (opaque_tid(wv) == 0) slot[0] = (int)atomicAdd(ctl + 64 * (1 + layer + 2 * r2), 1u);
                    __syncthreads();
                    const int it = slot[0];
                    if (it >= 1632 + (layer == 0 ? NCONV_ITEMS : 0)) break;
                    if (it >= 1632) { if (PHON(9)) { const int c0i = (it - 1632) * 16;
                        convert_weights(args, 1, (LAS float*)(lds + wave * 16384), c0i + wave, 8, KT_LANE(), c0i + 16); }
                        continue; }
                    if (it >= 608) { if (PHON(2)) { const int ci = it - 608, chain = ci >> 6, j = ci & 63;
                        mlstm_passA((LAS char*)lds, Pb, Gt, UC, GS, NL, ci, (size_t)(chain >> 2) * SEQ + 64 * j, chain & 3, wv); }
                    } else if (it >= 64 && it < 96) { if (PHON(2)) { const int sb = (it - 64) >> 2, hh = (it - 64) & 3; const size_t si = (size_t)(layer * 8 + sb) * 4 + hh;
                        mlstm_item((LAS char*)lds, Pb, Gt, MIX, as_global(args.in[10]) + layer * 1024, (size_t)MP + sb * 16, hh, 1, 16, as_global(args.in[5]) + si * 32768, as_global(args.in[6]) + si * 128, as_global(args.in[7]) + si,
                                   out + O_CS + si * 32768, out + O_NS + si * 128, out + O_MS + si, wv); }
                    } else if (it < 64) { if (PHON(3)) { const int sb = it >> 3, h = it & 7;
                        fox_sample_item((LAS char*)lds, Pb, lfS, as_global(args.in[2]) + (size_t)layer * SBATCH * PAST * 1024, as_global(args.in[3]) + (size_t)layer * SBATCH * PAST * 1024,
                                        as_global(args.in[4]) + (size_t)layer * SBATCH * PAST * 8, MIX, sb, h, wv); }
                    } else if (PHON(4)) { const int qb = 15 - ((it - 96) >> 5), bh = (it - 96) & 31;
                        fox_prompt_unit((LAS char*)lds, Pb, lfT, MIX, bh >> 3, bh & 7, qb, wv); }
                } }
                GRID_SYNC();
                for (int r2 = 0; r2 < (REP_STAGE == 2 ? 2 : 1); ++r2) { if (r2) GRID_SYNC();
                if (PHON(2)) mlstm_passB(UC, GS, NL, NSV, MSV, out + O_CP + (size_t)layer * 16 * 32768, out + O_NP + (size_t)layer * 16 * 128, out + O_MP + layer * 16,
                                        (int)blockIdx.x * 512 + opaque_tid(wv), G * 512); }
                GRID_SYNC();
                for (int r2 = 0; r2 < (REP_STAGE == 3 ? 2 : 1); ++r2) { if (r2) GRID_SYNC();
                for (int it = (int)blockIdx.x; it < 1024; it += G) {
                    __syncthreads();
                    if (PHON(2)) { const int ci = it, chain = ci >> 6, j = ci & 63;
                        mlstm_passC((LAS char*)lds, Pb, Gt, UC, GS, NSV, MSV, MIX, as_global(args.in[10]) + layer * 1024, ci, j, (size_t)(chain >> 2) * SEQ + 64 * j, chain & 3, wv); }
                } }
            } else if (sub == 2) { if (PHON(5)) {
                { pg8::Gemm g{MIX, (const bf16_t*)(ws + (layer ? WS_WOUT2 : WS_WOUT)), MP, DM, DM, DM}; pg8::StaticOrder S; S.init(MP, DM, G, (int)blockIdx.x);
                  EpiRes E{XB, Z};
                  pg8::gemm_phase<EpiRes, pg8::StaticOrder, true, true>(lds, g, S, E, wv); }
                { pg8::Gemm g{MIX, (const bf16_t*)(ws + (layer ? WS_WOUT2 : WS_WOUT)), MPAD, DM, DM / NSL_OUT, DM}; pg8::SplitOrder S; S.init(DM, NSL_OUT, MP / 256, G, (int)blockIdx.x);
                  EpiPart E{PART};
                  pg8::gemm_phase<EpiPart, pg8::SplitOrder, true, true>(lds, g, S, E, wv); } }
            } else if (sub == 3) {
                if (PHON(6)) ln_phase(Z, XB, PART, NSL_OUT, as_global(args.in[12]) + layer * DM, as_global(args.in[13]) + layer * DM, XB, nullptr, nullptr, gw, NGW, KT_LANE());
            } else if (sub == 4) { if (PHON(7)) {
                pg8::Gemm g{XB, (const bf16_t*)(ws + (layer ? WS_WUP2 : WS_WUP)), MPAD, DFF, DM, DM}; pg8::StaticOrder S; S.init(MPAD, DFF, G, (int)blockIdx.x);
                EpiUp E{Hb};
                pg8::gemm_phase<EpiUp, pg8::StaticOrder, true, true>(lds, g, S, E, wv); }
            } else if (sub == 5) { if (PHON(8)) {
                { pg8::Gemm g{Hb, (const bf16_t*)(ws + WS_WDN), MP, DM, DFF, DFF}; pg8::StaticOrder S; S.init(MP, DM, G, (int)blockIdx.x);
                  EpiRes E{XB, Z};
                  pg8::gemm_phase<EpiRes, pg8::StaticOrder, true, true>(lds, g, S, E, wv); }
                { pg8::Gemm g{Hb, (const bf16_t*)(ws + WS_WDN), MPAD, DM, DFF / NSL_DN, DFF}; pg8::SplitOrder S; S.init(DM, NSL_DN, MP / 256, G, (int)blockIdx.x);
                  EpiPart E{PART};
                  pg8::gemm_phase<EpiPart, pg8::SplitOrder, true, true>(lds, g, S, E, wv); } }
            } else if (PHON(9)) {
                if (layer == 0) { ln_phase(Z, XB, PART, NSL_DN, as_global(args.in[16]), as_global(args.in[17]), XB, nullptr, nullptr, gw, NGW, KT_LANE());
                    convert_weights(args, 1, (LAS float*)(lds + wave * 16384), NCONV_EARLY + gw, NGW, KT_LANE()); }
                else ln_phase(Z, XB, PART, NSL_DN, as_global(args.in[16]) + DM, as_global(args.in[17]) + DM, nullptr, out + O_YP, out + O_YS, gw, NGW, KT_LANE());
            }
        }
        if (rep + 1 < nrep) GRID_SYNC();
      }
        if (ph + 1 < args.ph_hi) GRID_SYNC();
    }
}

extern "C" void kernel_launch(void* const* d_in, const int* in_sizes, int n_in, void* d_out, int out_size, void* d_ws, size_t ws_size, hipStream_t stream) {
    static int grid = 0;
    if (grid == 0) {
        if (n_in != 18 || (size_t)out_size != O_END || ws_size < WS_END) { fprintf(stderr, "kernel_launch: unexpected shapes (n_in %d out %d ws %zu)\n", n_in, out_size, ws_size); grid = -1; return; }
        int dev = 0, cus = 0, per_cu = 0;
        hipGetDevice(&dev); hipDeviceGetAttribute(&cus, hipDeviceAttributeMultiprocessorCount, dev);
        hipFuncSetAttribute((const void*)fwd_megakernel, hipFuncAttributeMaxDynamicSharedMemorySize, LDS_BYTES);
        hipOccupancyMaxActiveBlocksPerMultiprocessor(&per_cu, (const void*)fwd_megakernel, 512, LDS_BYTES);
        (void)hipGetLastError();
        if (per_cu < 1) per_cu = 1;
        grid = cus;
        if (grid > cus * per_cu) grid = cus * per_cu;
    }
    if (grid < 0) return;
    hipMemsetAsync((char*)d_ws + WS_CTL, 0, 65536, stream);
    Args a{};
    for (int i = 0; i < 18; ++i) a.in[i] = (const float*)d_in[i];
    a.out = (float*)d_out; a.ws = (unsigned char*)d_ws; a.ph_lo = 0; a.ph_hi = NPHASE;
    void* kargs[] = {&a};
    hipError_t e = hipLaunchCooperativeKernel((const void*)fwd_megakernel, dim3(grid), dim3(512), kargs, LDS_BYTES, stream);
    if (e != hipSuccess) fprintf(stderr, "cooperative launch failed: %s (grid %d)\n", hipGetErrorString(e), grid);
}
```

```cpp
#include <hip/hip_runtime.h>
#include <hip/hip_cooperative_groups.h>
#include <cstdio>
#include <cstdint>
namespace cg = cooperative_groups;

constexpr int DM = 2048, NBATCH = 4, SEQ = 4096, MP = NBATCH * SEQ;
constexpr int SBATCH = 8, SLEN = 16, MS = SBATCH * SLEN;
constexpr int MT = MP + MS, MPAD = 16640;
constexpr int PAST = 1024, HA = 4, DVA = 256, DKA = 128, HB = 8, DHB = 128, DFF = 8192;
constexpr int NP = 6144;
constexpr int NIN = 6400, NINSRC = 6160;
constexpr int PC_QA = 0, PC_KA = 512, PC_VA = 1024, PC_OA = 2048, PC_QB = 3072, PC_KB = 4096, PC_VB = 5120;
constexpr float ALPHA = 1.4142135623730951f;
constexpr float LN_EPS = 1e-5f, HN_EPS = 1e-6f;
constexpr float LOG2E = 1.4426950408889634f;
constexpr float QA_SCALE = 0.08838834764831845f;
constexpr float QB_SCALE = 0.08838834764831845f * 1.4426950408889634f;

constexpr size_t O_YP = 0, O_YS = O_YP + (size_t)MP * DM, O_KP = O_YS + (size_t)MS * DM, O_VP = O_KP + (size_t)2 * MP * 1024,
                 O_LFP = O_VP + (size_t)2 * MP * 1024, O_CP = O_LFP + (size_t)2 * MP * 8, O_NP = O_CP + (size_t)2 * 4 * 4 * 256 * 128,
                 O_MP = O_NP + (size_t)2 * 4 * 4 * 128, O_KS = O_MP + 32, O_VS = O_KS + (size_t)2 * MS * 1024, O_LFS = O_VS + (size_t)2 * MS * 1024,
                 O_CS = O_LFS + (size_t)2 * MS * 8, O_NS = O_CS + (size_t)2 * 8 * 4 * 256 * 128, O_MS = O_NS + (size_t)2 * 8 * 4 * 128, O_END = O_MS + 64;

constexpr size_t MiB = 1u << 20;
constexpr size_t WS_CTL = 0;
constexpr size_t WS_WIN = 1 * MiB;
constexpr size_t WS_WOUT = 26 * MiB;
constexpr size_t WS_WUP = 34 * MiB;
constexpr size_t WS_WDN = 66 * MiB;
constexpr size_t WS_XB = 98 * MiB;
constexpr size_t WS_G = 163 * MiB;
constexpr size_t WS_LFT = WS_G + (size_t)MPAD * 16 * 4;
constexpr size_t WS_LFS = WS_LFT + (size_t)32 * 4096 * 4;
constexpr size_t WS_Z = 166 * MiB;
constexpr size_t WS_P = 296 * MiB;
constexpr size_t WS_MIX = WS_P + (size_t)MPAD * NP * 2;
constexpr size_t WS_H = WS_P;
constexpr size_t WS_PART = WS_P + (size_t)MPAD * DFF * 2;
constexpr size_t WS_WOUT2 = WS_PART + (size_t)32 * MS * DM * 4;
constexpr size_t WS_WUP2 = WS_WOUT2 + 8 * MiB;
constexpr size_t WS_END = WS_WUP2 + 32 * MiB;
constexpr int NSL_OUT = 16, NSL_DN = 32;
static_assert(WS_LFS + 64 * 16 * 4 <= WS_Z && WS_Z + (size_t)MPAD * DM * 4 <= WS_P && WS_MIX + (size_t)MPAD * DM * 2 <= WS_PART, "ws map");

#define LAS __attribute__((address_space(3)))
#define GAS __attribute__((address_space(1)))
typedef unsigned short bf16_t;
typedef short bf16x8 __attribute__((ext_vector_type(8)));
typedef short s16x4 __attribute__((ext_vector_type(4)));
typedef float f32x2 __attribute__((ext_vector_type(2)));
typedef float f32x4 __attribute__((ext_vector_type(4)));
typedef float f32x16 __attribute__((ext_vector_type(16)));
typedef unsigned u32x2 __attribute__((ext_vector_type(2)));
typedef unsigned u32x4 __attribute__((ext_vector_type(4)));
typedef __bf16 bf16x2_t __attribute__((ext_vector_type(2)));

__device__ __forceinline__ int opaque_tid(int wv) { int l; asm volatile("v_mbcnt_lo_u32_b32 %0, -1, 0\n\tv_mbcnt_hi_u32_b32 %0, -1, %0" : "=v"(l)); return wv * 64 + l; }
template <class T> __device__ __forceinline__ T* as_global(T* p) { return (T*)(__attribute__((address_space(1))) T*)p; }
__device__ __forceinline__ float bf2f(unsigned short u) { return __uint_as_float((unsigned)u << 16); }
__device__ __forceinline__ float bflo(unsigned u) { return __uint_as_float(u << 16); }
__device__ __forceinline__ float bfhi(unsigned u) { return __uint_as_float(u & 0xffff0000u); }
__device__ __forceinline__ unsigned pkbf(float lo, float hi) { f32x2 v = {lo, hi}; bf16x2_t b = __builtin_convertvector(v, bf16x2_t); return __builtin_bit_cast(unsigned, b); }
__device__ __forceinline__ float log_sigmoid(float x) {
    const float e = __expf(-fabsf(x));
    const float l = e < 0.03125f ? e * (1.0f - e * (0.5f - e * (0.33333334f - 0.25f * e))) : __logf(1.0f + e);
    return fminf(x, 0.f) - l; }
__device__ __forceinline__ int crow(int r, int hi) { return (r & 3) + 8 * (r >> 2) + 4 * hi; }
__device__ __forceinline__ s16x4 lds_tr(LAS const char* p) { return __builtin_bit_cast(s16x4, __builtin_amdgcn_ds_read_tr16_b64_v4i16((LAS s16x4*)p)); }
__device__ __forceinline__ bf16x8 cat44(s16x4 a, s16x4 b) { return (bf16x8){a[0], a[1], a[2], a[3], b[0], b[1], b[2], b[3]}; }

namespace pg8 {
#define PG8_LAS __attribute__((address_space(3)))
typedef unsigned short bf16_t;
typedef short bf16x8 __attribute__((ext_vector_type(8)));
typedef float f32x4 __attribute__((ext_vector_type(4)));
typedef unsigned u32x4 __attribute__((ext_vector_type(4)));
constexpr int BM = 256, BK = 64, HALF = 128, HTB = HALF * BK * 2  , STAGE_BYTES = 8 * HTB, NXCD = 8, WGM = 8;

__host__ __device__ __forceinline__ int lds_byte(int r, int c) { const int st = (r >> 4) * 2 + (c >> 5), rr = r & 15, cc = c & 31, ob = rr * 64 + cc * 2; return st * 1024 + (ob ^ (((ob >> 9) & 1) << 5)); }
__host__ __device__ __forceinline__ void stage_rc(int b, int& R, int& C) { const int st = b / 1024, sb = b % 1024, swz = sb ^ (((sb >> 9) & 1) << 5); R = (st >> 1) * 16 + swz / 64; C = (st & 1) * 32 + (swz % 64) / 2; }
__host__ __device__ __forceinline__ int perm32(int rho) { const int n = rho >> 4, i = rho & 15; return 8 * (i >> 2) + 4 * n + (i & 3); }

struct Unit { int pm, pn, pk; };
struct Gemm { const bf16_t* A; const bf16_t* Bt; int M, N, K, ld; };

struct StaticOrder {
    int nM, nN, nwg, G, c;
    __host__ __device__ void init(int M, int N, int G_, int c_) { nM = M / BM; nN = N / BM; nwg = nM * nN; G = G_; c = c_; }
    __host__ __device__ bool next(int i, Unit& u) const {
        const long L = (long)i * G + c; if (L >= nwg) return false;
        int wgid = (int)L; { const int q = nwg / NXCD, r = nwg % NXCD, xcd = wgid % NXCD, off = wgid / NXCD; wgid = (xcd < r ? xcd * (q + 1) : r * (q + 1) + (xcd - r) * q) + off; }
        const int nig = WGM * nN, gid = wgid / nig, fm = gid * WGM, gsz = (nM - fm) < WGM ? (nM - fm) : WGM;
        u.pm = fm + ((wgid % nig) % gsz); u.pn = (wgid % nig) / gsz; u.pk = 0; return true;
    }
    __device__ __forceinline__ void a_ready(const Unit&) const {}
    __device__ __forceinline__ void done(const Unit&) const {}
};

__device__ __forceinline__ unsigned cvt_pk_bf16(float lo, float hi) { unsigned r; asm volatile("v_cvt_pk_bf16_f32 %0, %1, %2" : "=v"(r) : "v"(lo), "v"(hi)); return r; }
typedef float f32x2 __attribute__((ext_vector_type(2)));
struct SplitOrder {
    int nN, np, G, c, pm0;
    __host__ __device__ void init(int N, int nsl, int pm0_, int G_, int c_) { nN = N / BM; np = nN * nsl; G = G_; c = c_; pm0 = pm0_; }
    __host__ __device__ bool next(int i, Unit& u) const { const long L = (long)i * G + c; if (L >= np) return false; u.pm = pm0; u.pn = (int)(L % nN); u.pk = (int)(L / nN); return true; }
    __device__ __forceinline__ void a_ready(const Unit&) const {}
    __device__ __forceinline__ void done(const Unit&) const {}
};
template <class Epi, class Sched, bool ALIGN_EPI = false, bool SP2 = false>
__device__ __forceinline__ void gemm_phase(PG8_LAS unsigned char* lds, const Gemm g, const Sched& S, const Epi& E, const int wv) {
    const int tid = opaque_tid(wv), wid = __builtin_amdgcn_readfirstlane(tid >> 6), lane = tid & 63, wr = wid >> 2, wc = wid & 3, fr = lane & 15, fq = lane >> 4;
    const int K = g.K, nt = K / BK;
    unsigned voffA[2], voffB[2];
#pragma unroll
    for (int i = 0; i < 2; ++i) { int R, C; stage_rc(tid * 16 + i * 8192, R, C); const int Rb = Epi::PERM ? ((R & ~31) + perm32(R & 31)) : R;
        voffA[i] = (unsigned)(R * g.ld + C) * 2u; voffB[i] = (unsigned)(Rb * g.ld + C) * 2u; }
    const size_t kstep = (size_t)(BK * 2);
    const size_t hstep = (size_t)HALF * g.ld * 2;
    const size_t tstep = 2 * hstep;
    const unsigned ldsw = (unsigned)wid * 1024u;
    const int aoff = lds_byte(wr * 64 + fr, fq * 8), boff = lds_byte(wc * 32 + fr, fq * 8);
#define PG8_SA(b, h) (((b) * 2 + (h)) * HTB)
#define PG8_SB(b, h) ((4 + (b) * 2 + (h)) * HTB)
#define PG8_STAGE(bufoff, gbase, voff) do { _Pragma("unroll") for (int _i = 0; _i < 2; ++_i) \
        __builtin_amdgcn_global_load_lds((const unsigned*)((const char*)(gbase) + (voff)[_i]), (PG8_LAS unsigned*)(lds + (bufoff) + ldsw + _i * 8192), 16, 0, 0); } while (0)
#define PG8_LDA(dst, b, h) do { _Pragma("unroll") for (int m = 0; m < 4; ++m) _Pragma("unroll") for (int k = 0; k < 2; ++k) dst[m][k] = *(const PG8_LAS bf16x8*)(lds + PG8_SA(b, h) + aoff + m * 2048 + k * 1024); } while (0)
#define PG8_LDB(dst, b, h) do { _Pragma("unroll") for (int n = 0; n < 2; ++n) _Pragma("unroll") for (int k = 0; k < 2; ++k) dst[n][k] = *(const PG8_LAS bf16x8*)(lds + PG8_SB(b, h) + boff + n * 2048 + k * 1024); } while (0)
#define PG8_MMA(ai, bj, At, Bt) do { __builtin_amdgcn_s_setprio(1); _Pragma("unroll") for (int m = 0; m < 4; ++m) _Pragma("unroll") for (int n = 0; n < 2; ++n) _Pragma("unroll") for (int k = 0; k < 2; ++k) \
        acc[ai][bj][m][n] = __builtin_amdgcn_mfma_f32_16x16x32_bf16(Bt[n][k], At[m][k], acc[ai][bj][m][n], 0, 0, 0); __builtin_amdgcn_s_setprio(0); } while (0)
#define PG8_WAIT_V(n) asm volatile("s_waitcnt vmcnt(" #n ")" ::: "memory")
#define PG8_WAIT_L(n) asm volatile("s_waitcnt lgkmcnt(" #n ")" ::: "memory")
#define PG8_BAR __builtin_amdgcn_s_barrier()
#define PG8_SCHED __builtin_amdgcn_sched_barrier(0)
    Unit cur, nxt; int ui = 0;
    if (!S.next(0, cur)) return;
    f32x4 acc[2][2][4][2];
#pragma unroll
    for (int a = 0; a < 2; ++a)
#pragma unroll
        for (int b = 0; b < 2; ++b)
#pragma unroll
            for (int m = 0; m < 4; ++m)
#pragma unroll
                for (int n = 0; n < 2; ++n) acc[a][b][m][n] = (f32x4){0.f, 0.f, 0.f, 0.f};
    bf16x8 At[4][2], B0[2][2], B1[2][2];
    const char* cA = (const char*)g.A + (size_t)cur.pm * tstep + (size_t)cur.pk * K * 2; const char* cB = (const char*)g.Bt + (size_t)cur.pn * tstep + (size_t)cur.pk * K * 2;
    S.a_ready(cur);
    if constexpr (SP2) {
        PG8_STAGE(PG8_SB(0, 0), cB, voffB); PG8_STAGE(PG8_SB(0, 1), cB + hstep, voffB); PG8_STAGE(PG8_SA(0, 0), cA, voffA); PG8_STAGE(PG8_SA(0, 1), cA + hstep, voffA);
        if (wr == 1) PG8_BAR;
        PG8_WAIT_V(2); PG8_BAR;
        PG8_STAGE(PG8_SB(1, 0), cB + kstep, voffB); PG8_STAGE(PG8_SA(1, 0), cA + kstep, voffA); PG8_STAGE(PG8_SB(1, 1), cB + hstep + kstep, voffB);
        PG8_WAIT_V(6); PG8_BAR;
    } else {
        PG8_STAGE(PG8_SB(0, 0), cB, voffB); PG8_STAGE(PG8_SA(0, 0), cA, voffA); PG8_STAGE(PG8_SB(0, 1), cB + hstep, voffB); PG8_STAGE(PG8_SA(0, 1), cA + hstep, voffA);
        if (wr == 1) PG8_BAR;
        PG8_WAIT_V(4); PG8_BAR;
        PG8_STAGE(PG8_SB(1, 0), cB + kstep, voffB); PG8_STAGE(PG8_SA(1, 0), cA + kstep, voffA); PG8_STAGE(PG8_SB(1, 1), cB + hstep + kstep, voffB);
        PG8_WAIT_V(6); PG8_BAR;
    }
    for (;;) {
        const bool has_next = S.next(ui + 1, nxt);
        const char* nA = has_next ? (const char*)g.A + (size_t)nxt.pm * tstep + (size_t)nxt.pk * K * 2 : cA; const char* nB = has_next ? (const char*)g.Bt + (size_t)nxt.pn * tstep + (size_t)nxt.pk * K * 2 : cB;
        for (int t = 0; t < nt; t += 2) {
            const bool last = (t == nt - 2);
            const char* a1 = cA + (size_t)(t + 1) * kstep;
            const char* a2 = last ? nA : cA + (size_t)(t + 2) * kstep; const char* b2 = last ? nB : cB + (size_t)(t + 2) * kstep;
            const char* a3 = a2 + kstep; const char* b3 = b2 + kstep;
            if (last && has_next) S.a_ready(nxt);
            if constexpr (SP2) {
            PG8_LDB(B0, 0, 0); PG8_LDB(B1, 0, 1); PG8_SCHED; PG8_LDA(At, 0, 0); PG8_STAGE(PG8_SA(1, 1), a1 + hstep, voffA);
            PG8_WAIT_V(8); PG8_WAIT_L(0); PG8_BAR; PG8_MMA(0, 0, At, B0); PG8_MMA(0, 1, At, B1); PG8_BAR; PG8_SCHED;
            PG8_LDA(At, 0, 1); PG8_STAGE(PG8_SB(0, 0), b2, voffB); PG8_STAGE(PG8_SB(0, 1), b2 + hstep, voffB); PG8_STAGE(PG8_SA(0, 0), a2, voffA);
            PG8_WAIT_V(8); PG8_WAIT_L(0); PG8_BAR; PG8_MMA(1, 0, At, B0); PG8_MMA(1, 1, At, B1); PG8_BAR; PG8_SCHED;
            PG8_LDB(B0, 1, 0); PG8_LDB(B1, 1, 1); PG8_SCHED; PG8_LDA(At, 1, 0); PG8_STAGE(PG8_SA(0, 1), a2 + hstep, voffA);
            PG8_WAIT_V(8); PG8_WAIT_L(0); PG8_BAR; PG8_MMA(0, 0, At, B0); PG8_MMA(0, 1, At, B1); PG8_BAR; PG8_SCHED;
            PG8_LDA(At, 1, 1); PG8_STAGE(PG8_SB(1, 0), b3, voffB); PG8_STAGE(PG8_SB(1, 1), b3 + hstep, voffB); PG8_STAGE(PG8_SA(1, 0), a3, voffA);
            PG8_WAIT_V(8); PG8_WAIT_L(0); PG8_BAR; PG8_MMA(1, 0, At, B0); PG8_MMA(1, 1, At, B1); PG8_BAR; PG8_SCHED;
            } else {
            PG8_LDB(B0, 0, 0); PG8_SCHED; PG8_LDA(At, 0, 0); PG8_STAGE(PG8_SA(1, 1), a1 + hstep, voffA);
            PG8_WAIT_L(8); PG8_BAR; PG8_WAIT_L(0); PG8_MMA(0, 0, At, B0); PG8_BAR; PG8_SCHED;
            PG8_LDB(B1, 0, 1); PG8_STAGE(PG8_SB(0, 0), b2, voffB);
            PG8_BAR; PG8_WAIT_L(0); PG8_MMA(0, 1, At, B1); PG8_BAR;
            PG8_LDA(At, 0, 1); PG8_STAGE(PG8_SA(0, 0), a2, voffA);
            PG8_BAR; PG8_WAIT_L(0); PG8_MMA(1, 0, At, B0); PG8_BAR; PG8_SCHED;
            PG8_STAGE(PG8_SB(0, 1), b2 + hstep, voffB);
            PG8_WAIT_V(6); PG8_BAR; PG8_MMA(1, 1, At, B1); PG8_BAR;
            PG8_LDB(B0, 1, 0); PG8_SCHED; PG8_LDA(At, 1, 0); PG8_STAGE(PG8_SA(0, 1), a2 + hstep, voffA);
            PG8_WAIT_L(8); PG8_BAR; PG8_WAIT_L(0); PG8_MMA(0, 0, At, B0); PG8_BAR; PG8_SCHED;
            PG8_LDB(B1, 1, 1); PG8_STAGE(PG8_SB(1, 0), b3, voffB);
            PG8_BAR; PG8_WAIT_L(0); PG8_MMA(0, 1, At, B1); PG8_BAR;
            PG8_LDA(At, 1, 1); PG8_STAGE(PG8_SA(1, 0), a3, voffA);
            PG8_BAR; PG8_WAIT_L(0); PG8_MMA(1, 0, At, B0); PG8_BAR; PG8_SCHED;
            PG8_STAGE(PG8_SB(1, 1), b3 + hstep, voffB);
            PG8_WAIT_V(6); PG8_BAR; PG8_MMA(1, 1, At, B1); PG8_BAR;
            }
        }
        if constexpr (ALIGN_EPI) { if (wr == 0) PG8_BAR; }
        if constexpr (!Epi::AFTER_DRAIN) { E(acc, cur, wr, wc, fr, fq); S.done(cur); }
        if (!has_next) break;
#pragma unroll
        for (int a = 0; a < 2; ++a)
#pragma unroll
            for (int b = 0; b < 2; ++b)
#pragma unroll
                for (int m = 0; m < 4; ++m)
#pragma unroll
                    for (int n = 0; n < 2; ++n) acc[a][b][m][n] = (f32x4){0.f, 0.f, 0.f, 0.f};
        cur = nxt; cA = nA; cB = nB; ++ui;
        if constexpr (ALIGN_EPI) { if (wr == 1) PG8_BAR; }
    }
    PG8_WAIT_V(0);
    if constexpr (!ALIGN_EPI) { if (wr == 0) PG8_BAR; }
    PG8_BAR;
    if constexpr (Epi::AFTER_DRAIN) { E.fused(acc, cur, wr, wc, fr, fq, lds, wid, lane); S.done(cur); }
#undef PG8_SA
#undef PG8_SB
#undef PG8_STAGE
#undef PG8_LDA
#undef PG8_LDB
#undef PG8_MMA
#undef PG8_WAIT_V
#undef PG8_WAIT_L
#undef PG8_BAR
#undef PG8_SCHED
}
}

struct EpiIn {
    static constexpr bool PERM = true, AFTER_DRAIN = false;
    bf16_t* P; float* G; float* lfT; float* lfS; const float* bg; float* kp; float* vp; float* ks; float* vs; float* lfp; float* lfs;
    __device__ __forceinline__ void operator()(const f32x4 (&acc)[2][2][4][2], const pg8::Unit& u, int wr, int wc, int fr, int fq) const {
        const int pn = u.pn, row0 = u.pm * 256 + wr * 64 + fr;
        if (pn < 24) {
            float sc = 1.f; if (pn < 2) sc = QA_SCALE; else if (pn >= 12 && pn < 16) sc = QB_SCALE;
            const int col0 = pn * 256 + wc * 32 + 8 * fq;
            const bool kv = pn >= 16; const bool isv = pn >= 20; const int fcol0 = (pn - (isv ? 20 : 16)) * 256 + wc * 32 + 8 * fq;
#pragma unroll
            for (int ai = 0; ai < 2; ++ai)
#pragma unroll
                for (int m = 0; m < 4; ++m) { const int row = row0 + ai * 128 + m * 16;
#pragma unroll
                    for (int bj = 0; bj < 2; ++bj) { const f32x4 v0 = acc[ai][bj][m][0] * sc, v1 = acc[ai][bj][m][1] * sc;
                        u32x4 w; w.x = pkbf(v0[0], v0[1]); w.y = pkbf(v0[2], v0[3]); w.z = pkbf(v1[0], v1[1]); w.w = pkbf(v1[2], v1[3]);
                        *(GAS u32x4*)(P + (size_t)row * NP + col0 + bj * 128) = w;
                        if (kv && row < MT) { float* dst = row < MP ? (isv ? vp : kp) + (size_t)row * 1024 : (isv ? vs : ks) + (size_t)(row - MP) * 1024;
                            dst += fcol0 + bj * 128; *(GAS f32x4*)dst = v0; *(GAS f32x4*)(dst + 4) = v1; } } }
        } else if (wc == 0 && fq < 2) {
#pragma unroll
            for (int ai = 0; ai < 2; ++ai)
#pragma unroll
                for (int m = 0; m < 4; ++m) { const int row = row0 + ai * 128 + m * 16;
                    if (row < MT) {
#pragma unroll
                        for (int n = 0; n < 2; ++n)
#pragma unroll
                            for (int i = 0; i < 4; ++i) { const int c = 8 * fq + 4 * n + i; float gt = acc[ai][0][m][n][i] + ((const GAS float*)bg)[c];
                                if (c >= 4) gt = log_sigmoid(gt);
                                ((GAS float*)G)[(size_t)row * 16 + c] = gt;
                                if (c >= 8) { const int h = c - 8;
                                    if (row < MP) { ((GAS float*)lfp)[(size_t)row * 8 + h] = gt; ((GAS float*)lfT)[(size_t)((row >> 12) * 8 + h) * 4096 + (row & 4095)] = gt; }
                                    else { const int rs = row - MP; ((GAS float*)lfs)[(size_t)rs * 8 + h] = gt; ((GAS float*)lfS)[((rs >> 4) * 8 + h) * 16 + (rs & 15)] = gt; } } } } }
        }
    }
};
struct EpiRes {
    static constexpr bool PERM = true, AFTER_DRAIN = false;
    const bf16_t* R; bf16_t* Z;
    __device__ __forceinline__ void operator()(const f32x4 (&acc)[2][2][4][2], const pg8::Unit& u, int wr, int wc, int fr, int fq) const {
        const int row0 = u.pm * 256 + wr * 64 + fr, col0 = u.pn * 256 + wc * 32 + 8 * fq;
#pragma unroll
        for (int ai = 0; ai < 2; ++ai)
#pragma unroll
            for (int m = 0; m < 4; ++m) { const size_t off = (size_t)(row0 + ai * 128 + m * 16) * DM + col0;
#pragma unroll
                for (int bj = 0; bj < 2; ++bj) { const u32x4 r = *(const GAS u32x4*)(R + off + bj * 128);
                    f32x4 v0 = acc[ai][bj][m][0], v1 = acc[ai][bj][m][1];
                    v0[0] += ALPHA * bflo(r.x); v0[1] += ALPHA * bfhi(r.x); v0[2] += ALPHA * bflo(r.y); v0[3] += ALPHA * bfhi(r.y);
                    v1[0] += ALPHA * bflo(r.z); v1[1] += ALPHA * bfhi(r.z); v1[2] += ALPHA * bflo(r.w); v1[3] += ALPHA * bfhi(r.w);
                    u32x4 w; w.x = pkbf(v0[0], v0[1]); w.y = pkbf(v0[2], v0[3]); w.z = pkbf(v1[0], v1[1]); w.w = pkbf(v1[2], v1[3]);
                    *(GAS u32x4*)(Z + off + bj * 128) = w; } }
    }
};
struct EpiPart {
    static constexpr bool PERM = true, AFTER_DRAIN = false;
    float* part;
    __device__ __forceinline__ void operator()(const f32x4 (&acc)[2][2][4][2], const pg8::Unit& u, int wr, int wc, int fr, int fq) const {
        const int r0 = wr * 64 + fr, col0 = u.pn * 256 + wc * 32 + 8 * fq;
#pragma unroll
        for (int m = 0; m < 4; ++m) { float* dst = part + ((size_t)u.pk * MS + r0 + m * 16) * DM + col0;
#pragma unroll
            for (int bj = 0; bj < 2; ++bj) { *(GAS f32x4*)(dst + bj * 128) = acc[0][bj][m][0]; *(GAS f32x4*)(dst + bj * 128 + 4) = acc[0][bj][m][1]; } }
    }
};
struct EpiUp {
    static constexpr bool PERM = true, AFTER_DRAIN = false;
    bf16_t* H;
    __device__ __forceinline__ void operator()(const f32x4 (&acc)[2][2][4][2], const pg8::Unit& u, int wr, int wc, int fr, int fq) const {
        const int row0 = u.pm * 256 + wr * 64 + fr, col0 = u.pn * 256 + wc * 32 + 8 * fq;
#pragma unroll
        for (int ai = 0; ai < 2; ++ai)
#pragma unroll
            for (int m = 0; m < 4; ++m) { const size_t off = (size_t)(row0 + ai * 128 + m * 16) * DFF + col0;
#pragma unroll
                for (int bj = 0; bj < 2; ++bj) { f32x4 v0 = acc[ai][bj][m][0], v1 = acc[ai][bj][m][1];
#pragma unroll
                    for (int i = 0; i < 4; ++i) { const float a = fmaxf(v0[i], 0.f), b = fmaxf(v1[i], 0.f); v0[i] = a * a; v1[i] = b * b; }
                    u32x4 w; w.x = pkbf(v0[0], v0[1]); w.y = pkbf(v0[2], v0[3]); w.z = pkbf(v1[0], v1[1]); w.w = pkbf(v1[2], v1[3]);
                    *(GAS u32x4*)(H + off + bj * 128) = w; } }
    }
};

#define LDS_WAIT() asm volatile("s_waitcnt lgkmcnt(0)" ::: "memory")
__device__ __forceinline__ float scan_sum64(float x, int lane) {
#pragma unroll
    for (int o = 1; o < 64; o <<= 1) { const float y = __shfl_up(x, o); if (lane >= o) x += y; }
    return x;
}
__device__ __forceinline__ float scan_max64(float x, int lane) {
#pragma unroll
    for (int o = 1; o < 64; o <<= 1) { const float y = __shfl_up(x, o); if (lane >= o) x = fmaxf(x, y); }
    return x;
}
__device__ __forceinline__ float wave_sum64(float v) {
#pragma unroll
    for (int o = 1; o < 64; o <<= 1) v += __shfl_xor(v, o);
    return v;
}

__device__ __forceinline__ float xsum32(float x) { auto rr = __builtin_amdgcn_permlane32_swap(__float_as_uint(x), __float_as_uint(x), false, false); return __uint_as_float(rr[0]) + __uint_as_float(rr[1]); }
__device__ __forceinline__ float xmax32(float x) { auto rr = __builtin_amdgcn_permlane32_swap(__float_as_uint(x), __float_as_uint(x), false, false); return fmaxf(__uint_as_float(rr[0]), __uint_as_float(rr[1])); }
__device__ __forceinline__ float dpp_f(float x, const int ctrl_sel) {
    const int v = __float_as_int(x); int r;
    if (ctrl_sel == 0) r = __builtin_amdgcn_update_dpp(v, v, 0xB1, 0xF, 0xF, false);
    else if (ctrl_sel == 1) r = __builtin_amdgcn_update_dpp(v, v, 0x4E, 0xF, 0xF, false);
    else r = __builtin_amdgcn_update_dpp(v, v, 0x141, 0xF, 0xF, false);
    return __int_as_float(r);
}
__device__ __forceinline__ float bperm_f(int srclane, float x) { return __int_as_float(__builtin_amdgcn_ds_bpermute(srclane << 2, __float_as_int(x))); }
__device__ __forceinline__ float scan_sum64l(float x, int lane) {
#pragma unroll
    for (int o = 1; o < 64; o <<= 1) { const float y = bperm_f(lane - o, x); if (lane >= o) x += y; }
    return x;
}
__device__ __forceinline__ float scan_max64l(float x, int lane) {
#pragma unroll
    for (int o = 1; o < 64; o <<= 1) { const float y = bperm_f(lane - o, x); if (lane >= o) x = fmaxf(x, y); }
    return x;
}
__device__ __forceinline__ f32x16 mfma32(bf16x8 a, bf16x8 b, f32x16 c) { return __builtin_amdgcn_mfma_f32_32x32x16_bf16(a, b, c, 0, 0, 0); }
__device__ __forceinline__ f32x4 mfma16(bf16x8 a, bf16x8 b, f32x4 c) { return __builtin_amdgcn_mfma_f32_16x16x32_bf16(a, b, c, 0, 0, 0); }
__device__ __forceinline__ float fexp2(float x) { return __builtin_amdgcn_exp2f(x); }

__device__ __forceinline__ void transpose_item(const float* W, int Nsrc, int K, bf16_t* WT, LAS float* scr, int item, int nblk, int lane, bool inmap) {
    const int kb = item / nblk, nb = item % nblk, k0 = 64 * kb, n0 = 32 * nb;
    const int nd = n0 + (lane & 31); int sc = nd;
    if (inmap) sc = nd < 3072 ? nd : (nd < 6144 ? nd + 8 : (nd < 6152 ? nd - 3072 : (nd < 6160 ? nd : -1)));
    float wv_[32];
    const GAS float* wp = (const GAS float*)W + (size_t)(k0 + (lane >> 5)) * Nsrc + (sc >= 0 ? sc : 0);
#pragma unroll
    for (int i = 0; i < 32; ++i) wv_[i] = wp[(size_t)(2 * i) * Nsrc];
#pragma unroll
    for (int i = 0; i < 32; ++i) scr[(2 * i + (lane >> 5)) * 33 + (lane & 31)] = sc >= 0 ? wv_[i] : 0.f;
    LDS_WAIT();
    const int c = lane & 7;
#pragma unroll
    for (int j = 0; j < 4; ++j) { const int n = (lane >> 3) + 8 * j; const LAS float* s = scr + (8 * c) * 33 + n;
        u32x4 o; o.x = pkbf(s[0 * 33], s[1 * 33]); o.y = pkbf(s[2 * 33], s[3 * 33]); o.z = pkbf(s[4 * 33], s[5 * 33]); o.w = pkbf(s[6 * 33], s[7 * 33]);
        *(GAS u32x4*)(WT + (size_t)(n0 + n) * K + k0 + 8 * c) = o; }
    LDS_WAIT();
}
struct Args { const float* in[18]; float* out; unsigned char* ws; int ph_lo, ph_hi; };

__device__ __forceinline__ void convert_weights(const Args& a, int layer, LAS float* scr, int gw, int NGW, int lane, int it_end = 1 << 30) {
    unsigned char* ws = as_global(a.ws);
    const float* w_in = as_global(a.in[8]) + (size_t)layer * DM * NINSRC; const float* w_out = as_global(a.in[11]) + (size_t)layer * DM * DM;
    const float* w_up = as_global(a.in[14]) + (size_t)layer * DM * DFF; const float* w_dn = as_global(a.in[15]) + (size_t)layer * DFF * DM;
    constexpr int I_IN = 32 * 200, I_OUT = 32 * 64, I_UP = 32 * 256, I_DN = 128 * 64;
    const int it_stop = it_end < I_IN + I_OUT + I_UP + I_DN ? it_end : I_IN + I_OUT + I_UP + I_DN;
    for (int it = gw; it < it_stop; it += NGW) {
        int r = it;
        if (r < I_IN) { transpose_item(w_in, NINSRC, DM, (bf16_t*)(ws + WS_WIN), scr, r, 200, lane, true); continue; } r -= I_IN;
        if (r < I_OUT) { transpose_item(w_out, DM, DM, (bf16_t*)(ws + (layer ? WS_WOUT2 : WS_WOUT)), scr, r, 64, lane, false); continue; } r -= I_OUT;
        if (r < I_UP) { transpose_item(w_up, DFF, DM, (bf16_t*)(ws + (layer ? WS_WUP2 : WS_WUP)), scr, r, 256, lane, false); continue; } r -= I_UP;
        transpose_item(w_dn, DM, DFF, (bf16_t*)(ws + WS_WDN), scr, r, 64, lane, false);
    }
}
__device__ __forceinline__ void convert_x(const Args& a, int gw, int NGW, int lane) {
    bf16_t* XB = (bf16_t*)(as_global(a.ws) + WS_XB);
    f32x4 xr[8];
#define CX_LOAD(row_) do { const GAS f32x4* x_ = (const GAS f32x4*)((row_) < MP ? as_global(a.in[0]) + (size_t)(row_) * DM : as_global(a.in[1]) + (size_t)((row_) - MP) * DM) + lane; _Pragma("unroll") for (int j = 0; j < 8; ++j) xr[j] = x_[64 * j]; } while (0)
    if (gw < MT) CX_LOAD(gw);
    for (int row = gw; row < MPAD; row += NGW) {
        GAS u32x2* o = (GAS u32x2*)(XB + (size_t)row * DM) + lane;
        if (row < MT) { u32x2 w[8];
#pragma unroll
            for (int j = 0; j < 8; ++j) { w[j].x = pkbf(xr[j][0], xr[j][1]); w[j].y = pkbf(xr[j][2], xr[j][3]); }
            if (row + NGW < MT) CX_LOAD(row + NGW);
#pragma unroll
            for (int j = 0; j < 8; ++j) o[64 * j] = w[j]; }
        else {
#pragma unroll
            for (int j = 0; j < 8; ++j) o[64 * j] = (u32x2){0u, 0u}; }
    }
#undef CX_LOAD
}
__device__ __forceinline__ void ln_phase(const bf16_t* Z, const bf16_t* RES, const float* part, int nsl, const float* g, const float* b, bf16_t* XB, float* outp, float* outs, int gw, int NGW, int lane,
                                         LAS float* scr, int wave, int bid, int nblk) {
    f32x4 gv[8], bv[8];
#pragma unroll
    for (int j = 0; j < 8; ++j) { gv[j] = ((const GAS f32x4*)g)[lane + 64 * j]; bv[j] = ((const GAS f32x4*)b)[lane + 64 * j]; }
#define LN_FINISH(v, row) do { float s = 0.f; \
        _Pragma("unroll") for (int j = 0; j < 8; ++j) s += (v[j][0] + v[j][1]) + (v[j][2] + v[j][3]); \
        const float mean = wave_sum64(s) * (1.f / DM); float s2 = 0.f; \
        _Pragma("unroll") for (int j = 0; j < 8; ++j) { v[j] = v[j] - mean; s2 += (v[j][0] * v[j][0] + v[j][1] * v[j][1]) + (v[j][2] * v[j][2] + v[j][3] * v[j][3]); } \
        const float rstd = 1.0f / sqrtf(wave_sum64(s2) * (1.f / DM) + LN_EPS); \
        _Pragma("unroll") for (int j = 0; j < 8; ++j) v[j] = v[j] * rstd * gv[j] + bv[j]; \
        if (XB) { GAS u32x2* o = (GAS u32x2*)(XB + (size_t)(row) * DM) + lane; \
            _Pragma("unroll") for (int j = 0; j < 8; ++j) { u32x2 w; w.x = pkbf(v[j][0], v[j][1]); w.y = pkbf(v[j][2], v[j][3]); o[64 * j] = w; } } \
        if (outp) { GAS f32x4* o = (GAS f32x4*)((row) < MP ? outp + (size_t)(row) * DM : outs + (size_t)((row) - MP) * DM) + lane; \
            _Pragma("unroll") for (int j = 0; j < 8; ++j) o[64 * j] = v[j]; } } while (0)
    for (int r = bid; r < MS; r += nblk) {
        f32x4 acc[8];
#pragma unroll
        for (int j = 0; j < 8; ++j) acc[j] = (f32x4){0.f, 0.f, 0.f, 0.f};
        for (int sl = wave; sl < nsl; sl += 8) { const GAS f32x4* p = (const GAS f32x4*)(part + ((size_t)sl * MS + r) * DM) + lane;
#pragma unroll
            for (int j = 0; j < 8; ++j) acc[j] += p[64 * j]; }
#pragma unroll
        for (int j = 0; j < 8; ++j) *(LAS f32x4*)(scr + wave * 2048 + (lane + 64 * j) * 4) = acc[j];
        __syncthreads();
        if (wave == 0) { const GAS u32x2* z_ = (const GAS u32x2*)(RES + (size_t)(MP + r) * DM) + lane; f32x4 v[8];
#pragma unroll
            for (int j = 0; j < 8; ++j) { const u32x2 w = z_[64 * j]; v[j] = (f32x4){ALPHA * bflo(w.x), ALPHA * bfhi(w.x), ALPHA * bflo(w.y), ALPHA * bfhi(w.y)}; }
#pragma unroll
            for (int w8 = 0; w8 < 8; ++w8)
#pragma unroll
                for (int j = 0; j < 8; ++j) v[j] += *(LAS const f32x4*)(scr + w8 * 2048 + (lane + 64 * j) * 4);
            LN_FINISH(v, MP + r); }
        __syncthreads();
    }
    u32x2 zr[8];
#define LN_LOAD(row_) do { const GAS u32x2* z_ = (const GAS u32x2*)(Z + (size_t)(row_) * DM) + lane; _Pragma("unroll") for (int j = 0; j < 8; ++j) zr[j] = z_[64 * j]; } while (0)
    if (gw < MP) LN_LOAD(gw);
    for (int row = gw; row < MP; row += NGW) {
        f32x4 v[8];
#pragma unroll
        for (int j = 0; j < 8; ++j) v[j] = (f32x4){bflo(zr[j].x), bfhi(zr[j].x), bflo(zr[j].y), bfhi(zr[j].y)};
        if (row + NGW < MP) LN_LOAD(row + NGW);
        LN_FINISH(v, row);
    }
#undef LN_LOAD
#undef LN_FINISH
}

constexpr int AT_K = 0, AT_V = 34816, AT_NF = 75776, AT_SCR = 92160, AVP = 320;
__device__ __forceinline__ void fox_prompt_unit(LAS char* L, const bf16_t* P, const float* lfT, bf16_t* MIX, int b, int h, int qb, const int wv) {
    const int tid = opaque_tid(wv), lane = tid & 63, wid = __builtin_amdgcn_readfirstlane(tid >> 6), r32 = lane & 31, hi = lane >> 5, i16 = lane & 15, cb = (lane >> 4) & 1;
    const int qend = 256 * (qb + 1), NT = 4 * (qb + 1);
    const size_t rowb = (size_t)b * SEQ;
    LAS float* nfk = (LAS float*)(L + AT_NF); LAS float* scr = (LAS float*)(L + AT_SCR);
    {
        float v[8]; const bool act = 8 * tid < qend;
        if (act) { const GAS f32x4* src = (const GAS f32x4*)(lfT + (size_t)(b * 8 + h) * 4096 + 8 * tid); const f32x4 a = src[0], c = src[1];
            v[0] = a[0]; v[1] = a[1]; v[2] = a[2]; v[3] = a[3]; v[4] = c[0]; v[5] = c[1]; v[6] = c[2]; v[7] = c[3]; }
        else {
#pragma unroll
            for (int i = 0; i < 8; ++i) v[i] = 0.f; }
#pragma unroll
        for (int i = 1; i < 8; ++i) v[i] += v[i - 1];
        const float tot = v[7]; const float x = scan_sum64(tot, lane);
        if (lane == 63) scr[wid] = x;
        __syncthreads();
        float off = 0.f;
        for (int w = 0; w < wid; ++w) off += scr[w];
        const float base = off + x - tot;
        if (act) {
#pragma unroll
            for (int i = 0; i < 8; ++i) nfk[8 * tid + i] = -(base + v[i]) * LOG2E; }
    }
    const bf16_t* Kg = P + rowb * NP + PC_KB + h * 128; const bf16_t* Vg = P + rowb * NP + PC_VB + h * 128;
    u32x4 kr[2], vr[2];
#define AT_LOAD(t) do { _Pragma("unroll") for (int i_ = 0; i_ < 2; ++i_) { const int c_ = tid + 512 * i_, row_ = c_ >> 4, ch_ = c_ & 15; \
        kr[i_] = *(const GAS u32x4*)(Kg + (size_t)(64 * (t) + row_) * NP + ch_ * 8); vr[i_] = *(const GAS u32x4*)(Vg + (size_t)(64 * (t) + row_) * NP + ch_ * 8); } } while (0)
#define AT_STORE(buf) do { _Pragma("unroll") for (int i_ = 0; i_ < 2; ++i_) { const int c_ = tid + 512 * i_, row_ = c_ >> 4, ch_ = c_ & 15; \
        *(LAS u32x4*)(L + AT_K + (buf) * 17408 + row_ * 272 + ch_ * 16) = kr[i_]; *(LAS u32x4*)(L + AT_V + (buf) * 20480 + row_ * AVP + ch_ * 16) = vr[i_]; } } while (0)
    bf16x8 qf[8];
    { const bf16_t* Qg = P + (rowb + 256 * qb + 32 * wid + r32) * NP + PC_QB + h * 128 + 8 * hi;
#pragma unroll
        for (int kk = 0; kk < 8; ++kk) qf[kk] = *(const GAS bf16x8*)(Qg + 16 * kk); }
    f32x16 o[4];
#pragma unroll
    for (int d = 0; d < 4; ++d)
#pragma unroll
        for (int r = 0; r < 16; ++r) o[d][r] = 0.f;
    float m = -INFINITY, l = 0.f;
    AT_LOAD(0); AT_STORE(0);
    __syncthreads();
    for (int t = 0; t < NT; ++t) {
        if (t + 1 < NT) AT_LOAD(t + 1);
        const int jb = t - (NT - 4);
        if (!(jb >= 0 && 64 * jb > 32 * wid + 31)) {
            LAS const char* Kb = L + AT_K + (t & 1) * 17408; LAS const char* Vb = L + AT_V + (t & 1) * 20480;
            LAS const float* nf = nfk + 64 * t;
            f32x16 s0, s1;
#pragma unroll
            for (int g = 0; g < 4; ++g) { const f32x4 a = *(LAS const f32x4*)(nf + 8 * g + 4 * hi), c = *(LAS const f32x4*)(nf + 32 + 8 * g + 4 * hi);
                s0[4 * g] = a[0]; s0[4 * g + 1] = a[1]; s0[4 * g + 2] = a[2]; s0[4 * g + 3] = a[3]; s1[4 * g] = c[0]; s1[4 * g + 1] = c[1]; s1[4 * g + 2] = c[2]; s1[4 * g + 3] = c[3]; }
            {
                bf16x8 ka[16];
#pragma unroll
                for (int kk = 0; kk < 8; ++kk) { ka[2 * kk] = *(LAS const bf16x8*)(Kb + r32 * 272 + kk * 32 + hi * 16); ka[2 * kk + 1] = *(LAS const bf16x8*)(Kb + (32 + r32) * 272 + kk * 32 + hi * 16); }
                __builtin_amdgcn_sched_barrier(0);
#pragma unroll
                for (int kk = 0; kk < 8; ++kk) { s0 = mfma32(ka[2 * kk], qf[kk], s0); s1 = mfma32(ka[2 * kk + 1], qf[kk], s1); }
                __builtin_amdgcn_sched_barrier(0);
            }
            if (jb >= 0 && 64 * jb + 63 > 32 * wid) { const int q = 32 * wid + r32;
#pragma unroll
                for (int r = 0; r < 16; ++r) { const int kv = 64 * jb + crow(r, hi); if (kv > q) s0[r] = -INFINITY; if (kv + 32 > q) s1[r] = -INFINITY; } }
            float mx = fmaxf(s0[0], s1[0]);
#pragma unroll
            for (int r = 1; r < 16; ++r) mx = fmaxf(mx, fmaxf(s0[r], s1[r]));
            mx = xmax32(mx);
            const float mn = fmaxf(m, mx), alpha = fexp2(m - mn); m = mn;
            float ls = 0.f;
#pragma unroll
            for (int r = 0; r < 16; ++r) { s0[r] = fexp2(s0[r] - mn); s1[r] = fexp2(s1[r] - mn); ls += s0[r] + s1[r]; }
            l = l * alpha + ls;
#pragma unroll
            for (int d = 0; d < 4; ++d)
#pragma unroll
                for (int r = 0; r < 16; ++r) o[d][r] *= alpha;
            bf16x8 pf[4];
            { u32x4 w;
              w.x = pkbf(s0[0], s0[1]); w.y = pkbf(s0[2], s0[3]); w.z = pkbf(s0[4], s0[5]); w.w = pkbf(s0[6], s0[7]); pf[0] = __builtin_bit_cast(bf16x8, w);
              w.x = pkbf(s0[8], s0[9]); w.y = pkbf(s0[10], s0[11]); w.z = pkbf(s0[12], s0[13]); w.w = pkbf(s0[14], s0[15]); pf[1] = __builtin_bit_cast(bf16x8, w);
              w.x = pkbf(s1[0], s1[1]); w.y = pkbf(s1[2], s1[3]); w.z = pkbf(s1[4], s1[5]); w.w = pkbf(s1[6], s1[7]); pf[2] = __builtin_bit_cast(bf16x8, w);
              w.x = pkbf(s1[8], s1[9]); w.y = pkbf(s1[10], s1[11]); w.z = pkbf(s1[12], s1[13]); w.w = pkbf(s1[14], s1[15]); pf[3] = __builtin_bit_cast(bf16x8, w); }
#pragma unroll
            for (int ss = 0; ss < 4; ++ss)
#pragma unroll
                for (int d = 0; d < 4; ++d) { LAS const char* vp = Vb + (16 * ss + 4 * hi + (i16 >> 2)) * AVP + (32 * d + 16 * cb + 4 * (i16 & 3)) * 2;
                    o[d] = mfma32(cat44(lds_tr(vp), lds_tr(vp + 8 * AVP)), pf[ss], o[d]); }
        }
        if (t + 1 < NT) AT_STORE((t + 1) & 1);
        __syncthreads();
    }
    l = xsum32(l);
    const float inv = 1.0f / l;
    bf16_t* Og = MIX + (rowb + 256 * qb + 32 * wid + r32) * DM + 1024 + h * 128 + 4 * hi;
#pragma unroll
    for (int d = 0; d < 4; ++d)
#pragma unroll
        for (int g = 0; g < 4; ++g) { u32x2 w; w.x = pkbf(o[d][4 * g] * inv, o[d][4 * g + 1] * inv); w.y = pkbf(o[d][4 * g + 2] * inv, o[d][4 * g + 3] * inv);
            *(GAS u32x2*)(Og + 32 * d + 8 * g) = w; }
#undef AT_LOAD
#undef AT_STORE
}

constexpr int FS_Q = 0, FS_NF = 8448, FS_SC = 12672, FS_TL = 80512, FS_LI = 97408, FS_SCP = 1060;
__device__ __forceinline__ void fox_sample_item(LAS char* L, const bf16_t* P, const float* lfS, const float* ck, const float* cv, const float* clf, bf16_t* MIX, int sb, int h, const int wv) {
    const int tid = opaque_tid(wv), lane = tid & 63, wid = __builtin_amdgcn_readfirstlane(tid >> 6);
    LAS float* QF = (LAS float*)(L + FS_Q); LAS float* NF = (LAS float*)(L + FS_NF); LAS float* SC = (LAS float*)(L + FS_SC); LAS float* TL = (LAS float*)(L + FS_TL); LAS float* LI = (LAS float*)(L + FS_LI);
    const size_t srow = (size_t)MP + sb * 16;
    for (int e = tid; e < 16 * 128; e += 512) { const int q = e >> 7, d = e & 127; QF[q * 132 + d] = bf2f(((const GAS bf16_t*)P)[(srow + q) * NP + PC_QB + h * 128 + d]); }
    if (wid == 0) {
        float v[17];
#pragma unroll
        for (int i = 0; i < 17; ++i) { const int idx = 17 * lane + i; float x = 0.f;
            if (idx < PAST) x = ((const GAS float*)clf)[((size_t)sb * PAST + idx) * 8 + h]; else if (idx < PAST + 16) x = ((const GAS float*)lfS)[(sb * 8 + h) * 16 + idx - PAST];
            v[i] = x; }
#pragma unroll
        for (int i = 1; i < 17; ++i) v[i] += v[i - 1];
        const float tot = v[16], x = scan_sum64(tot, lane), base = x - tot;
#pragma unroll
        for (int i = 0; i < 17; ++i) { const int idx = 17 * lane + i; if (idx < 1056) NF[idx] = -(base + v[i]) * LOG2E; }
    }
    f32x4 ta[2], tb2[2], tc[2];
#define FS_LOAD(R, src, pcol, tile) do { _Pragma("unroll") for (int i_ = 0; i_ < 2; ++i_) { const int c_ = tid + 512 * i_, row_ = c_ >> 5, ch_ = c_ & 31, kv_ = 32 * (tile) + row_; \
        if (kv_ < PAST) R[i_] = *(const GAS f32x4*)((src) + (((size_t)sb * PAST + kv_) * 8 + h) * 128 + 4 * ch_); \
        else if (kv_ < PAST + 16) { const u32x2 w_ = *(const GAS u32x2*)(P + (srow + kv_ - PAST) * NP + (pcol) + h * 128 + 4 * ch_); R[i_] = (f32x4){bflo(w_.x), bfhi(w_.x), bflo(w_.y), bfhi(w_.y)}; } \
        else R[i_] = (f32x4){0.f, 0.f, 0.f, 0.f}; } } while (0)
#define FS_STORE(R) do { _Pragma("unroll") for (int i_ = 0; i_ < 2; ++i_) { const int c_ = tid + 512 * i_, row_ = c_ >> 5, ch_ = c_ & 31; *(LAS f32x4*)(TL + row_ * 132 + 4 * ch_) = R[i_]; } } while (0)
    FS_LOAD(ta, ck, PC_KB, 0); FS_LOAD(tb2, ck, PC_KB, 1); FS_LOAD(tc, ck, PC_KB, 2);
    __syncthreads();
    {
        const int q = tid & 15, kl = tid >> 4;
#define FS_SC_STEP(R, tile_) do { const int tile = (tile_); FS_STORE(R); __syncthreads(); if (tile + 3 < 33) FS_LOAD(R, ck, PC_KB, tile + 3); \
            float acc = 0.f; \
            _Pragma("unroll 8") for (int i = 0; i < 32; ++i) { const f32x4 a = *(LAS const f32x4*)(QF + q * 132 + 4 * i), k = *(LAS const f32x4*)(TL + kl * 132 + 4 * i); acc += a[0] * k[0] + a[1] * k[1] + a[2] * k[2] + a[3] * k[3]; } \
            const int kv = 32 * tile + kl; float s = acc + NF[kv]; \
            if (kv >= PAST + 16 || (kv >= PAST && kv - PAST > q)) s = -INFINITY; \
            SC[q * FS_SCP + kv] = s; __syncthreads(); } while (0)
        for (int t3 = 0; t3 < 33; t3 += 3) { FS_SC_STEP(ta, t3); FS_SC_STEP(tb2, t3 + 1); FS_SC_STEP(tc, t3 + 2); }
#undef FS_SC_STEP
    }
    FS_LOAD(ta, cv, PC_VB, 0); FS_LOAD(tb2, cv, PC_VB, 1); FS_LOAD(tc, cv, PC_VB, 2);
    {
#pragma unroll
        for (int qq = 0; qq < 2; ++qq) { const int q = 2 * wid + qq; float mx = -INFINITY;
            for (int kv = lane; kv < 1056; kv += 64) mx = fmaxf(mx, SC[q * FS_SCP + kv]);
#pragma unroll
            for (int o = 1; o < 64; o <<= 1) mx = fmaxf(mx, __shfl_xor(mx, o));
            float sm = 0.f;
            for (int kv = lane; kv < 1056; kv += 64) { const float p = fexp2(SC[q * FS_SCP + kv] - mx); SC[q * FS_SCP + kv] = p; sm += p; }
            sm = wave_sum64(sm);
            if (lane == 0) LI[q] = 1.0f / sm; }
    }
    __syncthreads();
    {
        const int d = tid & 127, qg = tid >> 7; float o0 = 0.f, o1 = 0.f, o2 = 0.f, o3 = 0.f;
#define FS_PV_STEP(R, tile_) do { const int tile = (tile_); FS_STORE(R); __syncthreads(); if (tile + 3 < 33) FS_LOAD(R, cv, PC_VB, tile + 3); \
            _Pragma("unroll 8") for (int kl = 0; kl < 32; ++kl) { const float v = TL[kl * 132 + d]; const int kv = 32 * tile + kl; LAS const float* sp = SC + (4 * qg) * FS_SCP + kv; \
                o0 += sp[0] * v; o1 += sp[FS_SCP] * v; o2 += sp[2 * FS_SCP] * v; o3 += sp[3 * FS_SCP] * v; } \
            __syncthreads(); } while (0)
        for (int t3 = 0; t3 < 33; t3 += 3) { FS_PV_STEP(ta, t3); FS_PV_STEP(tb2, t3 + 1); FS_PV_STEP(tc, t3 + 2); }
#undef FS_PV_STEP
        GAS bf16_t* Og = (GAS bf16_t*)MIX + (srow + 4 * qg) * DM + 1024 + h * 128 + d;
        Og[0] = (bf16_t)(pkbf(o0 * LI[4 * qg], 0.f) & 0xffffu); Og[DM] = (bf16_t)(pkbf(o1 * LI[4 * qg + 1], 0.f) & 0xffffu);
        Og[2 * DM] = (bf16_t)(pkbf(o2 * LI[4 * qg + 2], 0.f) & 0xffffu); Og[3 * DM] = (bf16_t)(pkbf(o3 * LI[4 * qg + 3], 0.f) & 0xffffu);
    }
#undef FS_LOAD
#undef FS_STORE
}

constexpr int ML_Q = 0, ML_K = 17408, ML_KT = 34816, ML_V = 55296, ML_S = 92160, ML_FA = 101376, ML_N = 102656, ML_SSQ = 103168, ML_GH = 105216, ML_GP = 106240, ML_NP = 139008, ML_RS = 143104;
constexpr int KTP = 320, VP = 576;
__device__ __forceinline__ void mlstm_item(LAS char* L, const bf16_t* P, const float* G, bf16_t* MIX, const float* ghead, size_t row0, int hh, int nch, int Lv,
                                           const float* c0, const float* n0, const float* m0, float* cout, float* nout, float* mout, const int wv) {
    const int tid = opaque_tid(wv), lane = tid & 63, wid = __builtin_amdgcn_readfirstlane(tid >> 6), r32 = lane & 31, hi = lane >> 5, i16 = lane & 15, cb = (lane >> 4) & 1;
    LAS float* FA = (LAS float*)(L + ML_FA); LAS float* ROWT = FA, *COLS = FA + 64, *WINT = FA + 128, *EMT = FA + 192, *NQ = FA + 256;
    LAS float* NST = (LAS float*)(L + ML_N); LAS float* SSQ = (LAS float*)(L + ML_SSQ); LAS float* RS = (LAS float*)(L + ML_RS);
    f32x16 cT[4];
#pragma unroll
    for (int kb = 0; kb < 4; ++kb)
#pragma unroll
        for (int r = 0; r < 16; ++r) cT[kb][r] = c0 ? ((const GAS float*)c0)[(size_t)(32 * wid + r32) * 128 + 32 * kb + crow(r, hi)] : 0.f;
    if (tid < 128) NST[tid] = n0 ? ((const GAS float*)n0)[tid] : 0.f;
    float m = m0 ? ((const GAS float*)m0)[0] : 0.f;
    LAS float* GH = (LAS float*)(L + ML_GH);
    if (tid < 256) GH[tid] = ((const GAS float*)ghead)[hh * 256 + tid];
    u32x4 qr[2], kr[2], vr[4]; float igr;
#define ML_LOADQK(j) do { const size_t rb_ = row0 + 64 * (size_t)(j); \
        _Pragma("unroll") for (int i_ = 0; i_ < 2; ++i_) { const int c_ = tl_ + 512 * i_, row_ = c_ >> 4, ch_ = c_ & 15; \
            if (row_ < Lv) { qr[i_] = *(const GAS u32x4*)(P + (rb_ + row_) * NP + PC_QA + hh * 128 + ch_ * 8); kr[i_] = *(const GAS u32x4*)(P + (rb_ + row_) * NP + PC_KA + hh * 128 + ch_ * 8); } \
            else { qr[i_] = (u32x4){0u, 0u, 0u, 0u}; kr[i_] = (u32x4){0u, 0u, 0u, 0u}; } } \
        if ((tl_ & 63) < Lv) { igr = ((const GAS float*)G)[(rb_ + (tl_ & 63)) * 16 + hh]; } else { igr = -INFINITY; } } while (0)
#define ML_LOADV(j) do { const size_t rb_ = row0 + 64 * (size_t)(j); \
        _Pragma("unroll") for (int i_ = 0; i_ < 4; ++i_) { const int c_ = tl_ + 512 * i_, row_ = c_ >> 5, ch_ = c_ & 31; \
            if (row_ < Lv) vr[i_] = *(const GAS u32x4*)(P + (rb_ + row_) * NP + PC_VA + hh * 256 + ch_ * 8); else vr[i_] = (u32x4){0u, 0u, 0u, 0u}; } } while (0)
    { int tl_ = tid; ML_LOADQK(0); ML_LOADV(0); }
    LAS float* BCS = (LAS float*)(L + ML_GP); LAS float* PMX = BCS + 4096; LAS float* NPART = (LAS float*)(L + ML_NP);
    for (int jj = wid; jj < nch; jj += 8) {
        float ig0 = -INFINITY, lf0 = 0.f;
        if (lane < Lv) { ig0 = ((const GAS float*)G)[(row0 + 64 * (size_t)jj + lane) * 16 + hh]; lf0 = ((const GAS float*)G)[(row0 + 64 * (size_t)jj + lane) * 16 + 4 + hh]; }
        const float bc = scan_sum64l(lf0, lane), pmx = scan_max64l(ig0 - bc, lane);
        BCS[jj * 64 + lane] = bc; PMX[jj * 64 + lane] = pmx;
    }
    __syncthreads();
    for (int j = 0; j < nch; ++j) {
        int tl_ = tid; asm volatile("" : "+v"(tl_));
        const int r32j = tl_ & 31, hij = (tl_ >> 5) & 1;
        const int lj = tl_ & 63;
        const float bcs = BCS[j * 64 + lj], pm = PMX[j * 64 + lj], u = igr - bcs;
        const float mt = bcs + fmaxf(m, pm);
        const float b63 = __int_as_float(__builtin_amdgcn_readlane(__float_as_int(bcs), 63)), mnew = __int_as_float(__builtin_amdgcn_readlane(__float_as_int(mt), 63));
        const float av = __expf(b63 + u - mnew), decay = __expf(b63 + m - mnew);
        if (wid == 0) { ROWT[lane] = bcs - mt; COLS[lane] = u; WINT[lane] = __expf(bcs + m - mt); EMT[lane] = __expf(-mt); }
        m = mnew;
#pragma unroll
        for (int i = 0; i < 2; ++i) { const int c = tid + 512 * i, row = c >> 4, ch = c & 15;
            *(LAS u32x4*)(L + ML_Q + row * 272 + ch * 16) = qr[i]; *(LAS u32x4*)(L + ML_K + row * 272 + ch * 16) = kr[i];
            const float as = bperm_f(row, av); u32x4 w;
            w.x = pkbf(bflo(kr[i].x) * as, bfhi(kr[i].x) * as); w.y = pkbf(bflo(kr[i].y) * as, bfhi(kr[i].y) * as);
            w.z = pkbf(bflo(kr[i].z) * as, bfhi(kr[i].z) * as); w.w = pkbf(bflo(kr[i].w) * as, bfhi(kr[i].w) * as);
            *(LAS u32x4*)(L + ML_KT + row * KTP + ch * 16) = w; }
        __syncthreads();
        const size_t rb = row0 + 64 * (size_t)j;
        if (j + 1 < nch) ML_LOADQK(j + 1);
        u32x2 og[2][4];
#pragma unroll
        for (int tb = 0; tb < 2; ++tb)
#pragma unroll
            for (int g = 0; g < 4; ++g) og[tb][g] = *(const GAS u32x2*)(P + (rb + 32 * tb + r32j) * NP + PC_OA + hh * 256 + 32 * wid + 8 * g + 4 * hij);
        {
            const int fr = lane & 15, fq = lane >> 4;
#pragma unroll
            for (int bi = 0; bi < 2; ++bi) { const int id = 2 * wid + bi, sb = id >> 2, tb = id & 3; const int t = 16 * tb + fr, s0 = 16 * sb + 4 * fq;
                u32x2 ow = (u32x2){0u, 0u};
                if (sb <= tb) { f32x4 acc = (f32x4){0.f, 0.f, 0.f, 0.f}; bf16x8 a4[4], q4[4];
#pragma unroll
                    for (int kk = 0; kk < 4; ++kk) { a4[kk] = *(LAS const bf16x8*)(L + ML_K + (16 * sb + fr) * 272 + kk * 64 + fq * 16); q4[kk] = *(LAS const bf16x8*)(L + ML_Q + (16 * tb + fr) * 272 + kk * 64 + fq * 16); }
                    __builtin_amdgcn_sched_barrier(0);
#pragma unroll
                    for (int kk = 0; kk < 4; ++kk) acc = mfma16(a4[kk], q4[kk], acc);
                    const float rt = ROWT[t]; const f32x4 cs = *(LAS const f32x4*)(COLS + s0); float v[4];
#pragma unroll
                    for (int i = 0; i < 4; ++i) v[i] = (s0 + i <= t) ? acc[i] * __expf(rt + cs[i]) : 0.f;
                    ow.x = pkbf(v[0], v[1]); ow.y = pkbf(v[2], v[3]); }
                *(LAS u32x2*)(L + ML_S + t * 144 + s0 * 2) = ow;
                float ps = (bflo(ow.x) + bfhi(ow.x)) + (bflo(ow.y) + bfhi(ow.y));
                { auto r1 = __builtin_amdgcn_permlane16_swap(__float_as_uint(ps), __float_as_uint(ps), false, false); ps = __uint_as_float(r1[0]) + __uint_as_float(r1[1]); }
                ps = xsum32(ps);
                if (fq == 0) RS[sb * 64 + t] = ps; }
            const int t = 8 * wid + (lane >> 3), kp = lane & 7;
            const u32x4 q0 = *(LAS const u32x4*)(L + ML_Q + t * 272 + kp * 32), q1 = *(LAS const u32x4*)(L + ML_Q + t * 272 + kp * 32 + 16);
            const f32x4 n0v = *(LAS const f32x4*)(NST + 16 * kp), n1v = *(LAS const f32x4*)(NST + 16 * kp + 4), n2v = *(LAS const f32x4*)(NST + 16 * kp + 8), n3v = *(LAS const f32x4*)(NST + 16 * kp + 12);
            float d = bflo(q0.x) * n0v[0] + bfhi(q0.x) * n0v[1] + bflo(q0.y) * n0v[2] + bfhi(q0.y) * n0v[3] + bflo(q0.z) * n1v[0] + bfhi(q0.z) * n1v[1] + bflo(q0.w) * n1v[2] + bfhi(q0.w) * n1v[3]
                    + bflo(q1.x) * n2v[0] + bfhi(q1.x) * n2v[1] + bflo(q1.y) * n2v[2] + bfhi(q1.y) * n2v[3] + bflo(q1.z) * n3v[0] + bfhi(q1.z) * n3v[1] + bflo(q1.w) * n3v[2] + bfhi(q1.w) * n3v[3];
            d += dpp_f(d, 0); d += dpp_f(d, 1); d += dpp_f(d, 2);
            if (kp == 0) NQ[t] = d;
        }
#pragma unroll
        for (int i = 0; i < 4; ++i) { const int c = tid + 512 * i, row = c >> 5, ch = c & 31; *(LAS u32x4*)(L + ML_V + row * VP + ch * 16) = vr[i]; }
        __syncthreads();
        bf16x8 vf[4];
#pragma unroll
        for (int ss = 0; ss < 4; ++ss) { LAS const char* vp = L + ML_V + (16 * ss + 8 * hi + (i16 >> 2)) * VP + (32 * wid + 16 * cb + 4 * (i16 & 3)) * 2; vf[ss] = cat44(lds_tr(vp), lds_tr(vp + 4 * VP)); }
        f32x16 oa[2];
#pragma unroll
        for (int tb = 0; tb < 2; ++tb)
#pragma unroll
            for (int r = 0; r < 16; ++r) oa[tb][r] = 0.f;
        {
            u32x2 qbuf[2][2][2];
#define ML_LDQ(buf, st_) do { _Pragma("unroll") for (int tb = 0; tb < 2; ++tb) { LAS const char* qp = L + ML_Q + (32 * tb + r32) * 272 + (16 * (st_) + 4 * hi) * 2; qbuf[buf][tb][0] = *(LAS const u32x2*)qp; qbuf[buf][tb][1] = *(LAS const u32x2*)(qp + 16); } } while (0)
            ML_LDQ(0, 0);
#pragma unroll
            for (int st = 0; st < 8; ++st) { const int kb = st >> 1, s2 = st & 1;
                if (st < 7) ML_LDQ((st + 1) & 1, st + 1);
                u32x4 w; w.x = pkbf(cT[kb][8 * s2], cT[kb][8 * s2 + 1]); w.y = pkbf(cT[kb][8 * s2 + 2], cT[kb][8 * s2 + 3]); w.z = pkbf(cT[kb][8 * s2 + 4], cT[kb][8 * s2 + 5]); w.w = pkbf(cT[kb][8 * s2 + 6], cT[kb][8 * s2 + 7]);
                const bf16x8 af = __builtin_bit_cast(bf16x8, w);
#pragma unroll
                for (int tb = 0; tb < 2; ++tb) { const u32x4 bw = (u32x4){qbuf[st & 1][tb][0].x, qbuf[st & 1][tb][0].y, qbuf[st & 1][tb][1].x, qbuf[st & 1][tb][1].y}; oa[tb] = mfma32(af, __builtin_bit_cast(bf16x8, bw), oa[tb]); }
                __builtin_amdgcn_sched_barrier(0); }
#undef ML_LDQ
        }
#pragma unroll
        for (int tb = 0; tb < 2; ++tb) { const float w = WINT[32 * tb + r32];
#pragma unroll
            for (int r = 0; r < 16; ++r) oa[tb][r] *= w;
#pragma unroll
            for (int ss = 0; ss < 4; ++ss) if (tb == 1 || ss < 2) { const u32x4 sw = *(LAS const u32x4*)(L + ML_S + (32 * tb + r32) * 144 + (16 * ss + 8 * hi) * 2);
                oa[tb] = mfma32(vf[ss], __builtin_bit_cast(bf16x8, sw), oa[tb]); } }
#pragma unroll
        for (int tb = 0; tb < 2; ++tb) { const int t = 32 * tb + r32; const float rs = (RS[t] + RS[64 + t]) + (RS[128 + t] + RS[192 + t]);
            const float den = WINT[t] * NQ[t] + rs, dn = fmaxf(fabsf(den), EMT[t]), inv = __builtin_amdgcn_rcpf(dn); float sq = 0.f;
#pragma unroll
            for (int r = 0; r < 16; ++r) { oa[tb][r] *= inv; sq += oa[tb][r] * oa[tb][r]; }
            sq = xsum32(sq);
            if (hi == 0) SSQ[wid * 64 + t] = sq; }
#pragma unroll
        for (int kb = 0; kb < 4; ++kb)
#pragma unroll
            for (int r = 0; r < 16; ++r) cT[kb][r] *= decay;
        {
            s16x4 ktb[2][2][2];
#define ML_LDK(buf, st_) do { _Pragma("unroll") for (int k2 = 0; k2 < 2; ++k2) { LAS const char* kp = L + ML_KT + (16 * ((st_) >> 1) + 8 * hi + (i16 >> 2)) * KTP + (32 * (2 * ((st_) & 1) + k2) + 16 * cb + 4 * (i16 & 3)) * 2; ktb[buf][k2][0] = lds_tr(kp); ktb[buf][k2][1] = lds_tr(kp + 4 * KTP); } } while (0)
            ML_LDK(0, 0);
#pragma unroll
            for (int st = 0; st < 8; ++st) {
                if (st < 7) ML_LDK((st + 1) & 1, st + 1);
#pragma unroll
                for (int k2 = 0; k2 < 2; ++k2) cT[2 * (st & 1) + k2] = mfma32(cat44(ktb[st & 1][k2][0], ktb[st & 1][k2][1]), vf[st >> 1], cT[2 * (st & 1) + k2]);
                __builtin_amdgcn_sched_barrier(0); }
#undef ML_LDK
        }
        { float a0 = 0.f, a1 = 0.f;
#pragma unroll
            for (int s = 0; s < 8; ++s) { a0 += bf2f(*(LAS const bf16_t*)(L + ML_KT + (8 * wid + s) * KTP + lane * 2)); a1 += bf2f(*(LAS const bf16_t*)(L + ML_KT + (8 * wid + s) * KTP + 128 + lane * 2)); }
            NPART[wid * 128 + lane] = a0; NPART[wid * 128 + 64 + lane] = a1; }
        __syncthreads();
        if (j + 1 < nch) ML_LOADV(j + 1);
        if (tid < 128) { float acc = 0.f;
#pragma unroll
            for (int w = 0; w < 8; ++w) acc += NPART[w * 128 + tid];
            NST[tid] = decay * NST[tid] + acc; }
#pragma unroll
        for (int tb = 0; tb < 2; ++tb) { const int t = 32 * tb + r32; float tot = 0.f;
#pragma unroll
            for (int w = 0; w < 8; ++w) tot += SSQ[w * 64 + t];
            const float rsn = __builtin_amdgcn_rsqf(tot * (1.0f / 256.0f) + HN_EPS);
            if (t < Lv) { bf16_t* op = MIX + (rb + 32 * tb + r32j) * DM + hh * 256 + 32 * wid + 4 * hij;
#pragma unroll
                for (int g = 0; g < 4; ++g) { const u32x2 ov = og[tb][g]; const float o0 = bflo(ov.x), o1 = bfhi(ov.x), o2 = bflo(ov.y), o3 = bfhi(ov.y);
                    const f32x4 gh = *(LAS const f32x4*)(GH + 32 * wid + 8 * g + 4 * hi);
                    const float v0 = oa[tb][4 * g] * (rsn * gh[0]) * __builtin_amdgcn_rcpf(1.0f + __expf(-o0)), v1 = oa[tb][4 * g + 1] * (rsn * gh[1]) * __builtin_amdgcn_rcpf(1.0f + __expf(-o1));
                    const float v2 = oa[tb][4 * g + 2] * (rsn * gh[2]) * __builtin_amdgcn_rcpf(1.0f + __expf(-o2)), v3 = oa[tb][4 * g + 3] * (rsn * gh[3]) * __builtin_amdgcn_rcpf(1.0f + __expf(-o3));
                    u32x2 w; w.x = pkbf(v0, v1); w.y = pkbf(v2, v3); *(GAS u32x2*)(op + 8 * g) = w; } } }
    }
#pragma unroll
    for (int kb = 0; kb < 4; ++kb)
#pragma unroll
        for (int g = 0; g < 4; ++g) { const f32x4 st = (f32x4){cT[kb][4 * g], cT[kb][4 * g + 1], cT[kb][4 * g + 2], cT[kb][4 * g + 3]};
            *(GAS f32x4*)(cout + (size_t)(32 * wid + r32) * 128 + 32 * kb + 8 * g + 4 * hi) = st; }
    __syncthreads();
    if (tid < 128) ((GAS float*)nout)[tid] = NST[tid];
    if (tid == 0) ((GAS float*)mout)[0] = m;
#undef ML_LOADQK
#undef ML_LOADV
}

__device__ __forceinline__ void mlstm_passA(LAS char* L, const bf16_t* P, const float* G, bf16_t* UC, float* GS, float* NL, int ci, size_t rb, int hh, const int wv) {
    const int tid = opaque_tid(wv), lane = tid & 63, wid = __builtin_amdgcn_readfirstlane(tid >> 6), r32 = lane & 31, hi = lane >> 5, i16 = lane & 15, cb = (lane >> 4) & 1;
    LAS float* NPART = (LAS float*)(L + ML_NP);
    const float ig = ((const GAS float*)G)[(rb + lane) * 16 + hh], lf = ((const GAS float*)G)[(rb + lane) * 16 + 4 + hh];
    const float bcs = scan_sum64l(lf, lane), u = ig - bcs, pm = scan_max64l(u, lane);
    const float pm63 = __int_as_float(__builtin_amdgcn_readlane(__float_as_int(pm), 63));
    const float av = __expf(u - pm63);
    if (wid == 0) { ((GAS float*)GS)[(size_t)ci * 128 + lane] = bcs; ((GAS float*)GS)[(size_t)ci * 128 + 64 + lane] = pm; }
#pragma unroll
    for (int i = 0; i < 2; ++i) { const int c = tid + 512 * i, row = c >> 4, ch = c & 15;
        const u32x4 kr = *(const GAS u32x4*)(P + (rb + row) * NP + PC_KA + hh * 128 + ch * 8);
        const float as = bperm_f(row, av); u32x4 w;
        w.x = pkbf(bflo(kr.x) * as, bfhi(kr.x) * as); w.y = pkbf(bflo(kr.y) * as, bfhi(kr.y) * as);
        w.z = pkbf(bflo(kr.z) * as, bfhi(kr.z) * as); w.w = pkbf(bflo(kr.w) * as, bfhi(kr.w) * as);
        *(LAS u32x4*)(L + ML_KT + row * KTP + ch * 16) = w; }
#pragma unroll
    for (int i = 0; i < 4; ++i) { const int c = tid + 512 * i, row = c >> 5, ch = c & 31;
        *(LAS u32x4*)(L + ML_V + row * VP + ch * 16) = *(const GAS u32x4*)(P + (rb + row) * NP + PC_VA + hh * 256 + ch * 8); }
    __syncthreads();
    bf16x8 vf[4];
#pragma unroll
    for (int ss = 0; ss < 4; ++ss) { LAS const char* vp = L + ML_V + (16 * ss + 8 * hi + (i16 >> 2)) * VP + (32 * wid + 16 * cb + 4 * (i16 & 3)) * 2; vf[ss] = cat44(lds_tr(vp), lds_tr(vp + 4 * VP)); }
    f32x16 cT[4];
#pragma unroll
    for (int kb = 0; kb < 4; ++kb)
#pragma unroll
        for (int r = 0; r < 16; ++r) cT[kb][r] = 0.f;
    {   s16x4 kt[16][2];
#pragma unroll
        for (int ss = 0; ss < 4; ++ss)
#pragma unroll
            for (int kb = 0; kb < 4; ++kb) { LAS const char* kp = L + ML_KT + (16 * ss + 8 * hi + (i16 >> 2)) * KTP + (32 * kb + 16 * cb + 4 * (i16 & 3)) * 2; kt[4 * ss + kb][0] = lds_tr(kp); kt[4 * ss + kb][1] = lds_tr(kp + 4 * KTP); }
        __builtin_amdgcn_sched_barrier(0);
#pragma unroll
        for (int ss = 0; ss < 4; ++ss)
#pragma unroll
            for (int kb = 0; kb < 4; ++kb) cT[kb] = mfma32(cat44(kt[4 * ss + kb][0], kt[4 * ss + kb][1]), vf[ss], cT[kb]);
        __builtin_amdgcn_sched_barrier(0); }
    { float a0 = 0.f, a1 = 0.f;
#pragma unroll
        for (int s = 0; s < 8; ++s) { a0 += bf2f(*(LAS const bf16_t*)(L + ML_KT + (8 * wid + s) * KTP + lane * 2)); a1 += bf2f(*(LAS const bf16_t*)(L + ML_KT + (8 * wid + s) * KTP + 128 + lane * 2)); }
        NPART[wid * 128 + lane] = a0; NPART[wid * 128 + 64 + lane] = a1; }
    GAS bf16_t* uo = (GAS bf16_t*)UC + (size_t)ci * 32768 + (size_t)wid * 4096 + lane * 8;
#pragma unroll
    for (int kb = 0; kb < 4; ++kb)
#pragma unroll
        for (int s2 = 0; s2 < 2; ++s2) { u32x4 w; w.x = pkbf(cT[kb][8 * s2], cT[kb][8 * s2 + 1]); w.y = pkbf(cT[kb][8 * s2 + 2], cT[kb][8 * s2 + 3]); w.z = pkbf(cT[kb][8 * s2 + 4], cT[kb][8 * s2 + 5]); w.w = pkbf(cT[kb][8 * s2 + 6], cT[kb][8 * s2 + 7]);
            *(GAS u32x4*)(uo + (kb * 2 + s2) * 512) = w; }
    __syncthreads();
    if (tid < 128) { float acc = 0.f;
#pragma unroll
        for (int w = 0; w < 8; ++w) acc += NPART[w * 128 + tid];
        ((GAS float*)NL)[(size_t)ci * 128 + tid] = acc; }
}

__device__ __forceinline__ void mlstm_passB(bf16_t* UC, const float* GS, const float* NL, float* NSV, float* MSV, float* out_c, float* out_n, float* out_m, int gtid, int nthreads) {
    const GAS float* gs = (const GAS float*)GS;
    for (int e = gtid; e < 16 * 4096; e += nthreads) {
        const int chain = e >> 12, f = e & 4095;
        float c[8]; float m = 0.f;
#pragma unroll
        for (int i = 0; i < 8; ++i) c[i] = 0.f;
        GAS u32x4* up = (GAS u32x4*)((GAS bf16_t*)UC + (size_t)chain * 64 * 32768 + (size_t)f * 8);
        for (int j0 = 0; j0 < 64; j0 += 8) {
            u32x4 uw8[8]; float b8[8], p8[8];
#pragma unroll
            for (int jj = 0; jj < 8; ++jj) { const int ci = chain * 64 + j0 + jj; uw8[jj] = up[(size_t)(j0 + jj) * 4096]; b8[jj] = gs[(size_t)ci * 128 + 63]; p8[jj] = gs[(size_t)ci * 128 + 127]; }
#pragma unroll
            for (int jj = 0; jj < 8; ++jj) { const float b63 = b8[jj], pm63 = p8[jj];
                const float mn = b63 + fmaxf(m, pm63), dec = __expf(b63 + m - mn), w = __expf(b63 + pm63 - mn); m = mn;
                const u32x4 uw = uw8[jj];
                c[0] = dec * c[0] + w * bflo(uw.x); c[1] = dec * c[1] + w * bfhi(uw.x); c[2] = dec * c[2] + w * bflo(uw.y); c[3] = dec * c[3] + w * bfhi(uw.y);
                c[4] = dec * c[4] + w * bflo(uw.z); c[5] = dec * c[5] + w * bfhi(uw.z); c[6] = dec * c[6] + w * bflo(uw.w); c[7] = dec * c[7] + w * bfhi(uw.w);
                u32x4 o; o.x = pkbf(c[0], c[1]); o.y = pkbf(c[2], c[3]); o.z = pkbf(c[4], c[5]); o.w = pkbf(c[6], c[7]); uw8[jj] = o; }
#pragma unroll
            for (int jj = 0; jj < 8; ++jj) up[(size_t)(j0 + jj) * 4096] = uw8[jj]; }
        const int ln = f & 63, ks = (f >> 6) & 7, w8 = f >> 9;
        const int v = 32 * w8 + (ln & 31), k = 32 * (ks >> 1) + 16 * (ks & 1) + 4 * (ln >> 5);
        GAS float* oc = (GAS float*)out_c + (size_t)chain * 32768 + (size_t)v * 128 + k;
        *(GAS f32x4*)oc = (f32x4){c[0], c[1], c[2], c[3]}; *(GAS f32x4*)(oc + 8) = (f32x4){c[4], c[5], c[6], c[7]};
    }
    const int nt = gtid - 16 * 4096;
    if (nt >= 0 && nt < 16 * 128) { const int chain = nt >> 7, k = nt & 127; float n = 0.f, m = 0.f;
        for (int j0 = 0; j0 < 64; j0 += 8) { float b8[8], p8[8], l8[8];
#pragma unroll
            for (int jj = 0; jj < 8; ++jj) { const int ci = chain * 64 + j0 + jj; b8[jj] = gs[(size_t)ci * 128 + 63]; p8[jj] = gs[(size_t)ci * 128 + 127]; l8[jj] = ((const GAS float*)NL)[(size_t)ci * 128 + k]; }
#pragma unroll
            for (int jj = 0; jj < 8; ++jj) { const int ci = chain * 64 + j0 + jj;
                const float mn = b8[jj] + fmaxf(m, p8[jj]), dec = __expf(b8[jj] + m - mn), w = __expf(b8[jj] + p8[jj] - mn); m = mn;
                n = dec * n + w * l8[jj];
                ((GAS float*)NSV)[(size_t)ci * 128 + k] = n; if (k == 0) ((GAS float*)MSV)[ci] = m; } }
        ((GAS float*)out_n)[chain * 128 + k] = n; if (k == 0) ((GAS float*)out_m)[chain] = m; }
}

__device__ __forceinline__ void mlstm_passC(LAS char* L, const bf16_t* P, const float* G, const bf16_t* UC, const float* GS, const float* NSV, const float* MSV, bf16_t* MIX, const float* ghead,
                                            int ci, int j, size_t rb, int hh, const int wv) {
    const int tid = opaque_tid(wv), lane = tid & 63, wid = __builtin_amdgcn_readfirstlane(tid >> 6), r32 = lane & 31, hi = lane >> 5, i16 = lane & 15, cb = (lane >> 4) & 1;
    LAS float* FA = (LAS float*)(L + ML_FA); LAS float* ROWT = FA, *COLS = FA + 64, *WINT = FA + 128, *EMT = FA + 192, *NQ = FA + 256;
    LAS float* NST = (LAS float*)(L + ML_N); LAS float* SSQ = (LAS float*)(L + ML_SSQ); LAS float* RS = (LAS float*)(L + ML_RS); LAS float* GH = (LAS float*)(L + ML_GH);
    {
        const float ig = ((const GAS float*)G)[(rb + lane) * 16 + hh], bcs = ((const GAS float*)GS)[(size_t)ci * 128 + lane], pm = ((const GAS float*)GS)[(size_t)ci * 128 + 64 + lane];
        const float m = j > 0 ? ((const GAS float*)MSV)[ci - 1] : 0.f, mt = bcs + fmaxf(m, pm);
        if (wid == 0) { ROWT[lane] = bcs - mt; COLS[lane] = ig - bcs; WINT[lane] = __expf(bcs + m - mt); EMT[lane] = __expf(-mt); }
    }
    u32x2 og[2][4];
#pragma unroll
    for (int tb = 0; tb < 2; ++tb)
#pragma unroll
        for (int g = 0; g < 4; ++g) og[tb][g] = *(const GAS u32x2*)(P + (rb + 32 * tb + r32) * NP + PC_OA + hh * 256 + 32 * wid + 8 * g + 4 * hi);
    u32x4 af[8];
    if (j > 0) { const GAS bf16_t* ui = (const GAS bf16_t*)UC + (size_t)(ci - 1) * 32768 + (size_t)wid * 4096 + lane * 8;
#pragma unroll
        for (int st = 0; st < 8; ++st) af[st] = *(const GAS u32x4*)(ui + st * 512); }
    if (tid < 128) NST[tid] = j > 0 ? ((const GAS float*)NSV)[(size_t)(ci - 1) * 128 + tid] : 0.f;
    if (tid < 256) GH[tid] = ((const GAS float*)ghead)[hh * 256 + tid];
#pragma unroll
    for (int i = 0; i < 2; ++i) { const int c = tid + 512 * i, row = c >> 4, ch = c & 15;
        *(LAS u32x4*)(L + ML_Q + row * 272 + ch * 16) = *(const GAS u32x4*)(P + (rb + row) * NP + PC_QA + hh * 128 + ch * 8);
        *(LAS u32x4*)(L + ML_K + row * 272 + ch * 16) = *(const GAS u32x4*)(P + (rb + row) * NP + PC_KA + hh * 128 + ch * 8); }
#pragma unroll
    for (int i = 0; i < 4; ++i) { const int c = tid + 512 * i, row = c >> 5, ch = c & 31;
        *(LAS u32x4*)(L + ML_V + row * VP + ch * 16) = *(const GAS u32x4*)(P + (rb + row) * NP + PC_VA + hh * 256 + ch * 8); }
    __syncthreads();
    {
        const int fr = lane & 15, fq = lane >> 4;
#pragma unroll
        for (int bi = 0; bi < 2; ++bi) { const int id = 2 * wid + bi, sb = id >> 2, tb = id & 3; const int t = 16 * tb + fr, s0 = 16 * sb + 4 * fq;
            u32x2 ow = (u32x2){0u, 0u};
            if (sb <= tb) { f32x4 acc = (f32x4){0.f, 0.f, 0.f, 0.f};
#pragma unroll
                for (int kk = 0; kk < 4; ++kk) { const bf16x8 a = *(LAS const bf16x8*)(L + ML_K + (16 * sb + fr) * 272 + kk * 64 + fq * 16), q = *(LAS const bf16x8*)(L + ML_Q + (16 * tb + fr) * 272 + kk * 64 + fq * 16);
                    acc = mfma16(a, q, acc); }
                const float rt = ROWT[t]; const f32x4 cs = *(LAS const f32x4*)(COLS + s0); float v[4];
#pragma unroll
                for (int i = 0; i < 4; ++i) v[i] = (s0 + i <= t) ? acc[i] * __expf(rt + cs[i]) : 0.f;
                ow.x = pkbf(v[0], v[1]); ow.y = pkbf(v[2], v[3]); }
            *(LAS u32x2*)(L + ML_S + t * 144 + s0 * 2) = ow;
            float ps = (bflo(ow.x) + bfhi(ow.x)) + (bflo(ow.y) + bfhi(ow.y));
            { auto r1 = __builtin_amdgcn_permlane16_swap(__float_as_uint(ps), __float_as_uint(ps), false, false); ps = __uint_as_float(r1[0]) + __uint_as_float(r1[1]); }
            ps = xsum32(ps);
            if (fq == 0) RS[sb * 64 + t] = ps; }
        const int t = 8 * wid + (lane >> 3), kp = lane & 7;
        const u32x4 q0 = *(LAS const u32x4*)(L + ML_Q + t * 272 + kp * 32), q1 = *(LAS const u32x4*)(L + ML_Q + t * 272 + kp * 32 + 16);
        const f32x4 n0v = *(LAS const f32x4*)(NST + 16 * kp), n1v = *(LAS const f32x4*)(NST + 16 * kp + 4), n2v = *(LAS const f32x4*)(NST + 16 * kp + 8), n3v = *(LAS const f32x4*)(NST + 16 * kp + 12);
        float d = bflo(q0.x) * n0v[0] + bfhi(q0.x) * n0v[1] + bflo(q0.y) * n0v[2] + bfhi(q0.y) * n0v[3] + bflo(q0.z) * n1v[0] + bfhi(q0.z) * n1v[1] + bflo(q0.w) * n1v[2] + bfhi(q0.w) * n1v[3]
                + bflo(q1.x) * n2v[0] + bfhi(q1.x) * n2v[1] + bflo(q1.y) * n2v[2] + bfhi(q1.y) * n2v[3] + bflo(q1.z) * n3v[0] + bfhi(q1.z) * n3v[1] + bflo(q1.w) * n3v[2] + bfhi(q1.w) * n3v[3];
        d += dpp_f(d, 0); d += dpp_f(d, 1); d += dpp_f(d, 2);
        if (kp == 0) NQ[t] = d;
    }
    __syncthreads();
    bf16x8 vf[4];
#pragma unroll
    for (int ss = 0; ss < 4; ++ss) { LAS const char* vp = L + ML_V + (16 * ss + 8 * hi + (i16 >> 2)) * VP + (32 * wid + 16 * cb + 4 * (i16 & 3)) * 2; vf[ss] = cat44(lds_tr(vp), lds_tr(vp + 4 * VP)); }
    f32x16 oa[2];
#pragma unroll
    for (int tb = 0; tb < 2; ++tb)
#pragma unroll
        for (int r = 0; r < 16; ++r) oa[tb][r] = 0.f;
    if (j > 0) {
        u32x2 qw[16][2];
#pragma unroll
        for (int st = 0; st < 8; ++st)
#pragma unroll
            for (int tb = 0; tb < 2; ++tb) { LAS const char* qp = L + ML_Q + (32 * tb + r32) * 272 + (16 * st + 4 * hi) * 2; qw[2 * st + tb][0] = *(LAS const u32x2*)qp; qw[2 * st + tb][1] = *(LAS const u32x2*)(qp + 16); }
        __builtin_amdgcn_sched_barrier(0);
#pragma unroll
        for (int st = 0; st < 8; ++st)
#pragma unroll
            for (int tb = 0; tb < 2; ++tb) { const u32x4 bw = (u32x4){qw[2 * st + tb][0].x, qw[2 * st + tb][0].y, qw[2 * st + tb][1].x, qw[2 * st + tb][1].y};
                oa[tb] = mfma32(__builtin_bit_cast(bf16x8, af[st]), __builtin_bit_cast(bf16x8, bw), oa[tb]); }
        __builtin_amdgcn_sched_barrier(0);
    }
#pragma unroll
    for (int tb = 0; tb < 2; ++tb) { const float w = WINT[32 * tb + r32];
#pragma unroll
        for (int r = 0; r < 16; ++r) oa[tb][r] *= w;
#pragma unroll
        for (int ss = 0; ss < 4; ++ss) if (tb == 1 || ss < 2) { const u32x4 sw = *(LAS const u32x4*)(L + ML_S + (32 * tb + r32) * 144 + (16 * ss + 8 * hi) * 2);
            oa[tb] = mfma32(vf[ss], __builtin_bit_cast(bf16x8, sw), oa[tb]); } }
#pragma unroll
    for (int tb = 0; tb < 2; ++tb) { const int t = 32 * tb + r32; const float rs = (RS[t] + RS[64 + t]) + (RS[128 + t] + RS[192 + t]);
        const float den = WINT[t] * NQ[t] + rs, dn = fmaxf(fabsf(den), EMT[t]), inv = __builtin_amdgcn_rcpf(dn); float sq = 0.f;
#pragma unroll
        for (int r = 0; r < 16; ++r) { oa[tb][r] *= inv; sq += oa[tb][r] * oa[tb][r]; }
        sq = xsum32(sq);
        if (hi == 0) SSQ[wid * 64 + t] = sq; }
    __syncthreads();
#pragma unroll
    for (int tb = 0; tb < 2; ++tb) { const int t = 32 * tb + r32; float tot = 0.f;
#pragma unroll
        for (int w = 0; w < 8; ++w) tot += SSQ[w * 64 + t];
        const float rsn = __builtin_amdgcn_rsqf(tot * (1.0f / 256.0f) + HN_EPS);
        GAS bf16_t* op = (GAS bf16_t*)MIX + (rb + t) * DM + hh * 256 + 32 * wid + 4 * hi;
#pragma unroll
        for (int g = 0; g < 4; ++g) { const u32x2 ov = og[tb][g]; const float o0 = bflo(ov.x), o1 = bfhi(ov.x), o2 = bflo(ov.y), o3 = bfhi(ov.y);
            const f32x4 gh = *(LAS const f32x4*)(GH + 32 * wid + 8 * g + 4 * hi);
            const float v0 = oa[tb][4 * g] * (rsn * gh[0]) * __builtin_amdgcn_rcpf(1.0f + __expf(-o0)), v1 = oa[tb][4 * g + 1] * (rsn * gh[1]) * __builtin_amdgcn_rcpf(1.0f + __expf(-o1));
            const float v2 = oa[tb][4 * g + 2] * (rsn * gh[2]) * __builtin_amdgcn_rcpf(1.0f + __expf(-o2)), v3 = oa[tb][4 * g + 3] * (rsn * gh[3]) * __builtin_amdgcn_rcpf(1.0f + __expf(-o3));
            u32x2 w; w.x = pkbf(v0, v1); w.y = pkbf(v2, v3); *(GAS u32x2*)(op + 8 * g) = w; } }
}

#define XB_TMO      128
#define XB_XCNT(j)  (256  + 64 * (j))
#define XB_XSUB(j)  (1280 + 64 * (j))
#define XB_XGEN(j)  (2304 + 64 * (j))
#define XB_TOP      3328
#define XB_TOPGEN   3392
#define XCD_BAR_WORDS 3456
#define XB_SPIN_CAP (1u << 18)

__device__ __forceinline__ unsigned xb_ld(unsigned* p)              { return __hip_atomic_load(p, __ATOMIC_RELAXED, __HIP_MEMORY_SCOPE_AGENT); }
__device__ __forceinline__ unsigned xb_add(unsigned* p, unsigned v) { return __hip_atomic_fetch_add(p, v, __ATOMIC_RELAXED, __HIP_MEMORY_SCOPE_AGENT); }
__device__ __forceinline__ unsigned xb_xcc_id() { return (unsigned)__builtin_amdgcn_s_getreg((3 << 11) | 20) & 0xFu; }
#define XB_SPIN(cond, bar) do { unsigned _sp = 0; while (cond) { __builtin_amdgcn_s_sleep(1); \
    if ((++_sp & 255u) == 0u) { if (xb_ld(&(bar)[XB_TMO])) break; if (_sp > XB_SPIN_CAP) { atomicAdd(&(bar)[XB_TMO], 1u); break; } } } } while (0)

struct XcdBarrier {
    unsigned* bar; unsigned x;
    volatile LAS unsigned* st;
};

__device__ __forceinline__ XcdBarrier xcd_barrier_post(unsigned* bar, volatile LAS unsigned* st) {
    XcdBarrier b; b.bar = bar; b.x = xb_xcc_id(); b.st = st;
    if (threadIdx.x == 0) (void)xb_add(&bar[XB_XCNT(b.x)], 1u);
    return b;
}
__device__ __forceinline__ void xcd_barrier_complete(unsigned* bar, unsigned x, unsigned& nloc, unsigned& nx) {
    const unsigned G = gridDim.x * gridDim.y * gridDim.z;
    unsigned sum, cnt, mine, sp = 0u;
    for (;;) {
        sum = 0u; cnt = 0u; mine = 0u;
#pragma unroll
        for (unsigned j = 0; j < 16; ++j) { const unsigned c = xb_ld(&bar[XB_XCNT(j)]); sum += c; cnt += (c > 0u) ? 1u : 0u; mine = (j == x) ? c : mine; }
        if (sum == G) break;
        __builtin_amdgcn_s_sleep(1);
        if ((++sp & 255u) == 0u) { if (xb_ld(&bar[XB_TMO])) break; if (sp > XB_SPIN_CAP) { atomicAdd(&bar[XB_TMO], 1u); break; } }
    }
    nloc = mine > 0u ? mine : 1u; nx = cnt > 0u ? cnt : 1u;
}

__device__ __forceinline__ void xcd_barrier(const XcdBarrier& b) {
    asm volatile("s_waitcnt vmcnt(0)" ::: "memory");
    __syncthreads();
    if (threadIdx.x == 0) {
        unsigned* bar = b.bar;
        __builtin_amdgcn_s_waitcnt(0);
        unsigned nloc = b.st[0], nx = b.st[1];
        if (nloc == 0u) { xcd_barrier_complete(bar, b.x, nloc, nx); b.st[0] = nloc; b.st[1] = nx; }
        const unsigned old = xb_add(&bar[XB_XSUB(b.x)], 1u);
        const unsigned gen = old / nloc;
        if (old + 1u == (gen + 1u) * nloc) {
            __builtin_amdgcn_fence(__ATOMIC_RELEASE, "agent");
            asm volatile("s_waitcnt vmcnt(0)" ::: "memory");
            const unsigned og = xb_add(&bar[XB_TOP], 1u);
            const unsigned tg = og / nx;
            if (og + 1u == (tg + 1u) * nx) xb_add(&bar[XB_TOPGEN], 1u);
            else XB_SPIN(xb_ld(&bar[XB_TOPGEN]) == tg, bar);
            __builtin_amdgcn_fence(__ATOMIC_ACQUIRE, "agent");
            xb_add(&bar[XB_XGEN(b.x)], 1u);
            asm volatile("s_waitcnt vmcnt(0)" ::: "memory");
        } else {
            XB_SPIN(xb_ld(&bar[XB_XGEN(b.x)]) == gen, bar);
            __builtin_amdgcn_fence(__ATOMIC_ACQUIRE, "agent");
            asm volatile("s_waitcnt vmcnt(0)" ::: "memory");
        }
    }
    __syncthreads();
}

constexpr int LDS_BYTES = 147456;
constexpr int NPHASE = 15;
constexpr int NCONV_EARLY = 32 * 200 + 32 * 64 + 32 * 256;
constexpr int NCONV_ITEMS = NCONV_EARLY / 16;
#ifndef PH_MASK
#define PH_MASK 0xFFFF
#endif
#define PHON(k) ((PH_MASK >> (k)) & 1)
__global__ void __launch_bounds__(512) fwd_megakernel(Args args) {
    extern __shared__ __attribute__((aligned(16))) unsigned char lds_raw[];
    LAS unsigned char* lds = (LAS unsigned char*)lds_raw;
    cg::grid_group grid = cg::this_grid();
    const int wv = __builtin_amdgcn_readfirstlane((int)threadIdx.x >> 6);
    volatile LAS unsigned* xst = (volatile LAS unsigned*)(lds + LDS_BYTES - 32);
    if (threadIdx.x < 2) xst[threadIdx.x] = 0u;
    __syncthreads();
    const XcdBarrier xbar = xcd_barrier_post((unsigned*)as_global(args.ws) + 4096, xst);
    if (args.ph_lo < 0) grid.sync();
#define GRID_SYNC() xcd_barrier(xbar)
    const int G = gridDim.x, NGW = G * 8, wave = wv, gw = blockIdx.x * 8 + wave;
#define KT_LANE() (opaque_tid(wv) & 63)
#ifndef REP_SUB
#define REP_SUB -1
#define REP_N 0
#endif
    for (int ph = args.ph_lo; ph < args.ph_hi; ++ph) {
      const int nrep = (REP_SUB >= 0 && ph > 0 && (ph - 1) % 7 == REP_SUB) ? 1 + REP_N : 1;
      for (int rep = 0; rep < nrep; ++rep) {
        unsigned char* ws = args.ws; float* out = args.out; asm volatile("" : "+s"(ws), "+s"(out)); ws = as_global(ws); out = as_global(out);
    bf16_t* XB = (bf16_t*)(ws + WS_XB); bf16_t* Pb = (bf16_t*)(ws + WS_P); bf16_t* MIX = (bf16_t*)(ws + WS_MIX); bf16_t* Hb = (bf16_t*)(ws + WS_H);
    float* Gt = (float*)(ws + WS_G); float* lfT = (float*)(ws + WS_LFT); float* lfS = (float*)(ws + WS_LFS); bf16_t* Z = (bf16_t*)(ws + WS_Z);
    unsigned* ctl = (unsigned*)(ws + WS_CTL); float* PART = (float*)(ws + WS_PART);
        const int wave = wv, gw = blockIdx.x * 8 + wave;
#define KT_LANE() (opaque_tid(wv) & 63)
        if (ph == 0) { if (PHON(0)) {
            convert_x(args, gw, NGW, KT_LANE());
            convert_weights(args, 0, (LAS float*)(lds + wave * 16384), gw, NGW, KT_LANE()); }
        } else {
            const int layer = (ph - 1) / 7, sub = (ph - 1) % 7;
            if (sub == 0) { if (PHON(1)) {
                pg8::Gemm g{XB, (const bf16_t*)(ws + WS_WIN), MPAD, NIN, DM, DM}; pg8::StaticOrder S; S.init(MPAD, NIN, G, (int)blockIdx.x);
                EpiIn E{Pb, Gt, lfT, lfS, as_global(args.in[9]) + layer * 16, out + O_KP + (size_t)layer * MP * 1024, out + O_VP + (size_t)layer * MP * 1024,
                        out + O_KS + (size_t)layer * MS * 1024, out + O_VS + (size_t)layer * MS * 1024, out + O_LFP + (size_t)layer * MP * 8, out + O_LFS + (size_t)layer * MS * 8};
                pg8::gemm_phase<EpiIn, pg8::StaticOrder, true, true>(lds, g, S, E, wv); }
            } else if (sub == 1) {
                LAS int* slot = (LAS int*)(lds + LDS_BYTES - 64);
                bf16_t* UC = (bf16_t*)Z; float* GS = (float*)((unsigned char*)Z + 64 * MiB); float* NL = GS + 1024 * 128; float* NSV = NL + 1024 * 128; float* MSV = NSV + 1024 * 128;
#ifndef REP_STAGE
#define REP_STAGE 0
#endif
                for (int r2 = 0; r2 < (REP_STAGE == 1 ? 2 : 1); ++r2) { if (r2) GRID_SYNC();
                for (;;) {
                    __syncthreads();
                    if (opaque_tid(wv) == 0) slot[0] = (int)atomicAdd(ctl + 64 * (1 + layer + 2 * r2), 1u);
                    __syncthreads();
                    const int it = slot[0];
                    if (it >= 1632 + (layer == 0 ? NCONV_ITEMS : 0)) break;
                    if (it >= 1632) { if (PHON(9)) { const int c0i = (it - 1632) * 16;
                        convert_weights(args, 1, (LAS float*)(lds + wave * 16384), c0i + wave, 8, KT_LANE(), c0i + 16); }
                        continue; }
                    if (it >= 608) { if (PHON(2)) { const int ci = it - 608, chain = ci >> 6, j = ci & 63;
                        mlstm_passA((LAS char*)lds, Pb, Gt, UC, GS, NL, ci, (size_t)(chain >> 2) * SEQ + 64 * j, chain & 3, wv); }
                    } else if (it >= 64 && it < 96) { if (PHON(2)) { const int sb = (it - 64) >> 2, hh = (it - 64) & 3; const size_t si = (size_t)(layer * 8 + sb) * 4 + hh;
                        mlstm_item((LAS char*)lds, Pb, Gt, MIX, as_global(args.in[10]) + layer * 1024, (size_t)MP + sb * 16, hh, 1, 16, as_global(args.in[5]) + si * 32768, as_global(args.in[6]) + si * 128, as_global(args.in[7]) + si,
                                   out + O_CS + si * 32768, out + O_NS + si * 128, out + O_MS + si, wv); }
                    } else if (it < 64) { if (PHON(3)) { const int sb = it >> 3, h = it & 7;
                        fox_sample_item((LAS char*)lds, Pb, lfS, as_global(args.in[2]) + (size_t)layer * SBATCH * PAST * 1024, as_global(args.in[3]) + (size_t)layer * SBATCH * PAST * 1024,
                                        as_global(args.in[4]) + (size_t)layer * SBATCH * PAST * 8, MIX, sb, h, wv); }
                    } else if (PHON(4)) { const int qb = 15 - ((it - 96) >> 5), bh = (it - 96) & 31;
                        fox_prompt_unit((LAS char*)lds, Pb, lfT, MIX, bh >> 3, bh & 7, qb, wv); }
                } }
                GRID_SYNC();
                for (int r2 = 0; r2 < (REP_STAGE == 2 ? 2 : 1); ++r2) { if (r2) GRID_SYNC();
                if (PHON(2)) mlstm_passB(UC, GS, NL, NSV, MSV, out + O_CP + (size_t)layer * 16 * 32768, out + O_NP + (size_t)layer * 16 * 128, out + O_MP + layer * 16,
                                        (int)blockIdx.x * 512 + opaque_tid(wv), G * 512); }
                GRID_SYNC();
                for (int r2 = 0; r2 < (REP_STAGE == 3 ? 2 : 1); ++r2) { if (r2) GRID_SYNC();
                for (int it = (int)blockIdx.x; it < 1024; it += G) {
                    __syncthreads();
                    if (PHON(2)) { const int ci = it, chain = ci >> 6, j = ci & 63;
                        mlstm_passC((LAS char*)lds, Pb, Gt, UC, GS, NSV, MSV, MIX, as_global(args.in[10]) + layer * 1024, ci, j, (size_t)(chain >> 2) * SEQ + 64 * j, chain & 3, wv); }
                } }
            } else if (sub == 2) { if (PHON(5)) {
                { pg8::Gemm g{MIX, (const bf16_t*)(ws + (layer ? WS_WOUT2 : WS_WOUT)), MP, DM, DM, DM}; pg8::StaticOrder S; S.init(MP, DM, G, (int)blockIdx.x);
                  EpiRes E{XB, Z};
                  pg8::gemm_phase<EpiRes, pg8::StaticOrder, true, true>(lds, g, S, E, wv); }
                { pg8::Gemm g{MIX, (const bf16_t*)(ws + (layer ? WS_WOUT2 : WS_WOUT)), MPAD, DM, DM / NSL_OUT, DM}; pg8::SplitOrder S; S.init(DM, NSL_OUT, MP / 256, G, (int)blockIdx.x);
                  EpiPart E{PART};
                  pg8::gemm_phase<EpiPart, pg8::SplitOrder, true, true>(lds, g, S, E, wv); } }
            } else if (sub == 3) {
                if (PHON(6)) ln_phase(Z, XB, PART, NSL_OUT, as_global(args.in[12]) + layer * DM, as_global(args.in[13]) + layer * DM, XB, nullptr, nullptr, gw, NGW, KT_LANE(), (LAS float*)lds, wave, (int)blockIdx.x, G);
            } else if (sub == 4) { if (PHON(7)) {
                pg8::Gemm g{XB, (const bf16_t*)(ws + (layer ? WS_WUP2 : WS_WUP)), MPAD, DFF, DM, DM}; pg8::StaticOrder S; S.init(MPAD, DFF, G, (int)blockIdx.x);
                EpiUp E{Hb};
                pg8::gemm_phase<EpiUp, pg8::StaticOrder, true, true>(lds, g, S, E, wv); }
            } else if (sub == 5) { if (PHON(8)) {
                { pg8::Gemm g{Hb, (const bf16_t*)(ws + WS_WDN), MP, DM, DFF, DFF}; pg8::StaticOrder S; S.init(MP, DM, G, (int)blockIdx.x);
                  EpiRes E{XB, Z};
                  pg8::gemm_phase<EpiRes, pg8::StaticOrder, true, true>(lds, g, S, E, wv); }
                { pg8::Gemm g{Hb, (const bf16_t*)(ws + WS_WDN), MPAD, DM, DFF / NSL_DN, DFF}; pg8::SplitOrder S; S.init(DM, NSL_DN, MP / 256, G, (int)blockIdx.x);
                  EpiPart E{PART};
                  pg8::gemm_phase<EpiPart, pg8::SplitOrder, true, true>(lds, g, S, E, wv); } }
            } else if (PHON(9)) {
                if (layer == 0) { ln_phase(Z, XB, PART, NSL_DN, as_global(args.in[16]), as_global(args.in[17]), XB, nullptr, nullptr, gw, NGW, KT_LANE(), (LAS float*)lds, wave, (int)blockIdx.x, G);
                    convert_weights(args, 1, (LAS float*)(lds + wave * 16384), NCONV_EARLY + gw, NGW, KT_LANE()); }
                else ln_phase(Z, XB, PART, NSL_DN, as_global(args.in[16]) + DM, as_global(args.in[17]) + DM, nullptr, out + O_YP, out + O_YS, gw, NGW, KT_LANE(), (LAS float*)lds, wave, (int)blockIdx.x, G);
            }
        }
        if (rep + 1 < nrep) GRID_SYNC();
      }
        if (ph + 1 < args.ph_hi) GRID_SYNC();
    }
}

extern "C" void kernel_launch(void* const* d_in, const int* in_sizes, int n_in, void* d_out, int out_size, void* d_ws, size_t ws_size, hipStream_t stream) {
    static int grid = 0;
    if (grid == 0) {
        if (n_in != 18 || (size_t)out_size != O_END || ws_size < WS_END) { fprintf(stderr, "kernel_launch: unexpected shapes (n_in %d out %d ws %zu)\n", n_in, out_size, ws_size); grid = -1; return; }
        int dev = 0, cus = 0, per_cu = 0;
        hipGetDevice(&dev); hipDeviceGetAttribute(&cus, hipDeviceAttributeMultiprocessorCount, dev);
        hipFuncSetAttribute((const void*)fwd_megakernel, hipFuncAttributeMaxDynamicSharedMemorySize, LDS_BYTES);
        hipOccupancyMaxActiveBlocksPerMultiprocessor(&per_cu, (const void*)fwd_megakernel, 512, LDS_BYTES);
        (void)hipGetLastError();
        if (per_cu < 1) per_cu = 1;
        grid = cus;
        if (grid > cus * per_cu) grid = cus * per_cu;
    }
    if (grid < 0) return;
    hipMemsetAsync((char*)d_ws + WS_CTL, 0, 65536, stream);
    Args a{};
    for (int i = 0; i < 18; ++i) a.in[i] = (const float*)d_in[i];
    a.out = (float*)d_out; a.ws = (unsigned char*)d_ws; a.ph_lo = 0; a.ph_hi = NPHASE;
    void* kargs[] = {&a};
    hipError_t e = hipLaunchCooperativeKernel((const void*)fwd_megakernel, dim3(grid), dim3(512), kargs, LDS_BYTES, stream);
    if (e != hipSuccess) fprintf(stderr, "cooperative launch failed: %s (grid %d)\n", hipGetErrorString(e), grid);
}
```

```cpp
#include <hip/hip_runtime.h>
#include <hip/hip_cooperative_groups.h>
#include <cstdio>
#include <cstdint>
namespace cg = cooperative_groups;

constexpr int DM = 2048, NBATCH = 4, SEQ = 4096, MP = NBATCH * SEQ;
constexpr int SBATCH = 8, SLEN = 16, MS = SBATCH * SLEN;
constexpr int MT = MP + MS, MPAD = 16640;
constexpr int PAST = 1024, HA = 4, DVA = 256, DKA = 128, HB = 8, DHB = 128, DFF = 8192;
constexpr int NP = 6144;
constexpr int NIN = 6400, NINSRC = 6160;
constexpr int PC_QA = 0, PC_KA = 512, PC_VA = 1024, PC_OA = 2048, PC_QB = 3072, PC_KB = 4096, PC_VB = 5120;
constexpr float ALPHA = 1.4142135623730951f;
constexpr float LN_EPS = 1e-5f, HN_EPS = 1e-6f;
constexpr float LOG2E = 1.4426950408889634f;
constexpr float QA_SCALE = 0.08838834764831845f;
constexpr float QB_SCALE = 0.08838834764831845f * 1.4426950408889634f;

constexpr size_t O_YP = 0, O_YS = O_YP + (size_t)MP * DM, O_KP = O_YS + (size_t)MS * DM, O_VP = O_KP + (size_t)2 * MP * 1024,
                 O_LFP = O_VP + (size_t)2 * MP * 1024, O_CP = O_LFP + (size_t)2 * MP * 8, O_NP = O_CP + (size_t)2 * 4 * 4 * 256 * 128,
                 O_MP = O_NP + (size_t)2 * 4 * 4 * 128, O_KS = O_MP + 32, O_VS = O_KS + (size_t)2 * MS * 1024, O_LFS = O_VS + (size_t)2 * MS * 1024,
                 O_CS = O_LFS + (size_t)2 * MS * 8, O_NS = O_CS + (size_t)2 * 8 * 4 * 256 * 128, O_MS = O_NS + (size_t)2 * 8 * 4 * 128, O_END = O_MS + 64;

constexpr size_t MiB = 1u << 20;
constexpr size_t WS_CTL = 0;
constexpr size_t WS_WIN = 1 * MiB;
constexpr size_t WS_WOUT = 26 * MiB;
constexpr size_t WS_WUP = 34 * MiB;
constexpr size_t WS_WDN = 66 * MiB;
constexpr size_t WS_XB = 98 * MiB;
constexpr size_t WS_G = 163 * MiB;
constexpr size_t WS_LFT = WS_G + (size_t)MPAD * 16 * 4;
constexpr size_t WS_LFS = WS_LFT + (size_t)32 * 4096 * 4;
constexpr size_t WS_Z = 166 * MiB;
constexpr size_t WS_P = 296 * MiB;
constexpr size_t WS_MIX = WS_P + (size_t)MPAD * NP * 2;
constexpr size_t WS_H = WS_P;
constexpr size_t WS_PART = WS_P + (size_t)MPAD * DFF * 2;
constexpr size_t WS_WOUT2 = WS_PART + (size_t)32 * MS * DM * 4;
constexpr size_t WS_WUP2 = WS_WOUT2 + 8 * MiB;
constexpr size_t WS_END = WS_WUP2 + 32 * MiB;
constexpr int NSL_OUT = 16, NSL_DN = 32;
static_assert(WS_LFS + 64 * 16 * 4 <= WS_Z && WS_Z + (size_t)MPAD * DM * 4 <= WS_P && WS_MIX + (size_t)MPAD * DM * 2 <= WS_PART, "ws map");

#define LAS __attribute__((address_space(3)))
#define GAS __attribute__((address_space(1)))
typedef unsigned short bf16_t;
typedef short bf16x8 __attribute__((ext_vector_type(8)));
typedef short s16x4 __attribute__((ext_vector_type(4)));
typedef float f32x2 __attribute__((ext_vector_type(2)));
typedef float f32x4 __attribute__((ext_vector_type(4)));
typedef float f32x16 __attribute__((ext_vector_type(16)));
typedef unsigned u32x2 __attribute__((ext_vector_type(2)));
typedef unsigned u32x4 __attribute__((ext_vector_type(4)));
typedef __bf16 bf16x2_t __attribute__((ext_vector_type(2)));

__device__ __forceinline__ int opaque_tid(int wv) { int l; asm volatile("v_mbcnt_lo_u32_b32 %0, -1, 0\n\tv_mbcnt_hi_u32_b32 %0, -1, %0" : "=v"(l)); return wv * 64 + l; }
template <class T> __device__ __forceinline__ T* as_global(T* p) { return (T*)(__attribute__((address_space(1))) T*)p; }
__device__ __forceinline__ float bf2f(unsigned short u) { return __uint_as_float((unsigned)u << 16); }
__device__ __forceinline__ float bflo(unsigned u) { return __uint_as_float(u << 16); }
__device__ __forceinline__ float bfhi(unsigned u) { return __uint_as_float(u & 0xffff0000u); }
__device__ __forceinline__ unsigned pkbf(float lo, float hi) { f32x2 v = {lo, hi}; bf16x2_t b = __builtin_convertvector(v, bf16x2_t); return __builtin_bit_cast(unsigned, b); }
__device__ __forceinline__ float log_sigmoid(float x) {
    const float e = __expf(-fabsf(x));
    const float l = e < 0.03125f ? e * (1.0f - e * (0.5f - e * (0.33333334f - 0.25f * e))) : __logf(1.0f + e);
    return fminf(x, 0.f) - l; }
__device__ __forceinline__ int crow(int r, int hi) { return (r & 3) + 8 * (r >> 2) + 4 * hi; }
__device__ __forceinline__ s16x4 lds_tr(LAS const char* p) { return __builtin_bit_cast(s16x4, __builtin_amdgcn_ds_read_tr16_b64_v4i16((LAS s16x4*)p)); }
__device__ __forceinline__ bf16x8 cat44(s16x4 a, s16x4 b) { return (bf16x8){a[0], a[1], a[2], a[3], b[0], b[1], b[2], b[3]}; }

namespace pg8 {
#define PG8_LAS __attribute__((address_space(3)))
typedef unsigned short bf16_t;
typedef short bf16x8 __attribute__((ext_vector_type(8)));
typedef float f32x4 __attribute__((ext_vector_type(4)));
typedef unsigned u32x4 __attribute__((ext_vector_type(4)));
constexpr int BM = 256, BK = 64, HALF = 128, HTB = HALF * BK * 2  , STAGE_BYTES = 8 * HTB, NXCD = 8, WGM = 8;

__host__ __device__ __forceinline__ int lds_byte(int r, int c) { const int st = (r >> 4) * 2 + (c >> 5), rr = r & 15, cc = c & 31, ob = rr * 64 + cc * 2; return st * 1024 + (ob ^ (((ob >> 9) & 1) << 5)); }
__host__ __device__ __forceinline__ void stage_rc(int b, int& R, int& C) { const int st = b / 1024, sb = b % 1024, swz = sb ^ (((sb >> 9) & 1) << 5); R = (st >> 1) * 16 + swz / 64; C = (st & 1) * 32 + (swz % 64) / 2; }
__host__ __device__ __forceinline__ int perm32(int rho) { const int n = rho >> 4, i = rho & 15; return 8 * (i >> 2) + 4 * n + (i & 3); }

struct Unit { int pm, pn, pk; };
struct Gemm { const bf16_t* A; const bf16_t* Bt; int M, N, K, ld; };

struct StaticOrder {
    int nM, nN, nwg, G, c;
    __host__ __device__ void init(int M, int N, int G_, int c_) { nM = M / BM; nN = N / BM; nwg = nM * nN; G = G_; c = c_; }
    __host__ __device__ bool next(int i, Unit& u) const {
        const long L = (long)i * G + c; if (L >= nwg) return false;
        int wgid = (int)L; { const int q = nwg / NXCD, r = nwg % NXCD, xcd = wgid % NXCD, off = wgid / NXCD; wgid = (xcd < r ? xcd * (q + 1) : r * (q + 1) + (xcd - r) * q) + off; }
        const int nig = WGM * nN, gid = wgid / nig, fm = gid * WGM, gsz = (nM - fm) < WGM ? (nM - fm) : WGM;
        u.pm = fm + ((wgid % nig) % gsz); u.pn = (wgid % nig) / gsz; u.pk = 0; return true;
    }
    __device__ __forceinline__ void a_ready(const Unit&) const {}
    __device__ __forceinline__ void done(const Unit&) const {}
};

__device__ __forceinline__ unsigned cvt_pk_bf16(float lo, float hi) { unsigned r; asm volatile("v_cvt_pk_bf16_f32 %0, %1, %2" : "=v"(r) : "v"(lo), "v"(hi)); return r; }
typedef float f32x2 __attribute__((ext_vector_type(2)));
struct SplitOrder {
    int nN, np, G, c, pm0;
    __host__ __device__ void init(int N, int nsl, int pm0_, int G_, int c_) { nN = N / BM; np = nN * nsl; G = G_; c = c_; pm0 = pm0_; }
    __host__ __device__ bool next(int i, Unit& u) const { const long L = (long)i * G + c; if (L >= np) return false; u.pm = pm0; u.pn = (int)(L % nN); u.pk = (int)(L / nN); return true; }
    __device__ __forceinline__ void a_ready(const Unit&) const {}
    __device__ __forceinline__ void done(const Unit&) const {}
};
template <class Epi, class Sched, bool ALIGN_EPI = false, bool SP2 = false>
__device__ __forceinline__ void gemm_phase(PG8_LAS unsigned char* lds, const Gemm g, const Sched& S, const Epi& E, const int wv) {
    const int tid = opaque_tid(wv), wid = __builtin_amdgcn_readfirstlane(tid >> 6), lane = tid & 63, wr = wid >> 2, wc = wid & 3, fr = lane & 15, fq = lane >> 4;
    const int K = g.K, nt = K / BK;
    unsigned voffA[2], voffB[2];
#pragma unroll
    for (int i = 0; i < 2; ++i) { int R, C; stage_rc(tid * 16 + i * 8192, R, C); const int Rb = Epi::PERM ? ((R & ~31) + perm32(R & 31)) : R;
        voffA[i] = (unsigned)(R * g.ld + C) * 2u; voffB[i] = (unsigned)(Rb * g.ld + C) * 2u; }
    const size_t kstep = (size_t)(BK * 2);
    const size_t hstep = (size_t)HALF * g.ld * 2;
    const size_t tstep = 2 * hstep;
    const unsigned ldsw = (unsigned)wid * 1024u;
    const int aoff = lds_byte(wr * 64 + fr, fq * 8), boff = lds_byte(wc * 32 + fr, fq * 8);
#define PG8_SA(b, h) (((b) * 2 + (h)) * HTB)
#define PG8_SB(b, h) ((4 + (b) * 2 + (h)) * HTB)
#define PG8_STAGE(bufoff, gbase, voff) do { _Pragma("unroll") for (int _i = 0; _i < 2; ++_i) \
        __builtin_amdgcn_global_load_lds((const unsigned*)((const char*)(gbase) + (voff)[_i]), (PG8_LAS unsigned*)(lds + (bufoff) + ldsw + _i * 8192), 16, 0, 0); } while (0)
#define PG8_LDA(dst, b, h) do { _Pragma("unroll") for (int m = 0; m < 4; ++m) _Pragma("unroll") for (int k = 0; k < 2; ++k) dst[m][k] = *(const PG8_LAS bf16x8*)(lds + PG8_SA(b, h) + aoff + m * 2048 + k * 1024); } while (0)
#define PG8_LDB(dst, b, h) do { _Pragma("unroll") for (int n = 0; n < 2; ++n) _Pragma("unroll") for (int k = 0; k < 2; ++k) dst[n][k] = *(const PG8_LAS bf16x8*)(lds + PG8_SB(b, h) + boff + n * 2048 + k * 1024); } while (0)
#define PG8_MMA(ai, bj, At, Bt) do { __builtin_amdgcn_s_setprio(1); _Pragma("unroll") for (int m = 0; m < 4; ++m) _Pragma("unroll") for (int n = 0; n < 2; ++n) _Pragma("unroll") for (int k = 0; k < 2; ++k) \
        acc[ai][bj][m][n] = __builtin_amdgcn_mfma_f32_16x16x32_bf16(Bt[n][k], At[m][k], acc[ai][bj][m][n], 0, 0, 0); __builtin_amdgcn_s_setprio(0); } while (0)
#define PG8_WAIT_V(n) asm volatile("s_waitcnt vmcnt(" #n ")" ::: "memory")
#define PG8_WAIT_L(n) asm volatile("s_waitcnt lgkmcnt(" #n ")" ::: "memory")
#define PG8_BAR __builtin_amdgcn_s_barrier()
#define PG8_SCHED __builtin_amdgcn_sched_barrier(0)
    Unit cur, nxt; int ui = 0;
    if (!S.next(0, cur)) return;
    f32x4 acc[2][2][4][2];
#pragma unroll
    for (int a = 0; a < 2; ++a)
#pragma unroll
        for (int b = 0; b < 2; ++b)
#pragma unroll
            for (int m = 0; m < 4; ++m)
#pragma unroll
                for (int n = 0; n < 2; ++n) acc[a][b][m][n] = (f32x4){0.f, 0.f, 0.f, 0.f};
    bf16x8 At[4][2], B0[2][2], B1[2][2];
    const char* cA = (const char*)g.A + (size_t)cur.pm * tstep + (size_t)cur.pk * K * 2; const char* cB = (const char*)g.Bt + (size_t)cur.pn * tstep + (size_t)cur.pk * K * 2;
    S.a_ready(cur);
    if constexpr (SP2) {
        PG8_STAGE(PG8_SB(0, 0), cB, voffB); PG8_STAGE(PG8_SB(0, 1), cB + hstep, voffB); PG8_STAGE(PG8_SA(0, 0), cA, voffA); PG8_STAGE(PG8_SA(0, 1), cA + hstep, voffA);
        if (wr == 1) PG8_BAR;
        PG8_WAIT_V(2); PG8_BAR;
        PG8_STAGE(PG8_SB(1, 0), cB + kstep, voffB); PG8_STAGE(PG8_SA(1, 0), cA + kstep, voffA); PG8_STAGE(PG8_SB(1, 1), cB + hstep + kstep, voffB);
        PG8_WAIT_V(6); PG8_BAR;
    } else {
        PG8_STAGE(PG8_SB(0, 0), cB, voffB); PG8_STAGE(PG8_SA(0, 0), cA, voffA); PG8_STAGE(PG8_SB(0, 1), cB + hstep, voffB); PG8_STAGE(PG8_SA(0, 1), cA + hstep, voffA);
        if (wr == 1) PG8_BAR;
        PG8_WAIT_V(4); PG8_BAR;
        PG8_STAGE(PG8_SB(1, 0), cB + kstep, voffB); PG8_STAGE(PG8_SA(1, 0), cA + kstep, voffA); PG8_STAGE(PG8_SB(1, 1), cB + hstep + kstep, voffB);
        PG8_WAIT_V(6); PG8_BAR;
    }
    for (;;) {
        const bool has_next = S.next(ui + 1, nxt);
        const char* nA = has_next ? (const char*)g.A + (size_t)nxt.pm * tstep + (size_t)nxt.pk * K * 2 : cA; const char* nB = has_next ? (const char*)g.Bt + (size_t)nxt.pn * tstep + (size_t)nxt.pk * K * 2 : cB;
        for (int t = 0; t < nt; t += 2) {
            const bool last = (t == nt - 2);
            const char* a1 = cA + (size_t)(t + 1) * kstep;
            const char* a2 = last ? nA : cA + (size_t)(t + 2) * kstep; const char* b2 = last ? nB : cB + (size_t)(t + 2) * kstep;
            const char* a3 = a2 + kstep; const char* b3 = b2 + kstep;
            if (last && has_next) S.a_ready(nxt);
            if constexpr (SP2) {
            PG8_LDB(B0, 0, 0); PG8_LDB(B1, 0, 1); PG8_SCHED; PG8_LDA(At, 0, 0); PG8_STAGE(PG8_SA(1, 1), a1 + hstep, voffA);
            PG8_WAIT_V(8); PG8_WAIT_L(0); PG8_BAR; PG8_MMA(0, 0, At, B0); PG8_MMA(0, 1, At, B1); PG8_BAR; PG8_SCHED;
            PG8_LDA(At, 0, 1); PG8_STAGE(PG8_SB(0, 0), b2, voffB); PG8_STAGE(PG8_SB(0, 1), b2 + hstep, voffB); PG8_STAGE(PG8_SA(0, 0), a2, voffA);
            PG8_WAIT_V(8); PG8_WAIT_L(0); PG8_BAR; PG8_MMA(1, 0, At, B0); PG8_MMA(1, 1, At, B1); PG8_BAR; PG8_SCHED;
            PG8_LDB(B0, 1, 0); PG8_LDB(B1, 1, 1); PG8_SCHED; PG8_LDA(At, 1, 0); PG8_STAGE(PG8_SA(0, 1), a2 + hstep, voffA);
            PG8_WAIT_V(8); PG8_WAIT_L(0); PG8_BAR; PG8_MMA(0, 0, At, B0); PG8_MMA(0, 1, At, B1); PG8_BAR; PG8_SCHED;
            PG8_LDA(At, 1, 1); PG8_STAGE(PG8_SB(1, 0), b3, voffB); PG8_STAGE(PG8_SB(1, 1), b3 + hstep, voffB); PG8_STAGE(PG8_SA(1, 0), a3, voffA);
            PG8_WAIT_V(8); PG8_WAIT_L(0); PG8_BAR; PG8_MMA(1, 0, At, B0); PG8_MMA(1, 1, At, B1); PG8_BAR; PG8_SCHED;
            } else {
            PG8_LDB(B0, 0, 0); PG8_SCHED; PG8_LDA(At, 0, 0); PG8_STAGE(PG8_SA(1, 1), a1 + hstep, voffA);
            PG8_WAIT_L(8); PG8_BAR; PG8_WAIT_L(0); PG8_MMA(0, 0, At, B0); PG8_BAR; PG8_SCHED;
            PG8_LDB(B1, 0, 1); PG8_STAGE(PG8_SB(0, 0), b2, voffB);
            PG8_BAR; PG8_WAIT_L(0); PG8_MMA(0, 1, At, B1); PG8_BAR;
            PG8_LDA(At, 0, 1); PG8_STAGE(PG8_SA(0, 0), a2, voffA);
            PG8_BAR; PG8_WAIT_L(0); PG8_MMA(1, 0, At, B0); PG8_BAR; PG8_SCHED;
            PG8_STAGE(PG8_SB(0, 1), b2 + hstep, voffB);
            PG8_WAIT_V(6); PG8_BAR; PG8_MMA(1, 1, At, B1); PG8_BAR;
            PG8_LDB(B0, 1, 0); PG8_SCHED; PG8_LDA(At, 1, 0); PG8_STAGE(PG8_SA(0, 1), a2 + hstep, voffA);
            PG8_WAIT_L(8); PG8_BAR; PG8_WAIT_L(0); PG8_MMA(0, 0, At, B0); PG8_BAR; PG8_SCHED;
            PG8_LDB(B1, 1, 1); PG8_STAGE(PG8_SB(1, 0), b3, voffB);
            PG8_BAR; PG8_WAIT_L(0); PG8_MMA(0, 1, At, B1); PG8_BAR;
            PG8_LDA(At, 1, 1); PG8_STAGE(PG8_SA(1, 0), a3, voffA);
            PG8_BAR; PG8_WAIT_L(0); PG8_MMA(1, 0, At, B0); PG8_BAR; PG8_SCHED;
            PG8_STAGE(PG8_SB(1, 1), b3 + hstep, voffB);
            PG8_WAIT_V(6); PG8_BAR; PG8_MMA(1, 1, At, B1); PG8_BAR;
            }
        }
        if constexpr (ALIGN_EPI) { if (wr == 0) PG8_BAR; }
        if constexpr (!Epi::AFTER_DRAIN) { E(acc, cur, wr, wc, fr, fq); S.done(cur); }
        if (!has_next) break;
#pragma unroll
        for (int a = 0; a < 2; ++a)
#pragma unroll
            for (int b = 0; b < 2; ++b)
#pragma unroll
                for (int m = 0; m < 4; ++m)
#pragma unroll
                    for (int n = 0; n < 2; ++n) acc[a][b][m][n] = (f32x4){0.f, 0.f, 0.f, 0.f};
        cur = nxt; cA = nA; cB = nB; ++ui;
        if constexpr (ALIGN_EPI) { if (wr == 1) PG8_BAR; }
    }
    PG8_WAIT_V(0);
    if constexpr (!ALIGN_EPI) { if (wr == 0) PG8_BAR; }
    PG8_BAR;
    if constexpr (Epi::AFTER_DRAIN) { E.fused(acc, cur, wr, wc, fr, fq, lds, wid, lane); S.done(cur); }
#undef PG8_SA
#undef PG8_SB
#undef PG8_STAGE
#undef PG8_LDA
#undef PG8_LDB
#undef PG8_MMA
#undef PG8_WAIT_V
#undef PG8_WAIT_L
#undef PG8_BAR
#undef PG8_SCHED
}
}

struct EpiIn {
    static constexpr bool PERM = true, AFTER_DRAIN = false;
    bf16_t* P; float* G; float* lfT; float* lfS; const float* bg; float* kp; float* vp; float* ks; float* vs; float* lfp; float* lfs;
    __device__ __forceinline__ void operator()(const f32x4 (&acc)[2][2][4][2], const pg8::Unit& u, int wr, int wc, int fr, int fq) const {
        const int pn = u.pn, row0 = u.pm * 256 + wr * 64 + fr;
        if (pn < 24) {
            float sc = 1.f; if (pn < 2) sc = QA_SCALE; else if (pn >= 12 && pn < 16) sc = QB_SCALE;
            const int col0 = pn * 256 + wc * 32 + 8 * fq;
            const bool kv = pn >= 16; const bool isv = pn >= 20; const int fcol0 = (pn - (isv ? 20 : 16)) * 256 + wc * 32 + 8 * fq;
#pragma unroll
            for (int ai = 0; ai < 2; ++ai)
#pragma unroll
                for (int m = 0; m < 4; ++m) { const int row = row0 + ai * 128 + m * 16;
#pragma unroll
                    for (int bj = 0; bj < 2; ++bj) { const f32x4 v0 = acc[ai][bj][m][0] * sc, v1 = acc[ai][bj][m][1] * sc;
                        u32x4 w; w.x = pkbf(v0[0], v0[1]); w.y = pkbf(v0[2], v0[3]); w.z = pkbf(v1[0], v1[1]); w.w = pkbf(v1[2], v1[3]);
                        *(GAS u32x4*)(P + (size_t)row * NP + col0 + bj * 128) = w;
                        if (kv && row < MT) { float* dst = row < MP ? (isv ? vp : kp) + (size_t)row * 1024 : (isv ? vs : ks) + (size_t)(row - MP) * 1024;
                            dst += fcol0 + bj * 128; *(GAS f32x4*)dst = v0; *(GAS f32x4*)(dst + 4) = v1; } } }
        } else if (wc == 0 && fq < 2) {
#pragma unroll
            for (int ai = 0; ai < 2; ++ai)
#pragma unroll
                for (int m = 0; m < 4; ++m) { const int row = row0 + ai * 128 + m * 16;
                    if (row < MT) {
#pragma unroll
                        for (int n = 0; n < 2; ++n)
#pragma unroll
                            for (int i = 0; i < 4; ++i) { const int c = 8 * fq + 4 * n + i; float gt = acc[ai][0][m][n][i] + ((const GAS float*)bg)[c];
                                if (c >= 4) gt = log_sigmoid(gt);
                                ((GAS float*)G)[(size_t)row * 16 + c] = gt;
                                if (c >= 8) { const int h = c - 8;
                                    if (row < MP) { ((GAS float*)lfp)[(size_t)row * 8 + h] = gt; ((GAS float*)lfT)[(size_t)((row >> 12) * 8 + h) * 4096 + (row & 4095)] = gt; }
                                    else { const int rs = row - MP; ((GAS float*)lfs)[(size_t)rs * 8 + h] = gt; ((GAS float*)lfS)[((rs >> 4) * 8 + h) * 16 + (rs & 15)] = gt; } } } } }
        }
    }
};
struct EpiRes {
    static constexpr bool PERM = true, AFTER_DRAIN = false;
    const bf16_t* R; bf16_t* Z;
    __device__ __forceinline__ void operator()(const f32x4 (&acc)[2][2][4][2], const pg8::Unit& u, int wr, int wc, int fr, int fq) const {
        const int row0 = u.pm * 256 + wr * 64 + fr, col0 = u.pn * 256 + wc * 32 + 8 * fq;
#pragma unroll
        for (int ai = 0; ai < 2; ++ai)
#pragma unroll
            for (int m = 0; m < 4; ++m) { const size_t off = (size_t)(row0 + ai * 128 + m * 16) * DM + col0;
#pragma unroll
                for (int bj = 0; bj < 2; ++bj) { const u32x4 r = *(const GAS u32x4*)(R + off + bj * 128);
                    f32x4 v0 = acc[ai][bj][m][0], v1 = acc[ai][bj][m][1];
                    v0[0] += ALPHA * bflo(r.x); v0[1] += ALPHA * bfhi(r.x); v0[2] += ALPHA * bflo(r.y); v0[3] += ALPHA * bfhi(r.y);
                    v1[0] += ALPHA * bflo(r.z); v1[1] += ALPHA * bfhi(r.z); v1[2] += ALPHA * bflo(r.w); v1[3] += ALPHA * bfhi(r.w);
                    u32x4 w; w.x = pkbf(v0[0], v0[1]); w.y = pkbf(v0[2], v0[3]); w.z = pkbf(v1[0], v1[1]); w.w = pkbf(v1[2], v1[3]);
                    *(GAS u32x4*)(Z + off + bj * 128) = w; } }
    }
};
struct EpiPart {
    static constexpr bool PERM = true, AFTER_DRAIN = false;
    float* part;
    __device__ __forceinline__ void operator()(const f32x4 (&acc)[2][2][4][2], const pg8::Unit& u, int wr, int wc, int fr, int fq) const {
        const int r0 = wr * 64 + fr, col0 = u.pn * 256 + wc * 32 + 8 * fq;
#pragma unroll
        for (int m = 0; m < 4; ++m) { float* dst = part + ((size_t)u.pk * MS + r0 + m * 16) * DM + col0;
#pragma unroll
            for (int bj = 0; bj < 2; ++bj) { *(GAS f32x4*)(dst + bj * 128) = acc[0][bj][m][0]; *(GAS f32x4*)(dst + bj * 128 + 4) = acc[0][bj][m][1]; } }
    }
};
struct EpiUp {
    static constexpr bool PERM = true, AFTER_DRAIN = false;
    bf16_t* H;
    __device__ __forceinline__ void operator()(const f32x4 (&acc)[2][2][4][2], const pg8::Unit& u, int wr, int wc, int fr, int fq) const {
        const int row0 = u.pm * 256 + wr * 64 + fr, col0 = u.pn * 256 + wc * 32 + 8 * fq;
#pragma unroll
        for (int ai = 0; ai < 2; ++ai)
#pragma unroll
            for (int m = 0; m < 4; ++m) { const size_t off = (size_t)(row0 + ai * 128 + m * 16) * DFF + col0;
#pragma unroll
                for (int bj = 0; bj < 2; ++bj) { f32x4 v0 = acc[ai][bj][m][0], v1 = acc[ai][bj][m][1];
#pragma unroll
                    for (int i = 0; i < 4; ++i) { const float a = fmaxf(v0[i], 0.f), b = fmaxf(v1[i], 0.f); v0[i] = a * a; v1[i] = b * b; }
                    u32x4 w; w.x = pkbf(v0[0], v0[1]); w.y = pkbf(v0[2], v0[3]); w.z = pkbf(v1[0], v1[1]); w.w = pkbf(v1[2], v1[3]);
                    *(GAS u32x4*)(H + off + bj * 128) = w; } }
    }
};

#define LDS_WAIT() asm volatile("s_waitcnt lgkmcnt(0)" ::: "memory")
__device__ __forceinline__ float scan_sum64(float x, int lane) {
#pragma unroll
    for (int o = 1; o < 64; o <<= 1) { const float y = __shfl_up(x, o); if (lane >= o) x += y; }
    return x;
}
__device__ __forceinline__ float scan_max64(float x, int lane) {
#pragma unroll
    for (int o = 1; o < 64; o <<= 1) { const float y = __shfl_up(x, o); if (lane >= o) x = fmaxf(x, y); }
    return x;
}
__device__ __forceinline__ float wave_sum64(float v) {
#pragma unroll
    for (int o = 1; o < 64; o <<= 1) v += __shfl_xor(v, o);
    return v;
}

__device__ __forceinline__ float xsum32(float x) { auto rr = __builtin_amdgcn_permlane32_swap(__float_as_uint(x), __float_as_uint(x), false, false); return __uint_as_float(rr[0]) + __uint_as_float(rr[1]); }
__device__ __forceinline__ float xmax32(float x) { auto rr = __builtin_amdgcn_permlane32_swap(__float_as_uint(x), __float_as_uint(x), false, false); return fmaxf(__uint_as_float(rr[0]), __uint_as_float(rr[1])); }
__device__ __forceinline__ float dpp_f(float x, const int ctrl_sel) {
    const int v = __float_as_int(x); int r;
    if (ctrl_sel == 0) r = __builtin_amdgcn_update_dpp(v, v, 0xB1, 0xF, 0xF, false);
    else if (ctrl_sel == 1) r = __builtin_amdgcn_update_dpp(v, v, 0x4E, 0xF, 0xF, false);
    else r = __builtin_amdgcn_update_dpp(v, v, 0x141, 0xF, 0xF, false);
    return __int_as_float(r);
}
__device__ __forceinline__ float bperm_f(int srclane, float x) { return __int_as_float(__builtin_amdgcn_ds_bpermute(srclane << 2, __float_as_int(x))); }
__device__ __forceinline__ float scan_sum64l(float x, int lane) {
#pragma unroll
    for (int o = 1; o < 64; o <<= 1) { const float y = bperm_f(lane - o, x); if (lane >= o) x += y; }
    return x;
}
__device__ __forceinline__ float scan_max64l(float x, int lane) {
#pragma unroll
    for (int o = 1; o < 64; o <<= 1) { const float y = bperm_f(lane - o, x); if (lane >= o) x = fmaxf(x, y); }
    return x;
}
__device__ __forceinline__ f32x16 mfma32(bf16x8 a, bf16x8 b, f32x16 c) { return __builtin_amdgcn_mfma_f32_32x32x16_bf16(a, b, c, 0, 0, 0); }
__device__ __forceinline__ f32x4 mfma16(bf16x8 a, bf16x8 b, f32x4 c) { return __builtin_amdgcn_mfma_f32_16x16x32_bf16(a, b, c, 0, 0, 0); }
__device__ __forceinline__ float fexp2(float x) { return __builtin_amdgcn_exp2f(x); }

__device__ __forceinline__ void transpose_item(const float* W, int Nsrc, int K, bf16_t* WT, LAS float* scr, int item, int nblk, int lane, bool inmap) {
    const int kb = item / nblk, nb = item % nblk, k0 = 64 * kb, n0 = 32 * nb;
    const int nd = n0 + (lane & 31); int sc = nd;
    if (inmap) sc = nd < 3072 ? nd : (nd < 6144 ? nd + 8 : (nd < 6152 ? nd - 3072 : (nd < 6160 ? nd : -1)));
    float wv_[32];
    const GAS float* wp = (const GAS float*)W + (size_t)(k0 + (lane >> 5)) * Nsrc + (sc >= 0 ? sc : 0);
#pragma unroll
    for (int i = 0; i < 32; ++i) wv_[i] = wp[(size_t)(2 * i) * Nsrc];
#pragma unroll
    for (int i = 0; i < 32; ++i) scr[(2 * i + (lane >> 5)) * 33 + (lane & 31)] = sc >= 0 ? wv_[i] : 0.f;
    LDS_WAIT();
    const int c = lane & 7;
#pragma unroll
    for (int j = 0; j < 4; ++j) { const int n = (lane >> 3) + 8 * j; const LAS float* s = scr + (8 * c) * 33 + n;
        u32x4 o; o.x = pkbf(s[0 * 33], s[1 * 33]); o.y = pkbf(s[2 * 33], s[3 * 33]); o.z = pkbf(s[4 * 33], s[5 * 33]); o.w = pkbf(s[6 * 33], s[7 * 33]);
        *(GAS u32x4*)(WT + (size_t)(n0 + n) * K + k0 + 8 * c) = o; }
    LDS_WAIT();
}
struct Args { const float* in[18]; float* out; unsigned char* ws; int ph_lo, ph_hi; };

__device__ __forceinline__ void convert_weights(const Args& a, int layer, LAS float* scr, int gw, int NGW, int lane, int it_end = 1 << 30) {
    unsigned char* ws = as_global(a.ws);
    const float* w_in = as_global(a.in[8]) + (size_t)layer * DM * NINSRC; const float* w_out = as_global(a.in[11]) + (size_t)layer * DM * DM;
    const float* w_up = as_global(a.in[14]) + (size_t)layer * DM * DFF; const float* w_dn = as_global(a.in[15]) + (size_t)layer * DFF * DM;
    constexpr int I_IN = 32 * 200, I_OUT = 32 * 64, I_UP = 32 * 256, I_DN = 128 * 64;
    const int it_stop = it_end < I_IN + I_OUT + I_UP + I_DN ? it_end : I_IN + I_OUT + I_UP + I_DN;
    for (int it = gw; it < it_stop; it += NGW) {
        int r = it;
        if (r < I_IN) { transpose_item(w_in, NINSRC, DM, (bf16_t*)(ws + WS_WIN), scr, r, 200, lane, true); continue; } r -= I_IN;
        if (r < I_OUT) { transpose_item(w_out, DM, DM, (bf16_t*)(ws + (layer ? WS_WOUT2 : WS_WOUT)), scr, r, 64, lane, false); continue; } r -= I_OUT;
        if (r < I_UP) { transpose_item(w_up, DFF, DM, (bf16_t*)(ws + (layer ? WS_WUP2 : WS_WUP)), scr, r, 256, lane, false); continue; } r -= I_UP;
        transpose_item(w_dn, DM, DFF, (bf16_t*)(ws + WS_WDN), scr, r, 64, lane, false);
    }
}
__device__ __forceinline__ void convert_x(const Args& a, int gw, int NGW, int lane) {
    bf16_t* XB = (bf16_t*)(as_global(a.ws) + WS_XB);
    f32x4 xr[8];
#define CX_LOAD(row_) do { const GAS f32x4* x_ = (const GAS f32x4*)((row_) < MP ? as_global(a.in[0]) + (size_t)(row_) * DM : as_global(a.in[1]) + (size_t)((row_) - MP) * DM) + lane; _Pragma("unroll") for (int j = 0; j < 8; ++j) xr[j] = x_[64 * j]; } while (0)
    if (gw < MT) CX_LOAD(gw);
    for (int row = gw; row < MPAD; row += NGW) {
        GAS u32x2* o = (GAS u32x2*)(XB + (size_t)row * DM) + lane;
        if (row < MT) { u32x2 w[8];
#pragma unroll
            for (int j = 0; j < 8; ++j) { w[j].x = pkbf(xr[j][0], xr[j][1]); w[j].y = pkbf(xr[j][2], xr[j][3]); }
            if (row + NGW < MT) CX_LOAD(row + NGW);
#pragma unroll
            for (int j = 0; j < 8; ++j) o[64 * j] = w[j]; }
        else {
#pragma unroll
            for (int j = 0; j < 8; ++j) o[64 * j] = (u32x2){0u, 0u}; }
    }
#undef CX_LOAD
}
__device__ __forceinline__ void ln_phase(const bf16_t* Z, const bf16_t* RES, const float* part, int nsl, const float* g, const float* b, bf16_t* XB, float* outp, float* outs, int gw, int NGW, int lane,
                                         LAS float* scr, int wave, int bid, int nblk) {
    f32x4 gv[8], bv[8];
#pragma unroll
    for (int j = 0; j < 8; ++j) { gv[j] = ((const GAS f32x4*)g)[lane + 64 * j]; bv[j] = ((const GAS f32x4*)b)[lane + 64 * j]; }
#define LN_FINISH(v, row) do { float s = 0.f; \
        _Pragma("unroll") for (int j = 0; j < 8; ++j) s += (v[j][0] + v[j][1]) + (v[j][2] + v[j][3]); \
        const float mean = wave_sum64(s) * (1.f / DM); float s2 = 0.f; \
        _Pragma("unroll") for (int j = 0; j < 8; ++j) { v[j] = v[j] - mean; s2 += (v[j][0] * v[j][0] + v[j][1] * v[j][1]) + (v[j][2] * v[j][2] + v[j][3] * v[j][3]); } \
        const float rstd = 1.0f / sqrtf(wave_sum64(s2) * (1.f / DM) + LN_EPS); \
        _Pragma("unroll") for (int j = 0; j < 8; ++j) v[j] = v[j] * rstd * gv[j] + bv[j]; \
        if (XB) { GAS u32x2* o = (GAS u32x2*)(XB + (size_t)(row) * DM) + lane; \
            _Pragma("unroll") for (int j = 0; j < 8; ++j) { u32x2 w; w.x = pkbf(v[j][0], v[j][1]); w.y = pkbf(v[j][2], v[j][3]); o[64 * j] = w; } } \
        if (outp) { GAS f32x4* o = (GAS f32x4*)((row) < MP ? outp + (size_t)(row) * DM : outs + (size_t)((row) - MP) * DM) + lane; \
            _Pragma("unroll") for (int j = 0; j < 8; ++j) o[64 * j] = v[j]; } } while (0)
    for (int r = bid; r < MS; r += nblk) {
        f32x4 acc[8];
#pragma unroll
        for (int j = 0; j < 8; ++j) acc[j] = (f32x4){0.f, 0.f, 0.f, 0.f};
        for (int sl = wave; sl < nsl; sl += 8) { const GAS f32x4* p = (const GAS f32x4*)(part + ((size_t)sl * MS + r) * DM) + lane;
#pragma unroll
            for (int j = 0; j < 8; ++j) acc[j] += p[64 * j]; }
#pragma unroll
        for (int j = 0; j < 8; ++j) *(LAS f32x4*)(scr + wave * 2048 + (lane + 64 * j) * 4) = acc[j];
        __syncthreads();
        if (wave == 0) { const GAS u32x2* z_ = (const GAS u32x2*)(RES + (size_t)(MP + r) * DM) + lane; f32x4 v[8];
#pragma unroll
            for (int j = 0; j < 8; ++j) { const u32x2 w = z_[64 * j]; v[j] = (f32x4){ALPHA * bflo(w.x), ALPHA * bfhi(w.x), ALPHA * bflo(w.y), ALPHA * bfhi(w.y)}; }
#pragma unroll
            for (int w8 = 0; w8 < 8; ++w8)
#pragma unroll
                for (int j = 0; j < 8; ++j) v[j] += *(LAS const f32x4*)(scr + w8 * 2048 + (lane + 64 * j) * 4);
            LN_FINISH(v, MP + r); }
        __syncthreads();
    }
    u32x2 zr[8];
#define LN_LOAD(row_) do { const GAS u32x2* z_ = (const GAS u32x2*)(Z + (size_t)(row_) * DM) + lane; _Pragma("unroll") for (int j = 0; j < 8; ++j) zr[j] = z_[64 * j]; } while (0)
    if (gw < MP) LN_LOAD(gw);
    for (int row = gw; row < MP; row += NGW) {
        f32x4 v[8];
#pragma unroll
        for (int j = 0; j < 8; ++j) v[j] = (f32x4){bflo(zr[j].x), bfhi(zr[j].x), bflo(zr[j].y), bfhi(zr[j].y)};
        if (row + NGW < MP) LN_LOAD(row + NGW);
        LN_FINISH(v, row);
    }
#undef LN_LOAD
#undef LN_FINISH
}

constexpr int AT_K = 0, AT_V = 34816, AT_NF = 75776, AT_SCR = 92160, AVP = 320;
__device__ __forceinline__ void fox_prompt_unit(LAS char* L, const bf16_t* P, const float* lfT, bf16_t* MIX, int b, int h, int qb, const int wv) {
    const int tid = opaque_tid(wv), lane = tid & 63, wid = __builtin_amdgcn_readfirstlane(tid >> 6), r32 = lane & 31, hi = lane >> 5, i16 = lane & 15, cb = (lane >> 4) & 1;
    const int qend = 256 * (qb + 1), NT = 4 * (qb + 1);
    const size_t rowb = (size_t)b * SEQ;
    LAS float* nfk = (LAS float*)(L + AT_NF); LAS float* scr = (LAS float*)(L + AT_SCR);
    {
        float v[8]; const bool act = 8 * tid < qend;
        if (act) { const GAS f32x4* src = (const GAS f32x4*)(lfT + (size_t)(b * 8 + h) * 4096 + 8 * tid); const f32x4 a = src[0], c = src[1];
            v[0] = a[0]; v[1] = a[1]; v[2] = a[2]; v[3] = a[3]; v[4] = c[0]; v[5] = c[1]; v[6] = c[2]; v[7] = c[3]; }
        else {
#pragma unroll
            for (int i = 0; i < 8; ++i) v[i] = 0.f; }
#pragma unroll
        for (int i = 1; i < 8; ++i) v[i] += v[i - 1];
        const float tot = v[7]; const float x = scan_sum64(tot, lane);
        if (lane == 63) scr[wid] = x;
        __syncthreads();
        float off = 0.f;
        for (int w = 0; w < wid; ++w) off += scr[w];
        const float base = off + x - tot;
        if (act) {
#pragma unroll
            for (int i = 0; i < 8; ++i) nfk[8 * tid + i] = -(base + v[i]) * LOG2E; }
    }
    const bf16_t* Kg = P + rowb * NP + PC_KB + h * 128; const bf16_t* Vg = P + rowb * NP + PC_VB + h * 128;
    u32x4 kr[2], vr[2];
#define AT_LOAD(t) do { _Pragma("unroll") for (int i_ = 0; i_ < 2; ++i_) { const int c_ = tid + 512 * i_, row_ = c_ >> 4, ch_ = c_ & 15; \
        kr[i_] = *(const GAS u32x4*)(Kg + (size_t)(64 * (t) + row_) * NP + ch_ * 8); vr[i_] = *(const GAS u32x4*)(Vg + (size_t)(64 * (t) + row_) * NP + ch_ * 8); } } while (0)
#define AT_STORE(buf) do { _Pragma("unroll") for (int i_ = 0; i_ < 2; ++i_) { const int c_ = tid + 512 * i_, row_ = c_ >> 4, ch_ = c_ & 15; \
        *(LAS u32x4*)(L + AT_K + (buf) * 17408 + row_ * 272 + ch_ * 16) = kr[i_]; *(LAS u32x4*)(L + AT_V + (buf) * 20480 + row_ * AVP + ch_ * 16) = vr[i_]; } } while (0)
    bf16x8 qf[8];
    { const bf16_t* Qg = P + (rowb + 256 * qb + 32 * wid + r32) * NP + PC_QB + h * 128 + 8 * hi;
#pragma unroll
        for (int kk = 0; kk < 8; ++kk) qf[kk] = *(const GAS bf16x8*)(Qg + 16 * kk); }
    f32x16 o[4];
#pragma unroll
    for (int d = 0; d < 4; ++d)
#pragma unroll
        for (int r = 0; r < 16; ++r) o[d][r] = 0.f;
    float m = -INFINITY, l = 0.f;
    AT_LOAD(0); AT_STORE(0);
    __syncthreads();
    for (int t = 0; t < NT; ++t) {
        if (t + 1 < NT) AT_LOAD(t + 1);
        const int jb = t - (NT - 4);
        if (!(jb >= 0 && 64 * jb > 32 * wid + 31)) {
            LAS const char* Kb = L + AT_K + (t & 1) * 17408; LAS const char* Vb = L + AT_V + (t & 1) * 20480;
            LAS const float* nf = nfk + 64 * t;
            f32x16 s0, s1;
#pragma unroll
            for (int g = 0; g < 4; ++g) { const f32x4 a = *(LAS const f32x4*)(nf + 8 * g + 4 * hi), c = *(LAS const f32x4*)(nf + 32 + 8 * g + 4 * hi);
                s0[4 * g] = a[0]; s0[4 * g + 1] = a[1]; s0[4 * g + 2] = a[2]; s0[4 * g + 3] = a[3]; s1[4 * g] = c[0]; s1[4 * g + 1] = c[1]; s1[4 * g + 2] = c[2]; s1[4 * g + 3] = c[3]; }
            {
                bf16x8 ka[16];
#pragma unroll
                for (int kk = 0; kk < 8; ++kk) { ka[2 * kk] = *(LAS const bf16x8*)(Kb + r32 * 272 + kk * 32 + hi * 16); ka[2 * kk + 1] = *(LAS const bf16x8*)(Kb + (32 + r32) * 272 + kk * 32 + hi * 16); }
                __builtin_amdgcn_sched_barrier(0);
#pragma unroll
                for (int kk = 0; kk < 8; ++kk) { s0 = mfma32(ka[2 * kk], qf[kk], s0); s1 = mfma32(ka[2 * kk + 1], qf[kk], s1); }
                __builtin_amdgcn_sched_barrier(0);
            }
            if (jb >= 0 && 64 * jb + 63 > 32 * wid) { const int q = 32 * wid + r32;
#pragma unroll
                for (int r = 0; r < 16; ++r) { const int kv = 64 * jb + crow(r, hi); if (kv > q) s0[r] = -INFINITY; if (kv + 32 > q) s1[r] = -INFINITY; } }
            float mx = fmaxf(s0[0], s1[0]);
#pragma unroll
            for (int r = 1; r < 16; ++r) mx = fmaxf(mx, fmaxf(s0[r], s1[r]));
            mx = xmax32(mx);
            const float mn = fmaxf(m, mx), alpha = fexp2(m - mn); m = mn;
            float ls = 0.f;
#pragma unroll
            for (int r = 0; r < 16; ++r) { s0[r] = fexp2(s0[r] - mn); s1[r] = fexp2(s1[r] - mn); ls += s0[r] + s1[r]; }
            l = l * alpha + ls;
#pragma unroll
            for (int d = 0; d < 4; ++d)
#pragma unroll
                for (int r = 0; r < 16; ++r) o[d][r] *= alpha;
            bf16x8 pf[4];
            { u32x4 w;
              w.x = pkbf(s0[0], s0[1]); w.y = pkbf(s0[2], s0[3]); w.z = pkbf(s0[4], s0[5]); w.w = pkbf(s0[6], s0[7]); pf[0] = __builtin_bit_cast(bf16x8, w);
              w.x = pkbf(s0[8], s0[9]); w.y = pkbf(s0[10], s0[11]); w.z = pkbf(s0[12], s0[13]); w.w = pkbf(s0[14], s0[15]); pf[1] = __builtin_bit_cast(bf16x8, w);
              w.x = pkbf(s1[0], s1[1]); w.y = pkbf(s1[2], s1[3]); w.z = pkbf(s1[4], s1[5]); w.w = pkbf(s1[6], s1[7]); pf[2] = __builtin_bit_cast(bf16x8, w);
              w.x = pkbf(s1[8], s1[9]); w.y = pkbf(s1[10], s1[11]); w.z = pkbf(s1[12], s1[13]); w.w = pkbf(s1[14], s1[15]); pf[3] = __builtin_bit_cast(bf16x8, w); }
#pragma unroll
            for (int ss = 0; ss < 4; ++ss)
#pragma unroll
                for (int d = 0; d < 4; ++d) { LAS const char* vp = Vb + (16 * ss + 4 * hi + (i16 >> 2)) * AVP + (32 * d + 16 * cb + 4 * (i16 & 3)) * 2;
                    o[d] = mfma32(cat44(lds_tr(vp), lds_tr(vp + 8 * AVP)), pf[ss], o[d]); }
        }
        if (t + 1 < NT) AT_STORE((t + 1) & 1);
        __syncthreads();
    }
    l = xsum32(l);
    const float inv = 1.0f / l;
    bf16_t* Og = MIX + (rowb + 256 * qb + 32 * wid + r32) * DM + 1024 + h * 128 + 4 * hi;
#pragma unroll
    for (int d = 0; d < 4; ++d)
#pragma unroll
        for (int g = 0; g < 4; ++g) { u32x2 w; w.x = pkbf(o[d][4 * g] * inv, o[d][4 * g + 1] * inv); w.y = pkbf(o[d][4 * g + 2] * inv, o[d][4 * g + 3] * inv);
            *(GAS u32x2*)(Og + 32 * d + 8 * g) = w; }
#undef AT_LOAD
#undef AT_STORE
}

constexpr int FS_Q = 0, FS_NF = 8448, FS_SC = 12672, FS_TL = 80512, FS_LI = 97408, FS_SCP = 1060;
__device__ __forceinline__ void fox_sample_item(LAS char* L, const bf16_t* P, const float* lfS, const float* ck, const float* cv, const float* clf, bf16_t* MIX, int sb, int h, const int wv) {
    const int tid = opaque_tid(wv), lane = tid & 63, wid = __builtin_amdgcn_readfirstlane(tid >> 6);
    LAS float* QF = (LAS float*)(L + FS_Q); LAS float* NF = (LAS float*)(L + FS_NF); LAS float* SC = (LAS float*)(L + FS_SC); LAS float* TL = (LAS float*)(L + FS_TL); LAS float* LI = (LAS float*)(L + FS_LI);
    const size_t srow = (size_t)MP + sb * 16;
    for (int e = tid; e < 16 * 128; e += 512) { const int q = e >> 7, d = e & 127; QF[q * 132 + d] = bf2f(((const GAS bf16_t*)P)[(srow + q) * NP + PC_QB + h * 128 + d]); }
    if (wid == 0) {
        float v[17];
#pragma unroll
        for (int i = 0; i < 17; ++i) { const int idx = 17 * lane + i; float x = 0.f;
            if (idx < PAST) x = ((const GAS float*)clf)[((size_t)sb * PAST + idx) * 8 + h]; else if (idx < PAST + 16) x = ((const GAS float*)lfS)[(sb * 8 + h) * 16 + idx - PAST];
            v[i] = x; }
#pragma unroll
        for (int i = 1; i < 17; ++i) v[i] += v[i - 1];
        const float tot = v[16], x = scan_sum64(tot, lane), base = x - tot;
#pragma unroll
        for (int i = 0; i < 17; ++i) { const int idx = 17 * lane + i; if (idx < 1056) NF[idx] = -(base + v[i]) * LOG2E; }
    }
    f32x4 ta[2], tb2[2], tc[2];
#define FS_LOAD(R, src, pcol, tile) do { _Pragma("unroll") for (int i_ = 0; i_ < 2; ++i_) { const int c_ = tid + 512 * i_, row_ = c_ >> 5, ch_ = c_ & 31, kv_ = 32 * (tile) + row_; \
        if (kv_ < PAST) R[i_] = *(const GAS f32x4*)((src) + (((size_t)sb * PAST + kv_) * 8 + h) * 128 + 4 * ch_); \
        else if (kv_ < PAST + 16) { const u32x2 w_ = *(const GAS u32x2*)(P + (srow + kv_ - PAST) * NP + (pcol) + h * 128 + 4 * ch_); R[i_] = (f32x4){bflo(w_.x), bfhi(w_.x), bflo(w_.y), bfhi(w_.y)}; } \
        else R[i_] = (f32x4){0.f, 0.f, 0.f, 0.f}; } } while (0)
#define FS_STORE(R) do { _Pragma("unroll") for (int i_ = 0; i_ < 2; ++i_) { const int c_ = tid + 512 * i_, row_ = c_ >> 5, ch_ = c_ & 31; *(LAS f32x4*)(TL + row_ * 132 + 4 * ch_) = R[i_]; } } while (0)
    FS_LOAD(ta, ck, PC_KB, 0); FS_LOAD(tb2, ck, PC_KB, 1); FS_LOAD(tc, ck, PC_KB, 2);
    __syncthreads();
    {
        const int q = tid & 15, kl = tid >> 4;
#define FS_SC_STEP(R, tile_) do { const int tile = (tile_); FS_STORE(R); __syncthreads(); if (tile + 3 < 33) FS_LOAD(R, ck, PC_KB, tile + 3); \
            float acc = 0.f; \
            _Pragma("unroll 8") for (int i = 0; i < 32; ++i) { const f32x4 a = *(LAS const f32x4*)(QF + q * 132 + 4 * i), k = *(LAS const f32x4*)(TL + kl * 132 + 4 * i); acc += a[0] * k[0] + a[1] * k[1] + a[2] * k[2] + a[3] * k[3]; } \
            const int kv = 32 * tile + kl; float s = acc + NF[kv]; \
            if (kv >= PAST + 16 || (kv >= PAST && kv - PAST > q)) s = -INFINITY; \
            SC[q * FS_SCP + kv] = s; __syncthreads(); } while (0)
        for (int t3 = 0; t3 < 33; t3 += 3) { FS_SC_STEP(ta, t3); FS_SC_STEP(tb2, t3 + 1); FS_SC_STEP(tc, t3 + 2); }
#undef FS_SC_STEP
    }
    FS_LOAD(ta, cv, PC_VB, 0); FS_LOAD(tb2, cv, PC_VB, 1); FS_LOAD(tc, cv, PC_VB, 2);
    {
#pragma unroll
        for (int qq = 0; qq < 2; ++qq) { const int q = 2 * wid + qq; float mx = -INFINITY;
            for (int kv = lane; kv < 1056; kv += 64) mx = fmaxf(mx, SC[q * FS_SCP + kv]);
#pragma unroll
            for (int o = 1; o < 64; o <<= 1) mx = fmaxf(mx, __shfl_xor(mx, o));
            float sm = 0.f;
            for (int kv = lane; kv < 1056; kv += 64) { const float p = fexp2(SC[q * FS_SCP + kv] - mx); SC[q * FS_SCP + kv] = p; sm += p; }
            sm = wave_sum64(sm);
            if (lane == 0) LI[q] = 1.0f / sm; }
    }
    __syncthreads();
    {
        const int d = tid & 127, qg = tid >> 7; float o0 = 0.f, o1 = 0.f, o2 = 0.f, o3 = 0.f;
#define FS_PV_STEP(R, tile_) do { const int tile = (tile_); FS_STORE(R); __syncthreads(); if (tile + 3 < 33) FS_LOAD(R, cv, PC_VB, tile + 3); \
            _Pragma("unroll 8") for (int kl = 0; kl < 32; ++kl) { const float v = TL[kl * 132 + d]; const int kv = 32 * tile + kl; LAS const float* sp = SC + (4 * qg) * FS_SCP + kv; \
                o0 += sp[0] * v; o1 += sp[FS_SCP] * v; o2 += sp[2 * FS_SCP] * v; o3 += sp[3 * FS_SCP] * v; } \
            __syncthreads(); } while (0)
        for (int t3 = 0; t3 < 33; t3 += 3) { FS_PV_STEP(ta, t3); FS_PV_STEP(tb2, t3 + 1); FS_PV_STEP(tc, t3 + 2); }
#undef FS_PV_STEP
        GAS bf16_t* Og = (GAS bf16_t*)MIX + (srow + 4 * qg) * DM + 1024 + h * 128 + d;
        Og[0] = (bf16_t)(pkbf(o0 * LI[4 * qg], 0.f) & 0xffffu); Og[DM] = (bf16_t)(pkbf(o1 * LI[4 * qg + 1], 0.f) & 0xffffu);
        Og[2 * DM] = (bf16_t)(pkbf(o2 * LI[4 * qg + 2], 0.f) & 0xffffu); Og[3 * DM] = (bf16_t)(pkbf(o3 * LI[4 * qg + 3], 0.f) & 0xffffu);
    }
#undef FS_LOAD
#undef FS_STORE
}

constexpr int ML_Q = 0, ML_K = 17408, ML_KT = 34816, ML_V = 55296, ML_S = 92160, ML_FA = 101376, ML_N = 102656, ML_SSQ = 103168, ML_GH = 105216, ML_GP = 106240, ML_NP = 139008, ML_RS = 143104;
constexpr int KTP = 320, VP = 576;
__device__ __forceinline__ void mlstm_item(LAS char* L, const bf16_t* P, const float* G, bf16_t* MIX, const float* ghead, size_t row0, int hh, int nch, int Lv,
                                           const float* c0, const float* n0, const float* m0, float* cout, float* nout, float* mout, const int wv) {
    const int tid = opaque_tid(wv), lane = tid & 63, wid = __builtin_amdgcn_readfirstlane(tid >> 6), r32 = lane & 31, hi = lane >> 5, i16 = lane & 15, cb = (lane >> 4) & 1;
    LAS float* FA = (LAS float*)(L + ML_FA); LAS float* ROWT = FA, *COLS = FA + 64, *WINT = FA + 128, *EMT = FA + 192, *NQ = FA + 256;
    LAS float* NST = (LAS float*)(L + ML_N); LAS float* SSQ = (LAS float*)(L + ML_SSQ); LAS float* RS = (LAS float*)(L + ML_RS);
    f32x16 cT[4];
#pragma unroll
    for (int kb = 0; kb < 4; ++kb)
#pragma unroll
        for (int r = 0; r < 16; ++r) cT[kb][r] = c0 ? ((const GAS float*)c0)[(size_t)(32 * wid + r32) * 128 + 32 * kb + crow(r, hi)] : 0.f;
    if (tid < 128) NST[tid] = n0 ? ((const GAS float*)n0)[tid] : 0.f;
    float m = m0 ? ((const GAS float*)m0)[0] : 0.f;
    LAS float* GH = (LAS float*)(L + ML_GH);
    if (tid < 256) GH[tid] = ((const GAS float*)ghead)[hh * 256 + tid];
    u32x4 qr[2], kr[2], vr[4]; float igr;
#define ML_LOADQK(j) do { const size_t rb_ = row0 + 64 * (size_t)(j); \
        _Pragma("unroll") for (int i_ = 0; i_ < 2; ++i_) { const int c_ = tl_ + 512 * i_, row_ = c_ >> 4, ch_ = c_ & 15; \
            if (row_ < Lv) { qr[i_] = *(const GAS u32x4*)(P + (rb_ + row_) * NP + PC_QA + hh * 128 + ch_ * 8); kr[i_] = *(const GAS u32x4*)(P + (rb_ + row_) * NP + PC_KA + hh * 128 + ch_ * 8); } \
            else { qr[i_] = (u32x4){0u, 0u, 0u, 0u}; kr[i_] = (u32x4){0u, 0u, 0u, 0u}; } } \
        if ((tl_ & 63) < Lv) { igr = ((const GAS float*)G)[(rb_ + (tl_ & 63)) * 16 + hh]; } else { igr = -INFINITY; } } while (0)
#define ML_LOADV(j) do { const size_t rb_ = row0 + 64 * (size_t)(j); \
        _Pragma("unroll") for (int i_ = 0; i_ < 4; ++i_) { const int c_ = tl_ + 512 * i_, row_ = c_ >> 5, ch_ = c_ & 31; \
            if (row_ < Lv) vr[i_] = *(const GAS u32x4*)(P + (rb_ + row_) * NP + PC_VA + hh * 256 + ch_ * 8); else vr[i_] = (u32x4){0u, 0u, 0u, 0u}; } } while (0)
    { int tl_ = tid; ML_LOADQK(0); ML_LOADV(0); }
    LAS float* BCS = (LAS float*)(L + ML_GP); LAS float* PMX = BCS + 4096; LAS float* NPART = (LAS float*)(L + ML_NP);
    for (int jj = wid; jj < nch; jj += 8) {
        float ig0 = -INFINITY, lf0 = 0.f;
        if (lane < Lv) { ig0 = ((const GAS float*)G)[(row0 + 64 * (size_t)jj + lane) * 16 + hh]; lf0 = ((const GAS float*)G)[(row0 + 64 * (size_t)jj + lane) * 16 + 4 + hh]; }
        const float bc = scan_sum64l(lf0, lane), pmx = scan_max64l(ig0 - bc, lane);
        BCS[jj * 64 + lane] = bc; PMX[jj * 64 + lane] = pmx;
    }
    __syncthreads();
    for (int j = 0; j < nch; ++j) {
        int tl_ = tid; asm volatile("" : "+v"(tl_));
        const int r32j = tl_ & 31, hij = (tl_ >> 5) & 1;
        const int lj = tl_ & 63;
        const float bcs = BCS[j * 64 + lj], pm = PMX[j * 64 + lj], u = igr - bcs;
        const float mt = bcs + fmaxf(m, pm);
        const float b63 = __int_as_float(__builtin_amdgcn_readlane(__float_as_int(bcs), 63)), mnew = __int_as_float(__builtin_amdgcn_readlane(__float_as_int(mt), 63));
        const float av = __expf(b63 + u - mnew), decay = __expf(b63 + m - mnew);
        if (wid == 0) { ROWT[lane] = bcs - mt; COLS[lane] = u; WINT[lane] = __expf(bcs + m - mt); EMT[lane] = __expf(-mt); }
        m = mnew;
#pragma unroll
        for (int i = 0; i < 2; ++i) { const int c = tid + 512 * i, row = c >> 4, ch = c & 15;
            *(LAS u32x4*)(L + ML_Q + row * 272 + ch * 16) = qr[i]; *(LAS u32x4*)(L + ML_K + row * 272 + ch * 16) = kr[i];
            const float as = bperm_f(row, av); u32x4 w;
            w.x = pkbf(bflo(kr[i].x) * as, bfhi(kr[i].x) * as); w.y = pkbf(bflo(kr[i].y) * as, bfhi(kr[i].y) * as);
            w.z = pkbf(bflo(kr[i].z) * as, bfhi(kr[i].z) * as); w.w = pkbf(bflo(kr[i].w) * as, bfhi(kr[i].w) * as);
            *(LAS u32x4*)(L + ML_KT + row * KTP + ch * 16) = w; }
        __syncthreads();
        const size_t rb = row0 + 64 * (size_t)j;
        if (j + 1 < nch) ML_LOADQK(j + 1);
        u32x2 og[2][4];
#pragma unroll
        for (int tb = 0; tb < 2; ++tb)
#pragma unroll
            for (int g = 0; g < 4; ++g) og[tb][g] = *(const GAS u32x2*)(P + (rb + 32 * tb + r32j) * NP + PC_OA + hh * 256 + 32 * wid + 8 * g + 4 * hij);
        {
            const int fr = lane & 15, fq = lane >> 4;
#pragma unroll
            for (int bi = 0; bi < 2; ++bi) { const int id = 2 * wid + bi, sb = id >> 2, tb = id & 3; const int t = 16 * tb + fr, s0 = 16 * sb + 4 * fq;
                u32x2 ow = (u32x2){0u, 0u};
                if (sb <= tb) { f32x4 acc = (f32x4){0.f, 0.f, 0.f, 0.f}; bf16x8 a4[4], q4[4];
#pragma unroll
                    for (int kk = 0; kk < 4; ++kk) { a4[kk] = *(LAS const bf16x8*)(L + ML_K + (16 * sb + fr) * 272 + kk * 64 + fq * 16); q4[kk] = *(LAS const bf16x8*)(L + ML_Q + (16 * tb + fr) * 272 + kk * 64 + fq * 16); }
                    __builtin_amdgcn_sched_barrier(0);
#pragma unroll
                    for (int kk = 0; kk < 4; ++kk) acc = mfma16(a4[kk], q4[kk], acc);
                    const float rt = ROWT[t]; const f32x4 cs = *(LAS const f32x4*)(COLS + s0); float v[4];
#pragma unroll
                    for (int i = 0; i < 4; ++i) v[i] = (s0 + i <= t) ? acc[i] * __expf(rt + cs[i]) : 0.f;
                    ow.x = pkbf(v[0], v[1]); ow.y = pkbf(v[2], v[3]); }
                *(LAS u32x2*)(L + ML_S + t * 144 + s0 * 2) = ow;
                float ps = (bflo(ow.x) + bfhi(ow.x)) + (bflo(ow.y) + bfhi(ow.y));
                { auto r1 = __builtin_amdgcn_permlane16_swap(__float_as_uint(ps), __float_as_uint(ps), false, false); ps = __uint_as_float(r1[0]) + __uint_as_float(r1[1]); }
                ps = xsum32(ps);
                if (fq == 0) RS[sb * 64 + t] = ps; }
            const int t = 8 * wid + (lane >> 3), kp = lane & 7;
            const u32x4 q0 = *(LAS const u32x4*)(L + ML_Q + t * 272 + kp * 32), q1 = *(LAS const u32x4*)(L + ML_Q + t * 272 + kp * 32 + 16);
            const f32x4 n0v = *(LAS const f32x4*)(NST + 16 * kp), n1v = *(LAS const f32x4*)(NST + 16 * kp + 4), n2v = *(LAS const f32x4*)(NST + 16 * kp + 8), n3v = *(LAS const f32x4*)(NST + 16 * kp + 12);
            float d = bflo(q0.x) * n0v[0] + bfhi(q0.x) * n0v[1] + bflo(q0.y) * n0v[2] + bfhi(q0.y) * n0v[3] + bflo(q0.z) * n1v[0] + bfhi(q0.z) * n1v[1] + bflo(q0.w) * n1v[2] + bfhi(q0.w) * n1v[3]
                    + bflo(q1.x) * n2v[0] + bfhi(q1.x) * n2v[1] + bflo(q1.y) * n2v[2] + bfhi(q1.y) * n2v[3] + bflo(q1.z) * n3v[0] + bfhi(q1.z) * n3v[1] + bflo(q1.w) * n3v[2] + bfhi(q1.w) * n3v[3];
            d += dpp_f(d, 0); d += dpp_f(d, 1); d += dpp_f(d, 2);
            if (kp == 0) NQ[t] = d;
        }
#pragma unroll
        for (int i = 0; i < 4; ++i) { const int c = tid + 512 * i, row = c >> 5, ch = c & 31; *(LAS u32x4*)(L + ML_V + row * VP + ch * 16) = vr[i]; }
        __syncthreads();
        bf16x8 vf[4];
#pragma unroll
        for (int ss = 0; ss < 4; ++ss) { LAS const char* vp = L + ML_V + (16 * ss + 8 * hi + (i16 >> 2)) * VP + (32 * wid + 16 * cb + 4 * (i16 & 3)) * 2; vf[ss] = cat44(lds_tr(vp), lds_tr(vp + 4 * VP)); }
        f32x16 oa[2];
#pragma unroll
        for (int tb = 0; tb < 2; ++tb)
#pragma unroll
            for (int r = 0; r < 16; ++r) oa[tb][r] = 0.f;
        {
            u32x2 qbuf[2][2][2];
#define ML_LDQ(buf, st_) do { _Pragma("unroll") for (int tb = 0; tb < 2; ++tb) { LAS const char* qp = L + ML_Q + (32 * tb + r32) * 272 + (16 * (st_) + 4 * hi) * 2; qbuf[buf][tb][0] = *(LAS const u32x2*)qp; qbuf[buf][tb][1] = *(LAS const u32x2*)(qp + 16); } } while (0)
            ML_LDQ(0, 0);
#pragma unroll
            for (int st = 0; st < 8; ++st) { const int kb = st >> 1, s2 = st & 1;
                if (st < 7) ML_LDQ((st + 1) & 1, st + 1);
                u32x4 w; w.x = pkbf(cT[kb][8 * s2], cT[kb][8 * s2 + 1]); w.y = pkbf(cT[kb][8 * s2 + 2], cT[kb][8 * s2 + 3]); w.z = pkbf(cT[kb][8 * s2 + 4], cT[kb][8 * s2 + 5]); w.w = pkbf(cT[kb][8 * s2 + 6], cT[kb][8 * s2 + 7]);
                const bf16x8 af = __builtin_bit_cast(bf16x8, w);
#pragma unroll
                for (int tb = 0; tb < 2; ++tb) { const u32x4 bw = (u32x4){qbuf[st & 1][tb][0].x, qbuf[st & 1][tb][0].y, qbuf[st & 1][tb][1].x, qbuf[st & 1][tb][1].y}; oa[tb] = mfma32(af, __builtin_bit_cast(bf16x8, bw), oa[tb]); }
                __builtin_amdgcn_sched_barrier(0); }
#undef ML_LDQ
        }
#pragma unroll
        for (int tb = 0; tb < 2; ++tb) { const float w = WINT[32 * tb + r32];
#pragma unroll
            for (int r = 0; r < 16; ++r) oa[tb][r] *= w;
#pragma unroll
            for (int ss = 0; ss < 4; ++ss) if (tb == 1 || ss < 2) { const u32x4 sw = *(LAS const u32x4*)(L + ML_S + (32 * tb + r32) * 144 + (16 * ss + 8 * hi) * 2);
                oa[tb] = mfma32(vf[ss], __builtin_bit_cast(bf16x8, sw), oa[tb]); } }
#pragma unroll
        for (int tb = 0; tb < 2; ++tb) { const int t = 32 * tb + r32; const float rs = (RS[t] + RS[64 + t]) + (RS[128 + t] + RS[192 + t]);
            const float den = WINT[t] * NQ[t] + rs, dn = fmaxf(fabsf(den), EMT[t]), inv = __builtin_amdgcn_rcpf(dn); float sq = 0.f;
#pragma unroll
            for (int r = 0; r < 16; ++r) { oa[tb][r] *= inv; sq += oa[tb][r] * oa[tb][r]; }
            sq = xsum32(sq);
            if (hi == 0) SSQ[wid * 64 + t] = sq; }
#pragma unroll
        for (int kb = 0; kb < 4; ++kb)
#pragma unroll
            for (int r = 0; r < 16; ++r) cT[kb][r] *= decay;
        {
            s16x4 ktb[2][2][2];
#define ML_LDK(buf, st_) do { _Pragma("unroll") for (int k2 = 0; k2 < 2; ++k2) { LAS const char* kp = L + ML_KT + (16 * ((st_) >> 1) + 8 * hi + (i16 >> 2)) * KTP + (32 * (2 * ((st_) & 1) + k2) + 16 * cb + 4 * (i16 & 3)) * 2; ktb[buf][k2][0] = lds_tr(kp); ktb[buf][k2][1] = lds_tr(kp + 4 * KTP); } } while (0)
            ML_LDK(0, 0);
#pragma unroll
            for (int st = 0; st < 8; ++st) {
                if (st < 7) ML_LDK((st + 1) & 1, st + 1);
#pragma unroll
                for (int k2 = 0; k2 < 2; ++k2) cT[2 * (st & 1) + k2] = mfma32(cat44(ktb[st & 1][k2][0], ktb[st & 1][k2][1]), vf[st >> 1], cT[2 * (st & 1) + k2]);
                __builtin_amdgcn_sched_barrier(0); }
#undef ML_LDK
        }
        { float a0 = 0.f, a1 = 0.f;
#pragma unroll
            for (int s = 0; s < 8; ++s) { a0 += bf2f(*(LAS const bf16_t*)(L + ML_KT + (8 * wid + s) * KTP + lane * 2)); a1 += bf2f(*(LAS const bf16_t*)(L + ML_KT + (8 * wid + s) * KTP + 128 + lane * 2)); }
            NPART[wid * 128 + lane] = a0; NPART[wid * 128 + 64 + lane] = a1; }
        __syncthreads();
        if (j + 1 < nch) ML_LOADV(j + 1);
        if (tid < 128) { float acc = 0.f;
#pragma unroll
            for (int w = 0; w < 8; ++w) acc += NPART[w * 128 + tid];
            NST[tid] = decay * NST[tid] + acc; }
#pragma unroll
        for (int tb = 0; tb < 2; ++tb) { const int t = 32 * tb + r32; float tot = 0.f;
#pragma unroll
            for (int w = 0; w < 8; ++w) tot += SSQ[w * 64 + t];
            const float rsn = __builtin_amdgcn_rsqf(tot * (1.0f / 256.0f) + HN_EPS);
            if (t < Lv) { bf16_t* op = MIX + (rb + 32 * tb + r32j) * DM + hh * 256 + 32 * wid + 4 * hij;
#pragma unroll
                for (int g = 0; g < 4; ++g) { const u32x2 ov = og[tb][g]; const float o0 = bflo(ov.x), o1 = bfhi(ov.x), o2 = bflo(ov.y), o3 = bfhi(ov.y);
                    const f32x4 gh = *(LAS const f32x4*)(GH + 32 * wid + 8 * g + 4 * hi);
                    const float v0 = oa[tb][4 * g] * (rsn * gh[0]) * __builtin_amdgcn_rcpf(1.0f + __expf(-o0)), v1 = oa[tb][4 * g + 1] * (rsn * gh[1]) * __builtin_amdgcn_rcpf(1.0f + __expf(-o1));
                    const float v2 = oa[tb][4 * g + 2] * (rsn * gh[2]) * __builtin_amdgcn_rcpf(1.0f + __expf(-o2)), v3 = oa[tb][4 * g + 3] * (rsn * gh[3]) * __builtin_amdgcn_rcpf(1.0f + __expf(-o3));
                    u32x2 w; w.x = pkbf(v0, v1); w.y = pkbf(v2, v3); *(GAS u32x2*)(op + 8 * g) = w; } } }
    }
#pragma unroll
    for (int kb = 0; kb < 4; ++kb)
#pragma unroll
        for (int g = 0; g < 4; ++g) { const f32x4 st = (f32x4){cT[kb][4 * g], cT[kb][4 * g + 1], cT[kb][4 * g + 2], cT[kb][4 * g + 3]};
            *(GAS f32x4*)(cout + (size_t)(32 * wid + r32) * 128 + 32 * kb + 8 * g + 4 * hi) = st; }
    __syncthreads();
    if (tid < 128) ((GAS float*)nout)[tid] = NST[tid];
    if (tid == 0) ((GAS float*)mout)[0] = m;
#undef ML_LOADQK
#undef ML_LOADV
}

__device__ __forceinline__ void mlstm_passA(LAS char* L, const bf16_t* P, const float* G, bf16_t* UC, float* GS, float* NL, int ci, size_t rb, int hh, const int wv) {
    const int tid = opaque_tid(wv), lane = tid & 63, wid = __builtin_amdgcn_readfirstlane(tid >> 6), r32 = lane & 31, hi = lane >> 5, i16 = lane & 15, cb = (lane >> 4) & 1;
    LAS float* NPART = (LAS float*)(L + ML_NP);
    const float ig = ((const GAS float*)G)[(rb + lane) * 16 + hh], lf = ((const GAS float*)G)[(rb + lane) * 16 + 4 + hh];
    const float bcs = scan_sum64l(lf, lane), u = ig - bcs, pm = scan_max64l(u, lane);
    const float pm63 = __int_as_float(__builtin_amdgcn_readlane(__float_as_int(pm), 63));
    const float av = __expf(u - pm63);
    if (wid == 0) { ((GAS float*)GS)[(size_t)ci * 128 + lane] = bcs; ((GAS float*)GS)[(size_t)ci * 128 + 64 + lane] = pm; }
#pragma unroll
    for (int i = 0; i < 2; ++i) { const int c = tid + 512 * i, row = c >> 4, ch = c & 15;
        const u32x4 kr = *(const GAS u32x4*)(P + (rb + row) * NP + PC_KA + hh * 128 + ch * 8);
        const float as = bperm_f(row, av); u32x4 w;
        w.x = pkbf(bflo(kr.x) * as, bfhi(kr.x) * as); w.y = pkbf(bflo(kr.y) * as, bfhi(kr.y) * as);
        w.z = pkbf(bflo(kr.z) * as, bfhi(kr.z) * as); w.w = pkbf(bflo(kr.w) * as, bfhi(kr.w) * as);
        *(LAS u32x4*)(L + ML_KT + row * KTP + ch * 16) = w; }
#pragma unroll
    for (int i = 0; i < 4; ++i) { const int c = tid + 512 * i, row = c >> 5, ch = c & 31;
        *(LAS u32x4*)(L + ML_V + row * VP + ch * 16) = *(const GAS u32x4*)(P + (rb + row) * NP + PC_VA + hh * 256 + ch * 8); }
    __syncthreads();
    bf16x8 vf[4];
#pragma unroll
    for (int ss = 0; ss < 4; ++ss) { LAS const char* vp = L + ML_V + (16 * ss + 8 * hi + (i16 >> 2)) * VP + (32 * wid + 16 * cb + 4 * (i16 & 3)) * 2; vf[ss] = cat44(lds_tr(vp), lds_tr(vp + 4 * VP)); }
    f32x16 cT[4];
#pragma unroll
    for (int kb = 0; kb < 4; ++kb)
#pragma unroll
        for (int r = 0; r < 16; ++r) cT[kb][r] = 0.f;
    {   s16x4 kt[16][2];
#pragma unroll
        for (int ss = 0; ss < 4; ++ss)
#pragma unroll
            for (int kb = 0; kb < 4; ++kb) { LAS const char* kp = L + ML_KT + (16 * ss + 8 * hi + (i16 >> 2)) * KTP + (32 * kb + 16 * cb + 4 * (i16 & 3)) * 2; kt[4 * ss + kb][0] = lds_tr(kp); kt[4 * ss + kb][1] = lds_tr(kp + 4 * KTP); }
        __builtin_amdgcn_sched_barrier(0);
#pragma unroll
        for (int ss = 0; ss < 4; ++ss)
#pragma unroll
            for (int kb = 0; kb < 4; ++kb) cT[kb] = mfma32(cat44(kt[4 * ss + kb][0], kt[4 * ss + kb][1]), vf[ss], cT[kb]);
        __builtin_amdgcn_sched_barrier(0); }
    { float a0 = 0.f, a1 = 0.f;
#pragma unroll
        for (int s = 0; s < 8; ++s) { a0 += bf2f(*(LAS const bf16_t*)(L + ML_KT + (8 * wid + s) * KTP + lane * 2)); a1 += bf2f(*(LAS const bf16_t*)(L + ML_KT + (8 * wid + s) * KTP + 128 + lane * 2)); }
        NPART[wid * 128 + lane] = a0; NPART[wid * 128 + 64 + lane] = a1; }
    GAS bf16_t* uo = (GAS bf16_t*)UC + (size_t)ci * 32768 + (size_t)wid * 4096 + lane * 8;
#pragma unroll
    for (int kb = 0; kb < 4; ++kb)
#pragma unroll
        for (int s2 = 0; s2 < 2; ++s2) { u32x4 w; w.x = pkbf(cT[kb][8 * s2], cT[kb][8 * s2 + 1]); w.y = pkbf(cT[kb][8 * s2 + 2], cT[kb][8 * s2 + 3]); w.z = pkbf(cT[kb][8 * s2 + 4], cT[kb][8 * s2 + 5]); w.w = pkbf(cT[kb][8 * s2 + 6], cT[kb][8 * s2 + 7]);
            *(GAS u32x4*)(uo + (kb * 2 + s2) * 512) = w; }
    __syncthreads();
    if (tid < 128) { float acc = 0.f;
#pragma unroll
        for (int w = 0; w < 8; ++w) acc += NPART[w * 128 + tid];
        ((GAS float*)NL)[(size_t)ci * 128 + tid] = acc; }
}

__device__ __forceinline__ void mlstm_passB(bf16_t* UC, const float* GS, const float* NL, float* NSV, float* MSV, float* out_c, float* out_n, float* out_m, int gtid, int nthreads) {
    const GAS float* gs = (const GAS float*)GS;
    for (int e = gtid; e < 16 * 4096; e += nthreads) {
        const int chain = e >> 12, f = e & 4095;
        float c[8]; float m = 0.f;
#pragma unroll
        for (int i = 0; i < 8; ++i) c[i] = 0.f;
        GAS u32x4* up = (GAS u32x4*)((GAS bf16_t*)UC + (size_t)chain * 64 * 32768 + (size_t)f * 8);
        for (int j0 = 0; j0 < 64; j0 += 8) {
            u32x4 uw8[8]; float b8[8], p8[8];
#pragma unroll
            for (int jj = 0; jj < 8; ++jj) { const int ci = chain * 64 + j0 + jj; uw8[jj] = up[(size_t)(j0 + jj) * 4096]; b8[jj] = gs[(size_t)ci * 128 + 63]; p8[jj] = gs[(size_t)ci * 128 + 127]; }
#pragma unroll
            for (int jj = 0; jj < 8; ++jj) { const float b63 = b8[jj], pm63 = p8[jj];
                const float mn = b63 + fmaxf(m, pm63), dec = __expf(b63 + m - mn), w = __expf(b63 + pm63 - mn); m = mn;
                const u32x4 uw = uw8[jj];
                c[0] = dec * c[0] + w * bflo(uw.x); c[1] = dec * c[1] + w * bfhi(uw.x); c[2] = dec * c[2] + w * bflo(uw.y); c[3] = dec * c[3] + w * bfhi(uw.y);
                c[4] = dec * c[4] + w * bflo(uw.z); c[5] = dec * c[5] + w * bfhi(uw.z); c[6] = dec * c[6] + w * bflo(uw.w); c[7] = dec * c[7] + w * bfhi(uw.w);
                u32x4 o; o.x = pkbf(c[0], c[1]); o.y = pkbf(c[2], c[3]); o.z = pkbf(c[4], c[5]); o.w = pkbf(c[6], c[7]); uw8[jj] = o; }
#pragma unroll
            for (int jj = 0; jj < 8; ++jj) up[(size_t)(j0 + jj) * 4096] = uw8[jj]; }
        const int ln = f & 63, ks = (f >> 6) & 7, w8 = f >> 9;
        const int v = 32 * w8 + (ln & 31), k = 32 * (ks >> 1) + 16 * (ks & 1) + 4 * (ln >> 5);
        GAS float* oc = (GAS float*)out_c + (size_t)chain * 32768 + (size_t)v * 128 + k;
        *(GAS f32x4*)oc = (f32x4){c[0], c[1], c[2], c[3]}; *(GAS f32x4*)(oc + 8) = (f32x4){c[4], c[5], c[6], c[7]};
    }
    const int nt = gtid - 16 * 4096;
    if (nt >= 0 && nt < 16 * 128) { const int chain = nt >> 7, k = nt & 127; float n = 0.f, m = 0.f;
        for (int j0 = 0; j0 < 64; j0 += 8) { float b8[8], p8[8], l8[8];
#pragma unroll
            for (int jj = 0; jj < 8; ++jj) { const int ci = chain * 64 + j0 + jj; b8[jj] = gs[(size_t)ci * 128 + 63]; p8[jj] = gs[(size_t)ci * 128 + 127]; l8[jj] = ((const GAS float*)NL)[(size_t)ci * 128 + k]; }
#pragma unroll
            for (int jj = 0; jj < 8; ++jj) { const int ci = chain * 64 + j0 + jj;
                const float mn = b8[jj] + fmaxf(m, p8[jj]), dec = __expf(b8[jj] + m - mn), w = __expf(b8[jj] + p8[jj] - mn); m = mn;
                n = dec * n + w * l8[jj];
                ((GAS float*)NSV)[(size_t)ci * 128 + k] = n; if (k == 0) ((GAS float*)MSV)[ci] = m; } }
        ((GAS float*)out_n)[chain * 128 + k] = n; if (k == 0) ((GAS float*)out_m)[chain] = m; }
}

__device__ __forceinline__ void mlstm_passC(LAS char* L, const bf16_t* P, const float* G, const bf16_t* UC, const float* GS, const float* NSV, const float* MSV, bf16_t* MIX, const float* ghead,
                                            int ci, int j, size_t rb, int hh, const int wv) {
    const int tid = opaque_tid(wv), lane = tid & 63, wid = __builtin_amdgcn_readfirstlane(tid >> 6), r32 = lane & 31, hi = lane >> 5, i16 = lane & 15, cb = (lane >> 4) & 1;
    LAS float* FA = (LAS float*)(L + ML_FA); LAS float* ROWT = FA, *COLS = FA + 64, *WINT = FA + 128, *EMT = FA + 192, *NQ = FA + 256;
    LAS float* NST = (LAS float*)(L + ML_N); LAS float* SSQ = (LAS float*)(L + ML_SSQ); LAS float* RS = (LAS float*)(L + ML_RS); LAS float* GH = (LAS float*)(L + ML_GH);
    {
        const float ig = ((const GAS float*)G)[(rb + lane) * 16 + hh], bcs = ((const GAS float*)GS)[(size_t)ci * 128 + lane], pm = ((const GAS float*)GS)[(size_t)ci * 128 + 64 + lane];
        const float m = j > 0 ? ((const GAS float*)MSV)[ci - 1] : 0.f, mt = bcs + fmaxf(m, pm);
        if (wid == 0) { ROWT[lane] = bcs - mt; COLS[lane] = ig - bcs; WINT[lane] = __expf(bcs + m - mt); EMT[lane] = __expf(-mt); }
    }
    u32x2 og[2][4];
#pragma unroll
    for (int tb = 0; tb < 2; ++tb)
#pragma unroll
        for (int g = 0; g < 4; ++g) og[tb][g] = *(const GAS u32x2*)(P + (rb + 32 * tb + r32) * NP + PC_OA + hh * 256 + 32 * wid + 8 * g + 4 * hi);
    u32x4 af[8];
    if (j > 0) { const GAS bf16_t* ui = (const GAS bf16_t*)UC + (size_t)(ci - 1) * 32768 + (size_t)wid * 4096 + lane * 8;
#pragma unroll
        for (int st = 0; st < 8; ++st) af[st] = *(const GAS u32x4*)(ui + st * 512); }
    if (tid < 128) NST[tid] = j > 0 ? ((const GAS float*)NSV)[(size_t)(ci - 1) * 128 + tid] : 0.f;
    if (tid < 256) GH[tid] = ((const GAS float*)ghead)[hh * 256 + tid];
#pragma unroll
    for (int i = 0; i < 2; ++i) { const int c = tid + 512 * i, row = c >> 4, ch = c & 15;
        *(LAS u32x4*)(L + ML_Q + row * 272 + ch * 16) = *(const GAS u32x4*)(P + (rb + row) * NP + PC_QA + hh * 128 + ch * 8);
        *(LAS u32x4*)(L + ML_K + row * 272 + ch * 16) = *(const GAS u32x4*)(P + (rb + row) * NP + PC_KA + hh * 128 + ch * 8); }
#pragma unroll
    for (int i = 0; i < 4; ++i) { const int c = tid + 512 * i, row = c >> 5, ch = c & 31;
        *(LAS u32x4*)(L + ML_V + row * VP + ch * 16) = *(const GAS u32x4*)(P + (rb + row) * NP + PC_VA + hh * 256 + ch * 8); }
    __syncthreads();
    {
        const int fr = lane & 15, fq = lane >> 4;
#pragma unroll
        for (int bi = 0; bi < 2; ++bi) { const int id = 2 * wid + bi, sb = id >> 2, tb = id & 3; const int t = 16 * tb + fr, s0 = 16 * sb + 4 * fq;
            u32x2 ow = (u32x2){0u, 0u};
            if (sb <= tb) { f32x4 acc = (f32x4){0.f, 0.f, 0.f, 0.f};
#pragma unroll
                for (int kk = 0; kk < 4; ++kk) { const bf16x8 a = *(LAS const bf16x8*)(L + ML_K + (16 * sb + fr) * 272 + kk * 64 + fq * 16), q = *(LAS const bf16x8*)(L + ML_Q + (16 * tb + fr) * 272 + kk * 64 + fq * 16);
                    acc = mfma16(a, q, acc); }
                const float rt = ROWT[t]; const f32x4 cs = *(LAS const f32x4*)(COLS + s0); float v[4];
#pragma unroll
                for (int i = 0; i < 4; ++i) v[i] = (s0 + i <= t) ? acc[i] * __expf(rt + cs[i]) : 0.f;
                ow.x = pkbf(v[0], v[1]); ow.y = pkbf(v[2], v[3]); }
            *(LAS u32x2*)(L + ML_S + t * 144 + s0 * 2) = ow;
            float ps = (bflo(ow.x) + bfhi(ow.x)) + (bflo(ow.y) + bfhi(ow.y));
            { auto r1 = __builtin_amdgcn_permlane16_swap(__float_as_uint(ps), __float_as_uint(ps), false, false); ps = __uint_as_float(r1[0]) + __uint_as_float(r1[1]); }
            ps = xsum32(ps);
            if (fq == 0) RS[sb * 64 + t] = ps; }
        const int t = 8 * wid + (lane >> 3), kp = lane & 7;
        const u32x4 q0 = *(LAS const u32x4*)(L + ML_Q + t * 272 + kp * 32), q1 = *(LAS const u32x4*)(L + ML_Q + t * 272 + kp * 32 + 16);
        const f32x4 n0v = *(LAS const f32x4*)(NST + 16 * kp), n1v = *(LAS const f32x4*)(NST + 16 * kp + 4), n2v = *(LAS const f32x4*)(NST + 16 * kp + 8), n3v = *(LAS const f32x4*)(NST + 16 * kp + 12);
        float d = bflo(q0.x) * n0v[0] + bfhi(q0.x) * n0v[1] + bflo(q0.y) * n0v[2] + bfhi(q0.y) * n0v[3] + bflo(q0.z) * n1v[0] + bfhi(q0.z) * n1v[1] + bflo(q0.w) * n1v[2] + bfhi(q0.w) * n1v[3]
                + bflo(q1.x) * n2v[0] + bfhi(q1.x) * n2v[1] + bflo(q1.y) * n2v[2] + bfhi(q1.y) * n2v[3] + bflo(q1.z) * n3v[0] + bfhi(q1.z) * n3v[1] + bflo(q1.w) * n3v[2] + bfhi(q1.w) * n3v[3];
        d += dpp_f(d, 0); d += dpp_f(d, 1); d += dpp_f(d, 2);
        if (kp == 0) NQ[t] = d;
    }
    __syncthreads();
    bf16x8 vf[4];
#pragma unroll
    for (int ss = 0; ss < 4; ++ss) { LAS const char* vp = L + ML_V + (16 * ss + 8 * hi + (i16 >> 2)) * VP + (32 * wid + 16 * cb + 4 * (i16 & 3)) * 2; vf[ss] = cat44(lds_tr(vp), lds_tr(vp + 4 * VP)); }
    f32x16 oa[2];
#pragma unroll
    for (int tb = 0; tb < 2; ++tb)
#pragma unroll
        for (int r = 0; r < 16; ++r) oa[tb][r] = 0.f;
    if (j > 0) {
        u32x2 qw[16][2];
#pragma unroll
        for (int st = 0; st < 8; ++st)
#pragma unroll
            for (int tb = 0; tb < 2; ++tb) { LAS const char* qp = L + ML_Q + (32 * tb + r32) * 272 + (16 * st + 4 * hi) * 2; qw[2 * st + tb][0] = *(LAS const u32x2*)qp; qw[2 * st + tb][1] = *(LAS const u32x2*)(qp + 16); }
        __builtin_amdgcn_sched_barrier(0);
#pragma unroll
        for (int st = 0; st < 8; ++st)
#pragma unroll
            for (int tb = 0; tb < 2; ++tb) { const u32x4 bw = (u32x4){qw[2 * st + tb][0].x, qw[2 * st + tb][0].y, qw[2 * st + tb][1].x, qw[2 * st + tb][1].y};
                oa[tb] = mfma32(__builtin_bit_cast(bf16x8, af[st]), __builtin_bit_cast(bf16x8, bw), oa[tb]); }
        __builtin_amdgcn_sched_barrier(0);
    }
#pragma unroll
    for (int tb = 0; tb < 2; ++tb) { const float w = WINT[32 * tb + r32];
#pragma unroll
        for (int r = 0; r < 16; ++r) oa[tb][r] *= w;
#pragma unroll
        for (int ss = 0; ss < 4; ++ss) if (tb == 1 || ss < 2) { const u32x4 sw = *(LAS const u32x4*)(L + ML_S + (32 * tb + r32) * 144 + (16 * ss + 8 * hi) * 2);
            oa[tb] = mfma32(vf[ss], __builtin_bit_cast(bf16x8, sw), oa[tb]); } }
#pragma unroll
    for (int tb = 0; tb < 2; ++tb) { const int t = 32 * tb + r32; const float rs = (RS[t] + RS[64 + t]) + (RS[128 + t] + RS[192 + t]);
        const float den = WINT[t] * NQ[t] + rs, dn = fmaxf(fabsf(den), EMT[t]), inv = __builtin_amdgcn_rcpf(dn); float sq = 0.f;
#pragma unroll
        for (int r = 0; r < 16; ++r) { oa[tb][r] *= inv; sq += oa[tb][r] * oa[tb][r]; }
        sq = xsum32(sq);
        if (hi == 0) SSQ[wid * 64 + t] = sq; }
    __syncthreads();
#pragma unroll
    for (int tb = 0; tb < 2; ++tb) { const int t = 32 * tb + r32; float tot = 0.f;
#pragma unroll
        for (int w = 0; w < 8; ++w) tot += SSQ[w * 64 + t];
        const float rsn = __builtin_amdgcn_rsqf(tot * (1.0f / 256.0f) + HN_EPS);
        GAS bf16_t* op = (GAS bf16_t*)MIX + (rb + t) * DM + hh * 256 + 32 * wid + 4 * hi;
#pragma unroll
        for (int g = 0; g < 4; ++g) { const u32x2 ov = og[tb][g]; const float o0 = bflo(ov.x), o1 = bfhi(ov.x), o2 = bflo(ov.y), o3 = bfhi(ov.y);
            const f32x4 gh = *(LAS const f32x4*)(GH + 32 * wid + 8 * g + 4 * hi);
            const float v0 = oa[tb][4 * g] * (rsn * gh[0]) * __builtin_amdgcn_rcpf(1.0f + __expf(-o0)), v1 = oa[tb][4 * g + 1] * (rsn * gh[1]) * __builtin_amdgcn_rcpf(1.0f + __expf(-o1));
            const float v2 = oa[tb][4 * g + 2] * (rsn * gh[2]) * __builtin_amdgcn_rcpf(1.0f + __expf(-o2)), v3 = oa[tb][4 * g + 3] * (rsn * gh[3]) * __builtin_amdgcn_rcpf(1.0f + __expf(-o3));
            u32x2 w; w.x = pkbf(v0, v1); w.y = pkbf(v2, v3); *(GAS u32x2*)(op + 8 * g) = w; } }
}

#define XB_TMO      128
#define XB_XCNT(j)  (256  + 64 * (j))
#define XB_XSUB(j)  (1280 + 64 * (j))
#define XB_XGEN(j)  (2304 + 64 * (j))
#define XB_TOP      3328
#define XB_TOPGEN   3392
#define XCD_BAR_WORDS 3456
#define XB_SPIN_CAP (1u << 18)

__device__ __forceinline__ unsigned xb_ld(unsigned* p)              { return __hip_atomic_load(p, __ATOMIC_RELAXED, __HIP_MEMORY_SCOPE_AGENT); }
__device__ __forceinline__ unsigned xb_add(unsigned* p, unsigned v) { return __hip_atomic_fetch_add(p, v, __ATOMIC_RELAXED, __HIP_MEMORY_SCOPE_AGENT); }
__device__ __forceinline__ unsigned xb_xcc_id() { return (unsigned)__builtin_amdgcn_s_getreg((3 << 11) | 20) & 0xFu; }
#define XB_SPIN(cond, bar) do { unsigned _sp = 0; while (cond) { __builtin_amdgcn_s_sleep(1); \
    if ((++_sp & 255u) == 0u) { if (xb_ld(&(bar)[XB_TMO])) break; if (_sp > XB_SPIN_CAP) { atomicAdd(&(bar)[XB_TMO], 1u); break; } } } } while (0)

struct XcdBarrier {
    unsigned* bar; unsigned x;
    volatile LAS unsigned* st;
};

__device__ __forceinline__ XcdBarrier xcd_barrier_post(unsigned* bar, volatile LAS unsigned* st) {
    XcdBarrier b; b.bar = bar; b.x = xb_xcc_id(); b.st = st;
    if (threadIdx.x == 0) (void)xb_add(&bar[XB_XCNT(b.x)], 1u);
    return b;
}
__device__ __forceinline__ void xcd_barrier_complete(unsigned* bar, unsigned x, unsigned& nloc, unsigned& nx) {
    const unsigned G = gridDim.x * gridDim.y * gridDim.z;
    unsigned sum, cnt, mine, sp = 0u;
    for (;;) {
        sum = 0u; cnt = 0u; mine = 0u;
#pragma unroll
        for (unsigned j = 0; j < 16; ++j) { const unsigned c = xb_ld(&bar[XB_XCNT(j)]); sum += c; cnt += (c > 0u) ? 1u : 0u; mine = (j == x) ? c : mine; }
        if (sum == G) break;
        __builtin_amdgcn_s_sleep(1);
        if ((++sp & 255u) == 0u) { if (xb_ld(&bar[XB_TMO])) break; if (sp > XB_SPIN_CAP) { atomicAdd(&bar[XB_TMO], 1u); break; } }
    }
    nloc = mine > 0u ? mine : 1u; nx = cnt > 0u ? cnt : 1u;
}

__device__ __forceinline__ void xcd_barrier(const XcdBarrier& b) {
    asm volatile("s_waitcnt vmcnt(0)" ::: "memory");
    __syncthreads();
    if (threadIdx.x == 0) {
        unsigned* bar = b.bar;
        __builtin_amdgcn_s_waitcnt(0);
        unsigned nloc = b.st[0], nx = b.st[1];
        if (nloc == 0u) { xcd_barrier_complete(bar, b.x, nloc, nx); b.st[0] = nloc; b.st[1] = nx; }
        const unsigned old = xb_add(&bar[XB_XSUB(b.x)], 1u);
        const unsigned gen = old / nloc;
        if (old + 1u == (gen + 1u) * nloc) {
            __builtin_amdgcn_fence(__ATOMIC_RELEASE, "agent");
            asm volatile("s_waitcnt vmcnt(0)" ::: "memory");
            const unsigned og = xb_add(&bar[XB_TOP], 1u);
            const unsigned tg = og / nx;
            if (og + 1u == (tg + 1u) * nx) xb_add(&bar[XB_TOPGEN], 1u);
            else XB_SPIN(xb_ld(&bar[XB_TOPGEN]) == tg, bar);
            __builtin_amdgcn_fence(__ATOMIC_ACQUIRE, "agent");
            xb_add(&bar[XB_XGEN(b.x)], 1u);
            asm volatile("s_waitcnt vmcnt(0)" ::: "memory");
        } else {
            XB_SPIN(xb_ld(&bar[XB_XGEN(b.x)]) == gen, bar);
            __builtin_amdgcn_fence(__ATOMIC_ACQUIRE, "agent");
            asm volatile("s_waitcnt vmcnt(0)" ::: "memory");
        }
    }
    __syncthreads();
}

constexpr int LDS_BYTES = 147456;
constexpr int NPHASE = 15;
constexpr int NCONV_EARLY = 32 * 200 + 32 * 64 + 32 * 256;
constexpr int NCONV_ITEMS = NCONV_EARLY / 16;
#ifndef PH_MASK
#define PH_MASK 0xFFFF
#endif
#define PHON(k) ((PH_MASK >> (k)) & 1)
__global__ void __launch_bounds__(512) fwd_megakernel(Args args) {
    extern __shared__ __attribute__((aligned(16))) unsigned char lds_raw[];
    LAS unsigned char* lds = (LAS unsigned char*)lds_raw;
    cg::grid_group grid = cg::this_grid();
    const int wv = __builtin_amdgcn_readfirstlane((int)threadIdx.x >> 6);
    volatile LAS unsigned* xst = (volatile LAS unsigned*)(lds + LDS_BYTES - 32);
    if (threadIdx.x < 2) xst[threadIdx.x] = 0u;
    __syncthreads();
    const XcdBarrier xbar = xcd_barrier_post((unsigned*)as_global(args.ws) + 4096, xst);
    if (args.ph_lo < 0) grid.sync();
#define GRID_SYNC() xcd_barrier(xbar)
    const int G = gridDim.x, NGW = G * 8, wave = wv, gw = blockIdx.x * 8 + wave;
#define KT_LANE() (opaque_tid(wv) & 63)
#ifndef REP_SUB
#define REP_SUB -1
#define REP_N 0
#endif
    for (int ph = args.ph_lo; ph < args.ph_hi; ++ph) {
      const int nrep = (REP_SUB >= 0 && ph > 0 && (ph - 1) % 7 == REP_SUB) ? 1 + REP_N : 1;
      for (int rep = 0; rep < nrep; ++rep) {
        unsigned char* ws = args.ws; float* out = args.out; asm volatile("" : "+s"(ws), "+s"(out)); ws = as_global(ws); out = as_global(out);
    bf16_t* XB = (bf16_t*)(ws + WS_XB); bf16_t* Pb = (bf16_t*)(ws + WS_P); bf16_t* MIX = (bf16_t*)(ws + WS_MIX); bf16_t* Hb = (bf16_t*)(ws + WS_H);
    float* Gt = (float*)(ws + WS_G); float* lfT = (float*)(ws + WS_LFT); float* lfS = (float*)(ws + WS_LFS); bf16_t* Z = (bf16_t*)(ws + WS_Z);
    unsigned* ctl = (unsigned*)(ws + WS_CTL); float* PART = (float*)(ws + WS_PART);
        const int wave = wv, gw = blockIdx.x * 8 + wave;
#define KT_LANE() (opaque_tid(wv) & 63)
        if (ph == 0) { if (PHON(0)) {
            convert_x(args, gw, NGW, KT_LANE());
            convert_weights(args, 0, (LAS float*)(lds + wave * 16384), gw, NGW, KT_LANE()); }
        } else {
            const int layer = (ph - 1) / 7, sub = (ph - 1) % 7;
            if (sub == 0) { if (PHON(1)) {
                pg8::Gemm g{XB, (const bf16_t*)(ws + WS_WIN), MPAD, NIN, DM, DM}; pg8::StaticOrder S; S.init(MPAD, NIN, G, (int)blockIdx.x);
                EpiIn E{Pb, Gt, lfT, lfS, as_global(args.in[9]) + layer * 16, out + O_KP + (size_t)layer * MP * 1024, out + O_VP + (size_t)layer * MP * 1024,
                        out + O_KS + (size_t)layer * MS * 1024, out + O_VS + (size_t)layer * MS * 1024, out + O_LFP + (size_t)layer * MP * 8, out + O_LFS + (size_t)layer * MS * 8};
                pg8::gemm_phase<EpiIn, pg8::StaticOrder, true, true>(lds, g, S, E, wv); }
            } else if (sub == 1) {
                LAS int* slot = (LAS int*)(lds + LDS_BYTES - 64);
                bf16_t* UC = (bf16_t*)Z; float* GS = (float*)((unsigned char*)Z + 64 * MiB); float* NL = GS + 1024 * 128; float* NSV = NL + 1024 * 128; float* MSV = NSV + 1024 * 128;
#ifndef REP_STAGE
#define REP_STAGE 0
#endif
                for (int r2 = 0; r2 < (REP_STAGE == 1 ? 2 : 1); ++r2) { if (r2) GRID_SYNC();
                for (;;) {
                    __syncthreads();
                    if (opaque_tid(wv) == 0) slot[0] = (int)atomicAdd(ctl + 64 * (1 + layer + 2 * r2), 1u);
                    __syncthreads();
                    const int it = slot[0];
                    if (it >= 1632) break;
                    if (it >= 608) { if (PHON(2)) { const int ci = it - 608, chain = ci >> 6, j = ci & 63;
                        mlstm_passA((LAS char*)lds, Pb, Gt, UC, GS, NL, ci, (size_t)(chain >> 2) * SEQ + 64 * j, chain & 3, wv); }
                    } else if (it >= 64 && it < 96) { if (PHON(2)) { const int sb = (it - 64) >> 2, hh = (it - 64) & 3; const size_t si = (size_t)(layer * 8 + sb) * 4 + hh;
                        mlstm_item((LAS char*)lds, Pb, Gt, MIX, as_global(args.in[10]) + layer * 1024, (size_t)MP + sb * 16, hh, 1, 16, as_global(args.in[5]) + si * 32768, as_global(args.in[6]) + si * 128, as_global(args.in[7]) + si,
                                   out + O_CS + si * 32768, out + O_NS + si * 128, out + O_MS + si, wv); }
                    } else if (it < 64) { if (PHON(3)) { const int sb = it >> 3, h = it & 7;
                        fox_sample_item((LAS char*)lds, Pb, lfS, as_global(args.in[2]) + (size_t)layer * SBATCH * PAST * 1024, as_global(args.in[3]) + (size_t)layer * SBATCH * PAST * 1024,
                                        as_global(args.in[4]) + (size_t)layer * SBATCH * PAST * 8, MIX, sb, h, wv); }
                    } else if (PHON(4)) { const int qb = 15 - ((it - 96) >> 5), bh = (it - 96) & 31;
                        fox_prompt_unit((LAS char*)lds, Pb, lfT, MIX, bh >> 3, bh & 7, qb, wv); }
                } }
                GRID_SYNC();
                for (int r2 = 0; r2 < (REP_STAGE == 2 ? 2 : 1); ++r2) { if (r2) GRID_SYNC();
                if (PHON(2)) mlstm_passB(UC, GS, NL, NSV, MSV, out + O_CP + (size_t)layer * 16 * 32768, out + O_NP + (size_t)layer * 16 * 128, out + O_MP + layer * 16,
                                        (int)blockIdx.x * 512 + opaque_tid(wv), G * 512); }
                GRID_SYNC();
                for (int r2 = 0; r2 < (REP_STAGE == 3 ? 2 : 1); ++r2) { if (r2) GRID_SYNC();
                for (int it = (int)blockIdx.x; it < 1024; it += G) {
                    __syncthreads();
                    if (PHON(2)) { const int ci = it, chain = ci >> 6, j = ci & 63;
                        mlstm_passC((LAS char*)lds, Pb, Gt, UC, GS, NSV, MSV, MIX, as_global(args.in[10]) + layer * 1024, ci, j, (size_t)(chain >> 2) * SEQ + 64 * j, chain & 3, wv); }
                } }
            } else if (sub == 2) { if (PHON(5)) {
                { pg8::Gemm g{MIX, (const bf16_t*)(ws + (layer ? WS_WOUT2 : WS_WOUT)), MP, DM, DM, DM}; pg8::StaticOrder S; S.init(MP, DM, G, (int)blockIdx.x);
                  EpiRes E{XB, Z};
                  pg8::gemm_phase<EpiRes, pg8::StaticOrder, true, true>(lds, g, S, E, wv); }
                { pg8::Gemm g{MIX, (const bf16_t*)(ws + (layer ? WS_WOUT2 : WS_WOUT)), MPAD, DM, DM / NSL_OUT, DM}; pg8::SplitOrder S; S.init(DM, NSL_OUT, MP / 256, G, (int)blockIdx.x);
                  EpiPart E{PART};
                  pg8::gemm_phase<EpiPart, pg8::SplitOrder, true, true>(lds, g, S, E, wv); } }
            } else if (sub == 3) {
                if (PHON(6)) ln_phase(Z, XB, PART, NSL_OUT, as_global(args.in[12]) + layer * DM, as_global(args.in[13]) + layer * DM, XB, nullptr, nullptr, gw, NGW, KT_LANE(), (LAS float*)lds, wave, (int)blockIdx.x, G);
            } else if (sub == 4) { if (PHON(7)) {
                pg8::Gemm g{XB, (const bf16_t*)(ws + (layer ? WS_WUP2 : WS_WUP)), MPAD, DFF, DM, DM}; pg8::StaticOrder S; S.init(MPAD, DFF, G, (int)blockIdx.x);
                EpiUp E{Hb};
                pg8::gemm_phase<EpiUp, pg8::StaticOrder, true, true>(lds, g, S, E, wv);
                {
                    const int first = layer == 0 ? 0 : NCONV_EARLY, nitems = (layer == 0 ? NCONV_EARLY : 32 * 200 + 32 * 64 + 32 * 256 + 128 * 64 - NCONV_EARLY) / 16;
                    LAS int* slot = (LAS int*)(lds + LDS_BYTES - 64);
                    for (;;) {
                        __syncthreads();
                        if (opaque_tid(wv) == 0) slot[0] = (int)atomicAdd(ctl + 64 * (13 + layer), 1u);
                        __syncthreads();
                        const int it = slot[0];
                        if (it >= nitems) break;
                        const int c0i = first + it * 16;
                        convert_weights(args, 1, (LAS float*)(lds + wave * 16384), c0i + wave, 8, KT_LANE(), c0i + 16); } } }
            } else if (sub == 5) { if (PHON(8)) {
                { pg8::Gemm g{Hb, (const bf16_t*)(ws + WS_WDN), MP, DM, DFF, DFF}; pg8::StaticOrder S; S.init(MP, DM, G, (int)blockIdx.x);
                  EpiRes E{XB, Z};
                  pg8::gemm_phase<EpiRes, pg8::StaticOrder, true, true>(lds, g, S, E, wv); }
                { pg8::Gemm g{Hb, (const bf16_t*)(ws + WS_WDN), MPAD, DM, DFF / NSL_DN, DFF}; pg8::SplitOrder S; S.init(DM, NSL_DN, MP / 256, G, (int)blockIdx.x);
                  EpiPart E{PART};
                  pg8::gemm_phase<EpiPart, pg8::SplitOrder, true, true>(lds, g, S, E, wv); } }
            } else if (PHON(9)) {
                if (layer == 0) { ln_phase(Z, XB, PART, NSL_DN, as_global(args.in[16]), as_global(args.in[17]), XB, nullptr, nullptr, gw, NGW, KT_LANE(), (LAS float*)lds, wave, (int)blockIdx.x, G);
                    }
                else ln_phase(Z, XB, PART, NSL_DN, as_global(args.in[16]) + DM, as_global(args.in[17]) + DM, nullptr, out + O_YP, out + O_YS, gw, NGW, KT_LANE(), (LAS float*)lds, wave, (int)blockIdx.x, G);
            }
        }
        if (rep + 1 < nrep) GRID_SYNC();
      }
        if (ph + 1 < args.ph_hi) GRID_SYNC();
    }
}

extern "C" void kernel_launch(void* const* d_in, const int* in_sizes, int n_in, void* d_out, int out_size, void* d_ws, size_t ws_size, hipStream_t stream) {
    static int grid = 0;
    if (grid == 0) {
        if (n_in != 18 || (size_t)out_size != O_END || ws_size < WS_END) { fprintf(stderr, "kernel_launch: unexpected shapes (n_in %d out %d ws %zu)\n", n_in, out_size, ws_size); grid = -1; return; }
        int dev = 0, cus = 0, per_cu = 0;
        hipGetDevice(&dev); hipDeviceGetAttribute(&cus, hipDeviceAttributeMultiprocessorCount, dev);
        hipFuncSetAttribute((const void*)fwd_megakernel, hipFuncAttributeMaxDynamicSharedMemorySize, LDS_BYTES);
        hipOccupancyMaxActiveBlocksPerMultiprocessor(&per_cu, (const void*)fwd_megakernel, 512, LDS_BYTES);
        (void)hipGetLastError();
        if (per_cu < 1) per_cu = 1;
        grid = cus;
        if (grid > cus * per_cu) grid = cus * per_cu;
    }
    if (grid < 0) return;
    hipMemsetAsync((char*)d_ws + WS_CTL, 0, 65536, stream);
    Args a{};
    for (int i = 0; i < 18; ++i) a.in[i] = (const float*)d_in[i];
    a.out = (float*)d_out; a.ws = (unsigned char*)d_ws; a.ph_lo = 0; a.ph_hi = NPHASE;
    void* kargs[] = {&a};
    hipError_t e = hipLaunchCooperativeKernel((const void*)fwd_megakernel, dim3(grid), dim3(512), kargs, LDS_BYTES, stream);
    if (e != hipSuccess) fprintf(stderr, "cooperative launch failed: %s (grid %d)\n", hipGetErrorString(e), grid);
}
```

```cpp
#include <hip/hip_runtime.h>
#include <hip/hip_cooperative_groups.h>
#include <cstdio>
#include <cstdint>
namespace cg = cooperative_groups;

constexpr int DM = 2048, NBATCH = 4, SEQ = 4096, MP = NBATCH * SEQ;
constexpr int SBATCH = 8, SLEN = 16, MS = SBATCH * SLEN;
constexpr int MT = MP + MS, MPAD = 16640;
constexpr int PAST = 1024, HA = 4, DVA = 256, DKA = 128, HB = 8, DHB = 128, DFF = 8192;
constexpr int NP = 6144;
constexpr int NIN = 6400, NINSRC = 6160;
constexpr int PC_QA = 0, PC_KA = 512, PC_VA = 1024, PC_OA = 2048, PC_QB = 3072, PC_KB = 4096, PC_VB = 5120;
constexpr float ALPHA = 1.4142135623730951f;
constexpr float LN_EPS = 1e-5f, HN_EPS = 1e-6f;
constexpr float LOG2E = 1.4426950408889634f;
constexpr float QA_SCALE = 0.08838834764831845f;
constexpr float QB_SCALE = 0.08838834764831845f * 1.4426950408889634f;

constexpr size_t O_YP = 0, O_YS = O_YP + (size_t)MP * DM, O_KP = O_YS + (size_t)MS * DM, O_VP = O_KP + (size_t)2 * MP * 1024,
                 O_LFP = O_VP + (size_t)2 * MP * 1024, O_CP = O_LFP + (size_t)2 * MP * 8, O_NP = O_CP + (size_t)2 * 4 * 4 * 256 * 128,
                 O_MP = O_NP + (size_t)2 * 4 * 4 * 128, O_KS = O_MP + 32, O_VS = O_KS + (size_t)2 * MS * 1024, O_LFS = O_VS + (size_t)2 * MS * 1024,
                 O_CS = O_LFS + (size_t)2 * MS * 8, O_NS = O_CS + (size_t)2 * 8 * 4 * 256 * 128, O_MS = O_NS + (size_t)2 * 8 * 4 * 128, O_END = O_MS + 64;

constexpr size_t MiB = 1u << 20;
constexpr size_t WS_CTL = 0;
constexpr size_t WS_WIN = 1 * MiB;
constexpr size_t WS_WOUT = 26 * MiB;
constexpr size_t WS_WUP = 34 * MiB;
constexpr size_t WS_WDN = 66 * MiB;
constexpr size_t WS_XB = 98 * MiB;
constexpr size_t WS_G = 163 * MiB;
constexpr size_t WS_LFT = WS_G + (size_t)MPAD * 16 * 4;
constexpr size_t WS_LFS = WS_LFT + (size_t)32 * 4096 * 4;
constexpr size_t WS_Z = 166 * MiB;
constexpr size_t WS_P = 296 * MiB;
constexpr size_t WS_MIX = WS_P + (size_t)MPAD * NP * 2;
constexpr size_t WS_H = WS_P;
constexpr size_t WS_PART = WS_P + (size_t)MPAD * DFF * 2;
constexpr size_t WS_WOUT2 = WS_PART + (size_t)32 * MS * DM * 4;
constexpr size_t WS_WUP2 = WS_WOUT2 + 8 * MiB;
constexpr size_t WS_END = WS_WUP2 + 32 * MiB;
constexpr int NSL_OUT = 16, NSL_DN = 32;
static_assert(WS_LFS + 64 * 16 * 4 <= WS_Z && WS_Z + (size_t)MPAD * DM * 4 <= WS_P && WS_MIX + (size_t)MPAD * DM * 2 <= WS_PART, "ws map");

#define LAS __attribute__((address_space(3)))
#define GAS __attribute__((address_space(1)))
typedef unsigned short bf16_t;
typedef short bf16x8 __attribute__((ext_vector_type(8)));
typedef short s16x4 __attribute__((ext_vector_type(4)));
typedef float f32x2 __attribute__((ext_vector_type(2)));
typedef float f32x4 __attribute__((ext_vector_type(4)));
typedef float f32x16 __attribute__((ext_vector_type(16)));
typedef unsigned u32x2 __attribute__((ext_vector_type(2)));
typedef unsigned u32x4 __attribute__((ext_vector_type(4)));
typedef __bf16 bf16x2_t __attribute__((ext_vector_type(2)));

__device__ __forceinline__ int opaque_tid(int wv) { int l; asm volatile("v_mbcnt_lo_u32_b32 %0, -1, 0\n\tv_mbcnt_hi_u32_b32 %0, -1, %0" : "=v"(l)); return wv * 64 + l; }
template <class T> __device__ __forceinline__ T* as_global(T* p) { return (T*)(__attribute__((address_space(1))) T*)p; }
__device__ __forceinline__ float bf2f(unsigned short u) { return __uint_as_float((unsigned)u << 16); }
__device__ __forceinline__ float bflo(unsigned u) { return __uint_as_float(u << 16); }
__device__ __forceinline__ float bfhi(unsigned u) { return __uint_as_float(u & 0xffff0000u); }
__device__ __forceinline__ unsigned pkbf(float lo, float hi) { f32x2 v = {lo, hi}; bf16x2_t b = __builtin_convertvector(v, bf16x2_t); return __builtin_bit_cast(unsigned, b); }
__device__ __forceinline__ float log_sigmoid(float x) {
    const float e = __expf(-fabsf(x));
    const float l = e < 0.03125f ? e * (1.0f - e * (0.5f - e * (0.33333334f - 0.25f * e))) : __logf(1.0f + e);
    return fminf(x, 0.f) - l; }
__device__ __forceinline__ int crow(int r, int hi) { return (r & 3) + 8 * (r >> 2) + 4 * hi; }
__device__ __forceinline__ s16x4 lds_tr(LAS const char* p) { return __builtin_bit_cast(s16x4, __builtin_amdgcn_ds_read_tr16_b64_v4i16((LAS s16x4*)p)); }
__device__ __forceinline__ bf16x8 cat44(s16x4 a, s16x4 b) { return (bf16x8){a[0], a[1], a[2], a[3], b[0], b[1], b[2], b[3]}; }

namespace pg8 {
#define PG8_LAS __attribute__((address_space(3)))
typedef unsigned short bf16_t;
typedef short bf16x8 __attribute__((ext_vector_type(8)));
typedef float f32x4 __attribute__((ext_vector_type(4)));
typedef unsigned u32x4 __attribute__((ext_vector_type(4)));
constexpr int BM = 256, BK = 64, HALF = 128, HTB = HALF * BK * 2  , STAGE_BYTES = 8 * HTB, NXCD = 8, WGM = 8;

__host__ __device__ __forceinline__ int lds_byte(int r, int c) { const int st = (r >> 4) * 2 + (c >> 5), rr = r & 15, cc = c & 31, ob = rr * 64 + cc * 2; return st * 1024 + (ob ^ (((ob >> 9) & 1) << 5)); }
__host__ __device__ __forceinline__ void stage_rc(int b, int& R, int& C) { const int st = b / 1024, sb = b % 1024, swz = sb ^ (((sb >> 9) & 1) << 5); R = (st >> 1) * 16 + swz / 64; C = (st & 1) * 32 + (swz % 64) / 2; }
__host__ __device__ __forceinline__ int perm32(int rho) { const int n = rho >> 4, i = rho & 15; return 8 * (i >> 2) + 4 * n + (i & 3); }

struct Unit { int pm, pn, pk; };
struct Gemm { const bf16_t* A; const bf16_t* Bt; int M, N, K, ld; };

struct StaticOrder {
    int nM, nN, nwg, G, c;
    __host__ __device__ void init(int M, int N, int G_, int c_) { nM = M / BM; nN = N / BM; nwg = nM * nN; G = G_; c = c_; }
    __host__ __device__ bool next(int i, Unit& u) const {
        const long L = (long)i * G + c; if (L >= nwg) return false;
        int wgid = (int)L; { const int q = nwg / NXCD, r = nwg % NXCD, xcd = wgid % NXCD, off = wgid / NXCD; wgid = (xcd < r ? xcd * (q + 1) : r * (q + 1) + (xcd - r) * q) + off; }
        const int nig = WGM * nN, gid = wgid / nig, fm = gid * WGM, gsz = (nM - fm) < WGM ? (nM - fm) : WGM;
        u.pm = fm + ((wgid % nig) % gsz); u.pn = (wgid % nig) / gsz; u.pk = 0; return true;
    }
    __device__ __forceinline__ void a_ready(const Unit&) const {}
    __device__ __forceinline__ void done(const Unit&) const {}
};

__device__ __forceinline__ unsigned cvt_pk_bf16(float lo, float hi) { unsigned r; asm volatile("v_cvt_pk_bf16_f32 %0, %1, %2" : "=v"(r) : "v"(lo), "v"(hi)); return r; }
typedef float f32x2 __attribute__((ext_vector_type(2)));
struct SplitOrder {
    int nN, np, G, c, pm0;
    __host__ __device__ void init(int N, int nsl, int pm0_, int G_, int c_) { nN = N / BM; np = nN * nsl; G = G_; c = c_; pm0 = pm0_; }
    __host__ __device__ bool next(int i, Unit& u) const { const long L = (long)i * G + c; if (L >= np) return false; u.pm = pm0; u.pn = (int)(L % nN); u.pk = (int)(L / nN); return true; }
    __device__ __forceinline__ void a_ready(const Unit&) const {}
    __device__ __forceinline__ void done(const Unit&) const {}
};
template <class Epi, class Sched, bool ALIGN_EPI = false, bool SP2 = false>
__device__ __forceinline__ void gemm_phase(PG8_LAS unsigned char* lds, const Gemm g, const Sched& S, const Epi& E, const int wv) {
    const int tid = opaque_tid(wv), wid = __builtin_amdgcn_readfirstlane(tid >> 6), lane = tid & 63, wr = wid >> 2, wc = wid & 3, fr = lane & 15, fq = lane >> 4;
    const int K = g.K, nt = K / BK;
    unsigned voffA[2], voffB[2];
#pragma unroll
    for (int i = 0; i < 2; ++i) { int R, C; stage_rc(tid * 16 + i * 8192, R, C); const int Rb = Epi::PERM ? ((R & ~31) + perm32(R & 31)) : R;
        voffA[i] = (unsigned)(R * g.ld + C) * 2u; voffB[i] = (unsigned)(Rb * g.ld + C) * 2u; }
    const size_t kstep = (size_t)(BK * 2);
    const size_t hstep = (size_t)HALF * g.ld * 2;
    const size_t tstep = 2 * hstep;
    const unsigned ldsw = (unsigned)wid * 1024u;
    const int aoff = lds_byte(wr * 64 + fr, fq * 8), boff = lds_byte(wc * 32 + fr, fq * 8);
#define PG8_SA(b, h) (((b) * 2 + (h)) * HTB)
#define PG8_SB(b, h) ((4 + (b) * 2 + (h)) * HTB)
#define PG8_STAGE(bufoff, gbase, voff) do { _Pragma("unroll") for (int _i = 0; _i < 2; ++_i) \
        __builtin_amdgcn_global_load_lds((const unsigned*)((const char*)(gbase) + (voff)[_i]), (PG8_LAS unsigned*)(lds + (bufoff) + ldsw + _i * 8192), 16, 0, 0); } while (0)
#define PG8_LDA(dst, b, h) do { _Pragma("unroll") for (int m = 0; m < 4; ++m) _Pragma("unroll") for (int k = 0; k < 2; ++k) dst[m][k] = *(const PG8_LAS bf16x8*)(lds + PG8_SA(b, h) + aoff + m * 2048 + k * 1024); } while (0)
#define PG8_LDB(dst, b, h) do { _Pragma("unroll") for (int n = 0; n < 2; ++n) _Pragma("unroll") for (int k = 0; k < 2; ++k) dst[n][k] = *(const PG8_LAS bf16x8*)(lds + PG8_SB(b, h) + boff + n * 2048 + k * 1024); } while (0)
#define PG8_MMA(ai, bj, At, Bt) do { __builtin_amdgcn_s_setprio(1); _Pragma("unroll") for (int m = 0; m < 4; ++m) _Pragma("unroll") for (int n = 0; n < 2; ++n) _Pragma("unroll") for (int k = 0; k < 2; ++k) \
        acc[ai][bj][m][n] = __builtin_amdgcn_mfma_f32_16x16x32_bf16(Bt[n][k], At[m][k], acc[ai][bj][m][n], 0, 0, 0); __builtin_amdgcn_s_setprio(0); } while (0)
#define PG8_WAIT_V(n) asm volatile("s_waitcnt vmcnt(" #n ")" ::: "memory")
#define PG8_WAIT_L(n) asm volatile("s_waitcnt lgkmcnt(" #n ")" ::: "memory")
#define PG8_BAR __builtin_amdgcn_s_barrier()
#define PG8_SCHED __builtin_amdgcn_sched_barrier(0)
    Unit cur, nxt; int ui = 0;
    if (!S.next(0, cur)) return;
    f32x4 acc[2][2][4][2];
#pragma unroll
    for (int a = 0; a < 2; ++a)
#pragma unroll
        for (int b = 0; b < 2; ++b)
#pragma unroll
            for (int m = 0; m < 4; ++m)
#pragma unroll
                for (int n = 0; n < 2; ++n) acc[a][b][m][n] = (f32x4){0.f, 0.f, 0.f, 0.f};
    bf16x8 At[4][2], B0[2][2], B1[2][2];
    const char* cA = (const char*)g.A + (size_t)cur.pm * tstep + (size_t)cur.pk * K * 2; const char* cB = (const char*)g.Bt + (size_t)cur.pn * tstep + (size_t)cur.pk * K * 2;
    S.a_ready(cur);
    if constexpr (SP2) {
        PG8_STAGE(PG8_SB(0, 0), cB, voffB); PG8_STAGE(PG8_SB(0, 1), cB + hstep, voffB); PG8_STAGE(PG8_SA(0, 0), cA, voffA); PG8_STAGE(PG8_SA(0, 1), cA + hstep, voffA);
        if (wr == 1) PG8_BAR;
        PG8_WAIT_V(2); PG8_BAR;
        PG8_STAGE(PG8_SB(1, 0), cB + kstep, voffB); PG8_STAGE(PG8_SA(1, 0), cA + kstep, voffA); PG8_STAGE(PG8_SB(1, 1), cB + hstep + kstep, voffB);
        PG8_WAIT_V(6); PG8_BAR;
    } else {
        PG8_STAGE(PG8_SB(0, 0), cB, voffB); PG8_STAGE(PG8_SA(0, 0), cA, voffA); PG8_STAGE(PG8_SB(0, 1), cB + hstep, voffB); PG8_STAGE(PG8_SA(0, 1), cA + hstep, voffA);
        if (wr == 1) PG8_BAR;
        PG8_WAIT_V(4); PG8_BAR;
        PG8_STAGE(PG8_SB(1, 0), cB + kstep, voffB); PG8_STAGE(PG8_SA(1, 0), cA + kstep, voffA); PG8_STAGE(PG8_SB(1, 1), cB + hstep + kstep, voffB);
        PG8_WAIT_V(6); PG8_BAR;
    }
    for (;;) {
        const bool has_next = S.next(ui + 1, nxt);
        const char* nA = has_next ? (const char*)g.A + (size_t)nxt.pm * tstep + (size_t)nxt.pk * K * 2 : cA; const char* nB = has_next ? (const char*)g.Bt + (size_t)nxt.pn * tstep + (size_t)nxt.pk * K * 2 : cB;
        for (int t = 0; t < nt; t += 2) {
            const bool last = (t == nt - 2);
            const char* a1 = cA + (size_t)(t + 1) * kstep;
            const char* a2 = last ? nA : cA + (size_t)(t + 2) * kstep; const char* b2 = last ? nB : cB + (size_t)(t + 2) * kstep;
            const char* a3 = a2 + kstep; const char* b3 = b2 + kstep;
            if (last && has_next) S.a_ready(nxt);
            if constexpr (SP2) {
            PG8_LDB(B0, 0, 0); PG8_LDB(B1, 0, 1); PG8_SCHED; PG8_LDA(At, 0, 0); PG8_STAGE(PG8_SA(1, 1), a1 + hstep, voffA);
            PG8_WAIT_V(8); PG8_WAIT_L(0); PG8_BAR; PG8_MMA(0, 0, At, B0); PG8_MMA(0, 1, At, B1); PG8_BAR; PG8_SCHED;
            PG8_LDA(At, 0, 1); PG8_STAGE(PG8_SB(0, 0), b2, voffB); PG8_STAGE(PG8_SB(0, 1), b2 + hstep, voffB); PG8_STAGE(PG8_SA(0, 0), a2, voffA);
            PG8_WAIT_V(8); PG8_WAIT_L(0); PG8_BAR; PG8_MMA(1, 0, At, B0); PG8_MMA(1, 1, At, B1); PG8_BAR; PG8_SCHED;
            PG8_LDB(B0, 1, 0); PG8_LDB(B1, 1, 1); PG8_SCHED; PG8_LDA(At, 1, 0); PG8_STAGE(PG8_SA(0, 1), a2 + hstep, voffA);
            PG8_WAIT_V(8); PG8_WAIT_L(0); PG8_BAR; PG8_MMA(0, 0, At, B0); PG8_MMA(0, 1, At, B1); PG8_BAR; PG8_SCHED;
            PG8_LDA(At, 1, 1); PG8_STAGE(PG8_SB(1, 0), b3, voffB); PG8_STAGE(PG8_SB(1, 1), b3 + hstep, voffB); PG8_STAGE(PG8_SA(1, 0), a3, voffA);
            PG8_WAIT_V(8); PG8_WAIT_L(0); PG8_BAR; PG8_MMA(1, 0, At, B0); PG8_MMA(1, 1, At, B1); PG8_BAR; PG8_SCHED;
            } else {
            PG8_LDB(B0, 0, 0); PG8_SCHED; PG8_LDA(At, 0, 0); PG8_STAGE(PG8_SA(1, 1), a1 + hstep, voffA);
            PG8_WAIT_L(8); PG8_BAR; PG8_WAIT_L(0); PG8_MMA(0, 0, At, B0); PG8_BAR; PG8_SCHED;
            PG8_LDB(B1, 0, 1); PG8_STAGE(PG8_SB(0, 0), b2, voffB);
            PG8_BAR; PG8_WAIT_L(0); PG8_MMA(0, 1, At, B1); PG8_BAR;
            PG8_LDA(At, 0, 1); PG8_STAGE(PG8_SA(0, 0), a2, voffA);
            PG8_BAR; PG8_WAIT_L(0); PG8_MMA(1, 0, At, B0); PG8_BAR; PG8_SCHED;
            PG8_STAGE(PG8_SB(0, 1), b2 + hstep, voffB);
            PG8_WAIT_V(6); PG8_BAR; PG8_MMA(1, 1, At, B1); PG8_BAR;
            PG8_LDB(B0, 1, 0); PG8_SCHED; PG8_LDA(At, 1, 0); PG8_STAGE(PG8_SA(0, 1), a2 + hstep, voffA);
            PG8_WAIT_L(8); PG8_BAR; PG8_WAIT_L(0); PG8_MMA(0, 0, At, B0); PG8_BAR; PG8_SCHED;
            PG8_LDB(B1, 1, 1); PG8_STAGE(PG8_SB(1, 0), b3, voffB);
            PG8_BAR; PG8_WAIT_L(0); PG8_MMA(0, 1, At, B1); PG8_BAR;
            PG8_LDA(At, 1, 1); PG8_STAGE(PG8_SA(1, 0), a3, voffA);
            PG8_BAR; PG8_WAIT_L(0); PG8_MMA(1, 0, At, B0); PG8_BAR; PG8_SCHED;
            PG8_STAGE(PG8_SB(1, 1), b3 + hstep, voffB);
            PG8_WAIT_V(6); PG8_BAR; PG8_MMA(1, 1, At, B1); PG8_BAR;
            }
        }
        if constexpr (ALIGN_EPI) { if (wr == 0) PG8_BAR; }
        if constexpr (!Epi::AFTER_DRAIN) { E(acc, cur, wr, wc, fr, fq); S.done(cur); }
        if (!has_next) break;
#pragma unroll
        for (int a = 0; a < 2; ++a)
#pragma unroll
            for (int b = 0; b < 2; ++b)
#pragma unroll
                for (int m = 0; m < 4; ++m)
#pragma unroll
                    for (int n = 0; n < 2; ++n) acc[a][b][m][n] = (f32x4){0.f, 0.f, 0.f, 0.f};
        cur = nxt; cA = nA; cB = nB; ++ui;
        if constexpr (ALIGN_EPI) { if (wr == 1) PG8_BAR; }
    }
    PG8_WAIT_V(0);
    if constexpr (!ALIGN_EPI) { if (wr == 0) PG8_BAR; }
    PG8_BAR;
    if constexpr (Epi::AFTER_DRAIN) { E.fused(acc, cur, wr, wc, fr, fq, lds, wid, lane); S.done(cur); }
#undef PG8_SA
#undef PG8_SB
#undef PG8_STAGE
#undef PG8_LDA
#undef PG8_LDB
#undef PG8_MMA
#undef PG8_WAIT_V
#undef PG8_WAIT_L
#undef PG8_BAR
#undef PG8_SCHED
}
}

struct EpiIn {
    static constexpr bool PERM = true, AFTER_DRAIN = false;
    bf16_t* P; float* G; float* lfT; float* lfS; const float* bg; float* kp; float* vp; float* ks; float* vs; float* lfp; float* lfs;
    __device__ __forceinline__ void operator()(const f32x4 (&acc)[2][2][4][2], const pg8::Unit& u, int wr, int wc, int fr, int fq) const {
        const int pn = u.pn, row0 = u.pm * 256 + wr * 64 + fr;
        if (pn < 24) {
            float sc = 1.f; if (pn < 2) sc = QA_SCALE; else if (pn >= 12 && pn < 16) sc = QB_SCALE;
            const int col0 = pn * 256 + wc * 32 + 8 * fq;
            const bool kv = pn >= 16; const bool isv = pn >= 20; const int fcol0 = (pn - (isv ? 20 : 16)) * 256 + wc * 32 + 8 * fq;
#pragma unroll
            for (int ai = 0; ai < 2; ++ai)
#pragma unroll
                for (int m = 0; m < 4; ++m) { const int row = row0 + ai * 128 + m * 16;
#pragma unroll
                    for (int bj = 0; bj < 2; ++bj) { const f32x4 v0 = acc[ai][bj][m][0] * sc, v1 = acc[ai][bj][m][1] * sc;
                        u32x4 w; w.x = pkbf(v0[0], v0[1]); w.y = pkbf(v0[2], v0[3]); w.z = pkbf(v1[0], v1[1]); w.w = pkbf(v1[2], v1[3]);
                        *(GAS u32x4*)(P + (size_t)row * NP + col0 + bj * 128) = w;
                        if (kv && row < MT) { float* dst = row < MP ? (isv ? vp : kp) + (size_t)row * 1024 : (isv ? vs : ks) + (size_t)(row - MP) * 1024;
                            dst += fcol0 + bj * 128; *(GAS f32x4*)dst = v0; *(GAS f32x4*)(dst + 4) = v1; } } }
        } else if (wc == 0 && fq < 2) {
#pragma unroll
            for (int ai = 0; ai < 2; ++ai)
#pragma unroll
                for (int m = 0; m < 4; ++m) { const int row = row0 + ai * 128 + m * 16;
                    if (row < MT) {
#pragma unroll
                        for (int n = 0; n < 2; ++n)
#pragma unroll
                            for (int i = 0; i < 4; ++i) { const int c = 8 * fq + 4 * n + i; float gt = acc[ai][0][m][n][i] + ((const GAS float*)bg)[c];
                                if (c >= 4) gt = log_sigmoid(gt);
                                ((GAS float*)G)[(size_t)row * 16 + c] = gt;
                                if (c >= 8) { const int h = c - 8;
                                    if (row < MP) { ((GAS float*)lfp)[(size_t)row * 8 + h] = gt; ((GAS float*)lfT)[(size_t)((row >> 12) * 8 + h) * 4096 + (row & 4095)] = gt; }
                                    else { const int rs = row - MP; ((GAS float*)lfs)[(size_t)rs * 8 + h] = gt; ((GAS float*)lfS)[((rs >> 4) * 8 + h) * 16 + (rs & 15)] = gt; } } } } }
        }
    }
};
struct EpiRes {
    static constexpr bool PERM = true, AFTER_DRAIN = false;
    const bf16_t* R; bf16_t* Z;
    __device__ __forceinline__ void operator()(const f32x4 (&acc)[2][2][4][2], const pg8::Unit& u, int wr, int wc, int fr, int fq) const {
        const int row0 = u.pm * 256 + wr * 64 + fr, col0 = u.pn * 256 + wc * 32 + 8 * fq;
#pragma unroll
        for (int ai = 0; ai < 2; ++ai)
#pragma unroll
            for (int m = 0; m < 4; ++m) { const size_t off = (size_t)(row0 + ai * 128 + m * 16) * DM + col0;
#pragma unroll
                for (int bj = 0; bj < 2; ++bj) { const u32x4 r = *(const GAS u32x4*)(R + off + bj * 128);
                    f32x4 v0 = acc[ai][bj][m][0], v1 = acc[ai][bj][m][1];
                    v0[0] += ALPHA * bflo(r.x); v0[1] += ALPHA * bfhi(r.x); v0[2] += ALPHA * bflo(r.y); v0[3] += ALPHA * bfhi(r.y);
                    v1[0] += ALPHA * bflo(r.z); v1[1] += ALPHA * bfhi(r.z); v1[2] += ALPHA * bflo(r.w); v1[3] += ALPHA * bfhi(r.w);
                    u32x4 w; w.x = pkbf(v0[0], v0[1]); w.y = pkbf(v0[2], v0[3]); w.z = pkbf(v1[0], v1[1]); w.w = pkbf(v1[2], v1[3]);
                    *(GAS u32x4*)(Z + off + bj * 128) = w; } }
    }
};
struct EpiPart {
    static constexpr bool PERM = true, AFTER_DRAIN = false;
    float* part;
    __device__ __forceinline__ void operator()(const f32x4 (&acc)[2][2][4][2], const pg8::Unit& u, int wr, int wc, int fr, int fq) const {
        const int r0 = wr * 64 + fr, col0 = u.pn * 256 + wc * 32 + 8 * fq;
#pragma unroll
        for (int m = 0; m < 4; ++m) { float* dst = part + ((size_t)u.pk * MS + r0 + m * 16) * DM + col0;
#pragma unroll
            for (int bj = 0; bj < 2; ++bj) { *(GAS f32x4*)(dst + bj * 128) = acc[0][bj][m][0]; *(GAS f32x4*)(dst + bj * 128 + 4) = acc[0][bj][m][1]; } }
    }
};
struct EpiUp {
    static constexpr bool PERM = true, AFTER_DRAIN = false;
    bf16_t* H;
    __device__ __forceinline__ void operator()(const f32x4 (&acc)[2][2][4][2], const pg8::Unit& u, int wr, int wc, int fr, int fq) const {
        const int row0 = u.pm * 256 + wr * 64 + fr, col0 = u.pn * 256 + wc * 32 + 8 * fq;
#pragma unroll
        for (int ai = 0; ai < 2; ++ai)
#pragma unroll
            for (int m = 0; m < 4; ++m) { const size_t off = (size_t)(row0 + ai * 128 + m * 16) * DFF + col0;
#pragma unroll
                for (int bj = 0; bj < 2; ++bj) { f32x4 v0 = acc[ai][bj][m][0], v1 = acc[ai][bj][m][1];
#pragma unroll
                    for (int i = 0; i < 4; ++i) { const float a = fmaxf(v0[i], 0.f), b = fmaxf(v1[i], 0.f); v0[i] = a * a; v1[i] = b * b; }
                    u32x4 w; w.x = pkbf(v0[0], v0[1]); w.y = pkbf(v0[2], v0[3]); w.z = pkbf(v1[0], v1[1]); w.w = pkbf(v1[2], v1[3]);
                    *(GAS u32x4*)(H + off + bj * 128) = w; } }
    }
};

#define LDS_WAIT() asm volatile("s_waitcnt lgkmcnt(0)" ::: "memory")
__device__ __forceinline__ float scan_sum64(float x, int lane) {
#pragma unroll
    for (int o = 1; o < 64; o <<= 1) { const float y = __shfl_up(x, o); if (lane >= o) x += y; }
    return x;
}
__device__ __forceinline__ float scan_max64(float x, int lane) {
#pragma unroll
    for (int o = 1; o < 64; o <<= 1) { const float y = __shfl_up(x, o); if (lane >= o) x = fmaxf(x, y); }
    return x;
}
__device__ __forceinline__ float wave_sum64(float v) {
#pragma unroll
    for (int o = 1; o < 64; o <<= 1) v += __shfl_xor(v, o);
    return v;
}

__device__ __forceinline__ float xsum32(float x) { auto rr = __builtin_amdgcn_permlane32_swap(__float_as_uint(x), __float_as_uint(x), false, false); return __uint_as_float(rr[0]) + __uint_as_float(rr[1]); }
__device__ __forceinline__ float xmax32(float x) { auto rr = __builtin_amdgcn_permlane32_swap(__float_as_uint(x), __float_as_uint(x), false, false); return fmaxf(__uint_as_float(rr[0]), __uint_as_float(rr[1])); }
__device__ __forceinline__ float dpp_f(float x, const int ctrl_sel) {
    const int v = __float_as_int(x); int r;
    if (ctrl_sel == 0) r = __builtin_amdgcn_update_dpp(v, v, 0xB1, 0xF, 0xF, false);
    else if (ctrl_sel == 1) r = __builtin_amdgcn_update_dpp(v, v, 0x4E, 0xF, 0xF, false);
    else r = __builtin_amdgcn_update_dpp(v, v, 0x141, 0xF, 0xF, false);
    return __int_as_float(r);
}
__device__ __forceinline__ float bperm_f(int srclane, float x) { return __int_as_float(__builtin_amdgcn_ds_bpermute(srclane << 2, __float_as_int(x))); }
__device__ __forceinline__ float scan_sum64l(float x, int lane) {
#pragma unroll
    for (int o = 1; o < 64; o <<= 1) { const float y = bperm_f(lane - o, x); if (lane >= o) x += y; }
    return x;
}
__device__ __forceinline__ float scan_max64l(float x, int lane) {
#pragma unroll
    for (int o = 1; o < 64; o <<= 1) { const float y = bperm_f(lane - o, x); if (lane >= o) x = fmaxf(x, y); }
    return x;
}
__device__ __forceinline__ f32x16 mfma32(bf16x8 a, bf16x8 b, f32x16 c) { return __builtin_amdgcn_mfma_f32_32x32x16_bf16(a, b, c, 0, 0, 0); }
__device__ __forceinline__ f32x4 mfma16(bf16x8 a, bf16x8 b, f32x4 c) { return __builtin_amdgcn_mfma_f32_16x16x32_bf16(a, b, c, 0, 0, 0); }
__device__ __forceinline__ float fexp2(float x) { return __builtin_amdgcn_exp2f(x); }

__device__ __forceinline__ void transpose_item(const float* W, int Nsrc, int K, bf16_t* WT, LAS float* scr, int item, int nblk, int lane, bool inmap) {
    const int kb = item / nblk, nb = item % nblk, k0 = 64 * kb, n0 = 32 * nb;
    const int nd = n0 + (lane & 31); int sc = nd;
    if (inmap) sc = nd < 3072 ? nd : (nd < 6144 ? nd + 8 : (nd < 6152 ? nd - 3072 : (nd < 6160 ? nd : -1)));
    float wv_[32];
    const GAS float* wp = (const GAS float*)W + (size_t)(k0 + (lane >> 5)) * Nsrc + (sc >= 0 ? sc : 0);
#pragma unroll
    for (int i = 0; i < 32; ++i) wv_[i] = wp[(size_t)(2 * i) * Nsrc];
#pragma unroll
    for (int i = 0; i < 32; ++i) scr[(2 * i + (lane >> 5)) * 33 + (lane & 31)] = sc >= 0 ? wv_[i] : 0.f;
    LDS_WAIT();
    const int c = lane & 7;
#pragma unroll
    for (int j = 0; j < 4; ++j) { const int n = (lane >> 3) + 8 * j; const LAS float* s = scr + (8 * c) * 33 + n;
        u32x4 o; o.x = pkbf(s[0 * 33], s[1 * 33]); o.y = pkbf(s[2 * 33], s[3 * 33]); o.z = pkbf(s[4 * 33], s[5 * 33]); o.w = pkbf(s[6 * 33], s[7 * 33]);
        *(GAS u32x4*)(WT + (size_t)(n0 + n) * K + k0 + 8 * c) = o; }
    LDS_WAIT();
}
struct Args { const float* in[18]; float* out; unsigned char* ws; int ph_lo, ph_hi; };

__device__ __forceinline__ void convert_weights(const Args& a, int layer, LAS float* scr, int gw, int NGW, int lane, int it_end = 1 << 30) {
    unsigned char* ws = as_global(a.ws);
    const float* w_in = as_global(a.in[8]) + (size_t)layer * DM * NINSRC; const float* w_out = as_global(a.in[11]) + (size_t)layer * DM * DM;
    const float* w_up = as_global(a.in[14]) + (size_t)layer * DM * DFF; const float* w_dn = as_global(a.in[15]) + (size_t)layer * DFF * DM;
    constexpr int I_IN = 32 * 200, I_OUT = 32 * 64, I_UP = 32 * 256, I_DN = 128 * 64;
    const int it_stop = it_end < I_IN + I_OUT + I_UP + I_DN ? it_end : I_IN + I_OUT + I_UP + I_DN;
    for (int it = gw; it < it_stop; it += NGW) {
        int r = it;
        if (r < I_IN) { transpose_item(w_in, NINSRC, DM, (bf16_t*)(ws + WS_WIN), scr, r, 200, lane, true); continue; } r -= I_IN;
        if (r < I_OUT) { transpose_item(w_out, DM, DM, (bf16_t*)(ws + (layer ? WS_WOUT2 : WS_WOUT)), scr, r, 64, lane, false); continue; } r -= I_OUT;
        if (r < I_UP) { transpose_item(w_up, DFF, DM, (bf16_t*)(ws + (layer ? WS_WUP2 : WS_WUP)), scr, r, 256, lane, false); continue; } r -= I_UP;
        transpose_item(w_dn, DM, DFF, (bf16_t*)(ws + WS_WDN), scr, r, 64, lane, false);
    }
}
__device__ __forceinline__ void convert_x(const Args& a, int gw, int NGW, int lane) {
    bf16_t* XB = (bf16_t*)(as_global(a.ws) + WS_XB);
    f32x4 xr[8];
#define CX_LOAD(row_) do { const GAS f32x4* x_ = (const GAS f32x4*)((row_) < MP ? as_global(a.in[0]) + (size_t)(row_) * DM : as_global(a.in[1]) + (size_t)((row_) - MP) * DM) + lane; _Pragma("unroll") for (int j = 0; j < 8; ++j) xr[j] = x_[64 * j]; } while (0)
    if (gw < MT) CX_LOAD(gw);
    for (int row = gw; row < MPAD; row += NGW) {
        GAS u32x2* o = (GAS u32x2*)(XB + (size_t)row * DM) + lane;
        if (row < MT) { u32x2 w[8];
#pragma unroll
            for (int j = 0; j < 8; ++j) { w[j].x = pkbf(xr[j][0], xr[j][1]); w[j].y = pkbf(xr[j][2], xr[j][3]); }
            if (row + NGW < MT) CX_LOAD(row + NGW);
#pragma unroll
            for (int j = 0; j < 8; ++j) o[64 * j] = w[j]; }
        else {
#pragma unroll
            for (int j = 0; j < 8; ++j) o[64 * j] = (u32x2){0u, 0u}; }
    }
#undef CX_LOAD
}
__device__ __forceinline__ void ln_phase(const bf16_t* Z, const bf16_t* RES, const float* part, int nsl, const float* g, const float* b, bf16_t* XB, float* outp, float* outs, int gw, int NGW, int lane,
                                         LAS float* scr, int wave, int bid, int nblk) {
    f32x4 gv[8], bv[8];
#pragma unroll
    for (int j = 0; j < 8; ++j) { gv[j] = ((const GAS f32x4*)g)[lane + 64 * j]; bv[j] = ((const GAS f32x4*)b)[lane + 64 * j]; }
#define LN_FINISH(v, row) do { float s = 0.f; \
        _Pragma("unroll") for (int j = 0; j < 8; ++j) s += (v[j][0] + v[j][1]) + (v[j][2] + v[j][3]); \
        const float mean = wave_sum64(s) * (1.f / DM); float s2 = 0.f; \
        _Pragma("unroll") for (int j = 0; j < 8; ++j) { v[j] = v[j] - mean; s2 += (v[j][0] * v[j][0] + v[j][1] * v[j][1]) + (v[j][2] * v[j][2] + v[j][3] * v[j][3]); } \
        const float rstd = 1.0f / sqrtf(wave_sum64(s2) * (1.f / DM) + LN_EPS); \
        _Pragma("unroll") for (int j = 0; j < 8; ++j) v[j] = v[j] * rstd * gv[j] + bv[j]; \
        if (XB) { GAS u32x2* o = (GAS u32x2*)(XB + (size_t)(row) * DM) + lane; \
            _Pragma("unroll") for (int j = 0; j < 8; ++j) { u32x2 w; w.x = pkbf(v[j][0], v[j][1]); w.y = pkbf(v[j][2], v[j][3]); o[64 * j] = w; } } \
        if (outp) { GAS f32x4* o = (GAS f32x4*)((row) < MP ? outp + (size_t)(row) * DM : outs + (size_t)((row) - MP) * DM) + lane; \
            _Pragma("unroll") for (int j = 0; j < 8; ++j) o[64 * j] = v[j]; } } while (0)
    for (int r = bid; r < MS; r += nblk) {
        f32x4 acc[8];
#pragma unroll
        for (int j = 0; j < 8; ++j) acc[j] = (f32x4){0.f, 0.f, 0.f, 0.f};
        for (int sl = wave; sl < nsl; sl += 8) { const GAS f32x4* p = (const GAS f32x4*)(part + ((size_t)sl * MS + r) * DM) + lane;
#pragma unroll
            for (int j = 0; j < 8; ++j) acc[j] += p[64 * j]; }
#pragma unroll
        for (int j = 0; j < 8; ++j) *(LAS f32x4*)(scr + wave * 2048 + (lane + 64 * j) * 4) = acc[j];
        __syncthreads();
        if (wave == 0) { const GAS u32x2* z_ = (const GAS u32x2*)(RES + (size_t)(MP + r) * DM) + lane; f32x4 v[8];
#pragma unroll
            for (int j = 0; j < 8; ++j) { const u32x2 w = z_[64 * j]; v[j] = (f32x4){ALPHA * bflo(w.x), ALPHA * bfhi(w.x), ALPHA * bflo(w.y), ALPHA * bfhi(w.y)}; }
#pragma unroll
            for (int w8 = 0; w8 < 8; ++w8)
#pragma unroll
                for (int j = 0; j < 8; ++j) v[j] += *(LAS const f32x4*)(scr + w8 * 2048 + (lane + 64 * j) * 4);
            LN_FINISH(v, MP + r); }
        __syncthreads();
    }
    u32x2 zr[8];
#define LN_LOAD(row_) do { const GAS u32x2* z_ = (const GAS u32x2*)(Z + (size_t)(row_) * DM) + lane; _Pragma("unroll") for (int j = 0; j < 8; ++j) zr[j] = z_[64 * j]; } while (0)
    if (gw < MP) LN_LOAD(gw);
    for (int row = gw; row < MP; row += NGW) {
        f32x4 v[8];
#pragma unroll
        for (int j = 0; j < 8; ++j) v[j] = (f32x4){bflo(zr[j].x), bfhi(zr[j].x), bflo(zr[j].y), bfhi(zr[j].y)};
        if (row + NGW < MP) LN_LOAD(row + NGW);
        LN_FINISH(v, row);
    }
#undef LN_LOAD
#undef LN_FINISH
}

constexpr int AT_K = 0, AT_V = 34816, AT_NF = 75776, AT_SCR = 92160, AVP = 320;
__device__ __forceinline__ void fox_prompt_unit(LAS char* L, const bf16_t* P, const float* lfT, bf16_t* MIX, int b, int h, int qb, const int wv) {
    const int tid = opaque_tid(wv), lane = tid & 63, wid = __builtin_amdgcn_readfirstlane(tid >> 6), r32 = lane & 31, hi = lane >> 5, i16 = lane & 15, cb = (lane >> 4) & 1;
    const int qend = 256 * (qb + 1), NT = 4 * (qb + 1);
    const size_t rowb = (size_t)b * SEQ;
    LAS float* nfk = (LAS float*)(L + AT_NF); LAS float* scr = (LAS float*)(L + AT_SCR);
    {
        float v[8]; const bool act = 8 * tid < qend;
        if (act) { const GAS f32x4* src = (const GAS f32x4*)(lfT + (size_t)(b * 8 + h) * 4096 + 8 * tid); const f32x4 a = src[0], c = src[1];
            v[0] = a[0]; v[1] = a[1]; v[2] = a[2]; v[3] = a[3]; v[4] = c[0]; v[5] = c[1]; v[6] = c[2]; v[7] = c[3]; }
        else {
#pragma unroll
            for (int i = 0; i < 8; ++i) v[i] = 0.f; }
#pragma unroll
        for (int i = 1; i < 8; ++i) v[i] += v[i - 1];
        const float tot = v[7]; const float x = scan_sum64(tot, lane);
        if (lane == 63) scr[wid] = x;
        __syncthreads();
        float off = 0.f;
        for (int w = 0; w < wid; ++w) off += scr[w];
        const float base = off + x - tot;
        if (act) {
#pragma unroll
            for (int i = 0; i < 8; ++i) nfk[8 * tid + i] = -(base + v[i]) * LOG2E; }
    }
    const bf16_t* Kg = P + rowb * NP + PC_KB + h * 128; const bf16_t* Vg = P + rowb * NP + PC_VB + h * 128;
    u32x4 kr[2], vr[2];
#define AT_LOAD(t) do { _Pragma("unroll") for (int i_ = 0; i_ < 2; ++i_) { const int c_ = tid + 512 * i_, row_ = c_ >> 4, ch_ = c_ & 15; \
        kr[i_] = *(const GAS u32x4*)(Kg + (size_t)(64 * (t) + row_) * NP + ch_ * 8); vr[i_] = *(const GAS u32x4*)(Vg + (size_t)(64 * (t) + row_) * NP + ch_ * 8); } } while (0)
#define AT_STORE(buf) do { _Pragma("unroll") for (int i_ = 0; i_ < 2; ++i_) { const int c_ = tid + 512 * i_, row_ = c_ >> 4, ch_ = c_ & 15; \
        *(LAS u32x4*)(L + AT_K + (buf) * 17408 + row_ * 272 + ch_ * 16) = kr[i_]; *(LAS u32x4*)(L + AT_V + (buf) * 20480 + row_ * AVP + ch_ * 16) = vr[i_]; } } while (0)
    bf16x8 qf[8];
    { const bf16_t* Qg = P + (rowb + 256 * qb + 32 * wid + r32) * NP + PC_QB + h * 128 + 8 * hi;
#pragma unroll
        for (int kk = 0; kk < 8; ++kk) qf[kk] = *(const GAS bf16x8*)(Qg + 16 * kk); }
    f32x16 o[4];
#pragma unroll
    for (int d = 0; d < 4; ++d)
#pragma unroll
        for (int r = 0; r < 16; ++r) o[d][r] = 0.f;
    float m = -INFINITY, l = 0.f;
    AT_LOAD(0); AT_STORE(0);
    __syncthreads();
    for (int t = 0; t < NT; ++t) {
        if (t + 1 < NT) AT_LOAD(t + 1);
        const int jb = t - (NT - 4);
        if (!(jb >= 0 && 64 * jb > 32 * wid + 31)) {
            LAS const char* Kb = L + AT_K + (t & 1) * 17408; LAS const char* Vb = L + AT_V + (t & 1) * 20480;
            LAS const float* nf = nfk + 64 * t;
            f32x16 s0, s1;
#pragma unroll
            for (int g = 0; g < 4; ++g) { const f32x4 a = *(LAS const f32x4*)(nf + 8 * g + 4 * hi), c = *(LAS const f32x4*)(nf + 32 + 8 * g + 4 * hi);
                s0[4 * g] = a[0]; s0[4 * g + 1] = a[1]; s0[4 * g + 2] = a[2]; s0[4 * g + 3] = a[3]; s1[4 * g] = c[0]; s1[4 * g + 1] = c[1]; s1[4 * g + 2] = c[2]; s1[4 * g + 3] = c[3]; }
            {
                bf16x8 ka[16];
#pragma unroll
                for (int kk = 0; kk < 8; ++kk) { ka[2 * kk] = *(LAS const bf16x8*)(Kb + r32 * 272 + kk * 32 + hi * 16); ka[2 * kk + 1] = *(LAS const bf16x8*)(Kb + (32 + r32) * 272 + kk * 32 + hi * 16); }
                __builtin_amdgcn_sched_barrier(0);
#pragma unroll
                for (int kk = 0; kk < 8; ++kk) { s0 = mfma32(ka[2 * kk], qf[kk], s0); s1 = mfma32(ka[2 * kk + 1], qf[kk], s1); }
                __builtin_amdgcn_sched_barrier(0);
            }
            if (jb >= 0 && 64 * jb + 63 > 32 * wid) { const int q = 32 * wid + r32;
#pragma unroll
                for (int r = 0; r < 16; ++r) { const int kv = 64 * jb + crow(r, hi); if (kv > q) s0[r] = -INFINITY; if (kv + 32 > q) s1[r] = -INFINITY; } }
            float mx = fmaxf(s0[0], s1[0]);
#pragma unroll
            for (int r = 1; r < 16; ++r) mx = fmaxf(mx, fmaxf(s0[r], s1[r]));
            mx = xmax32(mx);
            const float mn = fmaxf(m, mx), alpha = fexp2(m - mn); m = mn;
            float ls = 0.f;
#pragma unroll
            for (int r = 0; r < 16; ++r) { s0[r] = fexp2(s0[r] - mn); s1[r] = fexp2(s1[r] - mn); ls += s0[r] + s1[r]; }
            l = l * alpha + ls;
#pragma unroll
            for (int d = 0; d < 4; ++d)
#pragma unroll
                for (int r = 0; r < 16; ++r) o[d][r] *= alpha;
            bf16x8 pf[4];
            { u32x4 w;
              w.x = pkbf(s0[0], s0[1]); w.y = pkbf(s0[2], s0[3]); w.z = pkbf(s0[4], s0[5]); w.w = pkbf(s0[6], s0[7]); pf[0] = __builtin_bit_cast(bf16x8, w);
              w.x = pkbf(s0[8], s0[9]); w.y = pkbf(s0[10], s0[11]); w.z = pkbf(s0[12], s0[13]); w.w = pkbf(s0[14], s0[15]); pf[1] = __builtin_bit_cast(bf16x8, w);
              w.x = pkbf(s1[0], s1[1]); w.y = pkbf(s1[2], s1[3]); w.z = pkbf(s1[4], s1[5]); w.w = pkbf(s1[6], s1[7]); pf[2] = __builtin_bit_cast(bf16x8, w);
              w.x = pkbf(s1[8], s1[9]); w.y = pkbf(s1[10], s1[11]); w.z = pkbf(s1[12], s1[13]); w.w = pkbf(s1[14], s1[15]); pf[3] = __builtin_bit_cast(bf16x8, w); }
#pragma unroll
            for (int ss = 0; ss < 4; ++ss)
#pragma unroll
                for (int d = 0; d < 4; ++d) { LAS const char* vp = Vb + (16 * ss + 4 * hi + (i16 >> 2)) * AVP + (32 * d + 16 * cb + 4 * (i16 & 3)) * 2;
                    o[d] = mfma32(cat44(lds_tr(vp), lds_tr(vp + 8 * AVP)), pf[ss], o[d]); }
        }
        if (t + 1 < NT) AT_STORE((t + 1) & 1);
        __syncthreads();
    }
    l = xsum32(l);
    const float inv = 1.0f / l;
    bf16_t* Og = MIX + (rowb + 256 * qb + 32 * wid + r32) * DM + 1024 + h * 128 + 4 * hi;
#pragma unroll
    for (int d = 0; d < 4; ++d)
#pragma unroll
        for (int g = 0; g < 4; ++g) { u32x2 w; w.x = pkbf(o[d][4 * g] * inv, o[d][4 * g + 1] * inv); w.y = pkbf(o[d][4 * g + 2] * inv, o[d][4 * g + 3] * inv);
            *(GAS u32x2*)(Og + 32 * d + 8 * g) = w; }
#undef AT_LOAD
#undef AT_STORE
}

constexpr int FS_Q = 0, FS_NF = 8448, FS_SC = 12672, FS_TL = 80512, FS_LI = 97408, FS_SCP = 1060;
__device__ __forceinline__ void fox_sample_item(LAS char* L, const bf16_t* P, const float* lfS, const float* ck, const float* cv, const float* clf, bf16_t* MIX, int sb, int h, const int wv) {
    const int tid = opaque_tid(wv), lane = tid & 63, wid = __builtin_amdgcn_readfirstlane(tid >> 6);
    LAS float* QF = (LAS float*)(L + FS_Q); LAS float* NF = (LAS float*)(L + FS_NF); LAS float* SC = (LAS float*)(L + FS_SC); LAS float* TL = (LAS float*)(L + FS_TL); LAS float* LI = (LAS float*)(L + FS_LI);
    const size_t srow = (size_t)MP + sb * 16;
    for (int e = tid; e < 16 * 128; e += 512) { const int q = e >> 7, d = e & 127; QF[q * 132 + d] = bf2f(((const GAS bf16_t*)P)[(srow + q) * NP + PC_QB + h * 128 + d]); }
    if (wid == 0) {
        float v[17];
#pragma unroll
        for (int i = 0; i < 17; ++i) { const int idx = 17 * lane + i; float x = 0.f;
            if (idx < PAST) x = ((const GAS float*)clf)[((size_t)sb * PAST + idx) * 8 + h]; else if (idx < PAST + 16) x = ((const GAS float*)lfS)[(sb * 8 + h) * 16 + idx - PAST];
            v[i] = x; }
#pragma unroll
        for (int i = 1; i < 17; ++i) v[i] += v[i - 1];
        const float tot = v[16], x = scan_sum64(tot, lane), base = x - tot;
#pragma unroll
        for (int i = 0; i < 17; ++i) { const int idx = 17 * lane + i; if (idx < 1056) NF[idx] = -(base + v[i]) * LOG2E; }
    }
    f32x4 ta[2], tb2[2], tc[2];
#define FS_LOAD(R, src, pcol, tile) do { _Pragma("unroll") for (int i_ = 0; i_ < 2; ++i_) { const int c_ = tid + 512 * i_, row_ = c_ >> 5, ch_ = c_ & 31, kv_ = 32 * (tile) + row_; \
        if (kv_ < PAST) R[i_] = *(const GAS f32x4*)((src) + (((size_t)sb * PAST + kv_) * 8 + h) * 128 + 4 * ch_); \
        else if (kv_ < PAST + 16) { const u32x2 w_ = *(const GAS u32x2*)(P + (srow + kv_ - PAST) * NP + (pcol) + h * 128 + 4 * ch_); R[i_] = (f32x4){bflo(w_.x), bfhi(w_.x), bflo(w_.y), bfhi(w_.y)}; } \
        else R[i_] = (f32x4){0.f, 0.f, 0.f, 0.f}; } } while (0)
#define FS_STORE(R) do { _Pragma("unroll") for (int i_ = 0; i_ < 2; ++i_) { const int c_ = tid + 512 * i_, row_ = c_ >> 5, ch_ = c_ & 31; *(LAS f32x4*)(TL + row_ * 132 + 4 * ch_) = R[i_]; } } while (0)
    FS_LOAD(ta, ck, PC_KB, 0); FS_LOAD(tb2, ck, PC_KB, 1); FS_LOAD(tc, ck, PC_KB, 2);
    __syncthreads();
    {
        const int q = tid & 15, kl = tid >> 4;
#define FS_SC_STEP(R, tile_) do { const int tile = (tile_); FS_STORE(R); __syncthreads(); if (tile + 3 < 33) FS_LOAD(R, ck, PC_KB, tile + 3); \
            float acc = 0.f; \
            _Pragma("unroll 8") for (int i = 0; i < 32; ++i) { const f32x4 a = *(LAS const f32x4*)(QF + q * 132 + 4 * i), k = *(LAS const f32x4*)(TL + kl * 132 + 4 * i); acc += a[0] * k[0] + a[1] * k[1] + a[2] * k[2] + a[3] * k[3]; } \
            const int kv = 32 * tile + kl; float s = acc + NF[kv]; \
            if (kv >= PAST + 16 || (kv >= PAST && kv - PAST > q)) s = -INFINITY; \
            SC[q * FS_SCP + kv] = s; __syncthreads(); } while (0)
        for (int t3 = 0; t3 < 33; t3 += 3) { FS_SC_STEP(ta, t3); FS_SC_STEP(tb2, t3 + 1); FS_SC_STEP(tc, t3 + 2); }
#undef FS_SC_STEP
    }
    FS_LOAD(ta, cv, PC_VB, 0); FS_LOAD(tb2, cv, PC_VB, 1); FS_LOAD(tc, cv, PC_VB, 2);
    {
#pragma unroll
        for (int qq = 0; qq < 2; ++qq) { const int q = 2 * wid + qq; float mx = -INFINITY;
            for (int kv = lane; kv < 1056; kv += 64) mx = fmaxf(mx, SC[q * FS_SCP + kv]);
#pragma unroll
            for (int o = 1; o < 64; o <<= 1) mx = fmaxf(mx, __shfl_xor(mx, o));
            float sm = 0.f;
            for (int kv = lane; kv < 1056; kv += 64) { const float p = fexp2(SC[q * FS_SCP + kv] - mx); SC[q * FS_SCP + kv] = p; sm += p; }
            sm = wave_sum64(sm);
            if (lane == 0) LI[q] = 1.0f / sm; }
    }
    __syncthreads();
    {
        const int d = tid & 127, qg = tid >> 7; float o0 = 0.f, o1 = 0.f, o2 = 0.f, o3 = 0.f;
#define FS_PV_STEP(R, tile_) do { const int tile = (tile_); FS_STORE(R); __syncthreads(); if (tile + 3 < 33) FS_LOAD(R, cv, PC_VB, tile + 3); \
            _Pragma("unroll 8") for (int kl = 0; kl < 32; ++kl) { const float v = TL[kl * 132 + d]; const int kv = 32 * tile + kl; LAS const float* sp = SC + (4 * qg) * FS_SCP + kv; \
                o0 += sp[0] * v; o1 += sp[FS_SCP] * v; o2 += sp[2 * FS_SCP] * v; o3 += sp[3 * FS_SCP] * v; } \
            __syncthreads(); } while (0)
        for (int t3 = 0; t3 < 33; t3 += 3) { FS_PV_STEP(ta, t3); FS_PV_STEP(tb2, t3 + 1); FS_PV_STEP(tc, t3 + 2); }
#undef FS_PV_STEP
        GAS bf16_t* Og = (GAS bf16_t*)MIX + (srow + 4 * qg) * DM + 1024 + h * 128 + d;
        Og[0] = (bf16_t)(pkbf(o0 * LI[4 * qg], 0.f) & 0xffffu); Og[DM] = (bf16_t)(pkbf(o1 * LI[4 * qg + 1], 0.f) & 0xffffu);
        Og[2 * DM] = (bf16_t)(pkbf(o2 * LI[4 * qg + 2], 0.f) & 0xffffu); Og[3 * DM] = (bf16_t)(pkbf(o3 * LI[4 * qg + 3], 0.f) & 0xffffu);
    }
#undef FS_LOAD
#undef FS_STORE
}

constexpr int ML_Q = 0, ML_K = 17408, ML_KT = 34816, ML_V = 55296, ML_S = 92160, ML_FA = 101376, ML_N = 102656, ML_SSQ = 103168, ML_GH = 105216, ML_GP = 106240, ML_NP = 139008, ML_RS = 143104;
constexpr int KTP = 320, VP = 576;
__device__ __forceinline__ void mlstm_item(LAS char* L, const bf16_t* P, const float* G, bf16_t* MIX, const float* ghead, size_t row0, int hh, int nch, int Lv,
                                           const float* c0, const float* n0, const float* m0, float* cout, float* nout, float* mout, const int wv) {
    const int tid = opaque_tid(wv), lane = tid & 63, wid = __builtin_amdgcn_readfirstlane(tid >> 6), r32 = lane & 31, hi = lane >> 5, i16 = lane & 15, cb = (lane >> 4) & 1;
    LAS float* FA = (LAS float*)(L + ML_FA); LAS float* ROWT = FA, *COLS = FA + 64, *WINT = FA + 128, *EMT = FA + 192, *NQ = FA + 256;
    LAS float* NST = (LAS float*)(L + ML_N); LAS float* SSQ = (LAS float*)(L + ML_SSQ); LAS float* RS = (LAS float*)(L + ML_RS);
    f32x16 cT[4];
#pragma unroll
    for (int kb = 0; kb < 4; ++kb)
#pragma unroll
        for (int r = 0; r < 16; ++r) cT[kb][r] = c0 ? ((const GAS float*)c0)[(size_t)(32 * wid + r32) * 128 + 32 * kb + crow(r, hi)] : 0.f;
    if (tid < 128) NST[tid] = n0 ? ((const GAS float*)n0)[tid] : 0.f;
    float m = m0 ? ((const GAS float*)m0)[0] : 0.f;
    LAS float* GH = (LAS float*)(L + ML_GH);
    if (tid < 256) GH[tid] = ((const GAS float*)ghead)[hh * 256 + tid];
    u32x4 qr[2], kr[2], vr[4]; float igr;
#define ML_LOADQK(j) do { const size_t rb_ = row0 + 64 * (size_t)(j); \
        _Pragma("unroll") for (int i_ = 0; i_ < 2; ++i_) { const int c_ = tl_ + 512 * i_, row_ = c_ >> 4, ch_ = c_ & 15; \
            if (row_ < Lv) { qr[i_] = *(const GAS u32x4*)(P + (rb_ + row_) * NP + PC_QA + hh * 128 + ch_ * 8); kr[i_] = *(const GAS u32x4*)(P + (rb_ + row_) * NP + PC_KA + hh * 128 + ch_ * 8); } \
            else { qr[i_] = (u32x4){0u, 0u, 0u, 0u}; kr[i_] = (u32x4){0u, 0u, 0u, 0u}; } } \
        if ((tl_ & 63) < Lv) { igr = ((const GAS float*)G)[(rb_ + (tl_ & 63)) * 16 + hh]; } else { igr = -INFINITY; } } while (0)
#define ML_LOADV(j) do { const size_t rb_ = row0 + 64 * (size_t)(j); \
        _Pragma("unroll") for (int i_ = 0; i_ < 4; ++i_) { const int c_ = tl_ + 512 * i_, row_ = c_ >> 5, ch_ = c_ & 31; \
            if (row_ < Lv) vr[i_] = *(const GAS u32x4*)(P + (rb_ + row_) * NP + PC_VA + hh * 256 + ch_ * 8); else vr[i_] = (u32x4){0u, 0u, 0u, 0u}; } } while (0)
    { int tl_ = tid; ML_LOADQK(0); ML_LOADV(0); }
    LAS float* BCS = (LAS float*)(L + ML_GP); LAS float* PMX = BCS + 4096; LAS float* NPART = (LAS float*)(L + ML_NP);
    for (int jj = wid; jj < nch; jj += 8) {
        float ig0 = -INFINITY, lf0 = 0.f;
        if (lane < Lv) { ig0 = ((const GAS float*)G)[(row0 + 64 * (size_t)jj + lane) * 16 + hh]; lf0 = ((const GAS float*)G)[(row0 + 64 * (size_t)jj + lane) * 16 + 4 + hh]; }
        const float bc = scan_sum64l(lf0, lane), pmx = scan_max64l(ig0 - bc, lane);
        BCS[jj * 64 + lane] = bc; PMX[jj * 64 + lane] = pmx;
    }
    __syncthreads();
    for (int j = 0; j < nch; ++j) {
        int tl_ = tid; asm volatile("" : "+v"(tl_));
        const int r32j = tl_ & 31, hij = (tl_ >> 5) & 1;
        const int lj = tl_ & 63;
        const float bcs = BCS[j * 64 + lj], pm = PMX[j * 64 + lj], u = igr - bcs;
        const float mt = bcs + fmaxf(m, pm);
        const float b63 = __int_as_float(__builtin_amdgcn_readlane(__float_as_int(bcs), 63)), mnew = __int_as_float(__builtin_amdgcn_readlane(__float_as_int(mt), 63));
        const float av = __expf(b63 + u - mnew), decay = __expf(b63 + m - mnew);
        if (wid == 0) { ROWT[lane] = bcs - mt; COLS[lane] = u; WINT[lane] = __expf(bcs + m - mt); EMT[lane] = __expf(-mt); }
        m = mnew;
#pragma unroll
        for (int i = 0; i < 2; ++i) { const int c = tid + 512 * i, row = c >> 4, ch = c & 15;
            *(LAS u32x4*)(L + ML_Q + row * 272 + ch * 16) = qr[i]; *(LAS u32x4*)(L + ML_K + row * 272 + ch * 16) = kr[i];
            const float as = bperm_f(row, av); u32x4 w;
            w.x = pkbf(bflo(kr[i].x) * as, bfhi(kr[i].x) * as); w.y = pkbf(bflo(kr[i].y) * as, bfhi(kr[i].y) * as);
            w.z = pkbf(bflo(kr[i].z) * as, bfhi(kr[i].z) * as); w.w = pkbf(bflo(kr[i].w) * as, bfhi(kr[i].w) * as);
            *(LAS u32x4*)(L + ML_KT + row * KTP + ch * 16) = w; }
        __syncthreads();
        const size_t rb = row0 + 64 * (size_t)j;
        if (j + 1 < nch) ML_LOADQK(j + 1);
        u32x2 og[2][4];
#pragma unroll
        for (int tb = 0; tb < 2; ++tb)
#pragma unroll
            for (int g = 0; g < 4; ++g) og[tb][g] = *(const GAS u32x2*)(P + (rb + 32 * tb + r32j) * NP + PC_OA + hh * 256 + 32 * wid + 8 * g + 4 * hij);
        {
            const int fr = lane & 15, fq = lane >> 4;
#pragma unroll
            for (int bi = 0; bi < 2; ++bi) { const int id = 2 * wid + bi, sb = id >> 2, tb = id & 3; const int t = 16 * tb + fr, s0 = 16 * sb + 4 * fq;
                u32x2 ow = (u32x2){0u, 0u};
                if (sb <= tb) { f32x4 acc = (f32x4){0.f, 0.f, 0.f, 0.f}; bf16x8 a4[4], q4[4];
#pragma unroll
                    for (int kk = 0; kk < 4; ++kk) { a4[kk] = *(LAS const bf16x8*)(L + ML_K + (16 * sb + fr) * 272 + kk * 64 + fq * 16); q4[kk] = *(LAS const bf16x8*)(L + ML_Q + (16 * tb + fr) * 272 + kk * 64 + fq * 16); }
                    __builtin_amdgcn_sched_barrier(0);
#pragma unroll
                    for (int kk = 0; kk < 4; ++kk) acc = mfma16(a4[kk], q4[kk], acc);
                    const float rt = ROWT[t]; const f32x4 cs = *(LAS const f32x4*)(COLS + s0); float v[4];
#pragma unroll
                    for (int i = 0; i < 4; ++i) v[i] = (s0 + i <= t) ? acc[i] * __expf(rt + cs[i]) : 0.f;
                    ow.x = pkbf(v[0], v[1]); ow.y = pkbf(v[2], v[3]); }
                *(LAS u32x2*)(L + ML_S + t * 144 + s0 * 2) = ow;
                float ps = (bflo(ow.x) + bfhi(ow.x)) + (bflo(ow.y) + bfhi(ow.y));
                { auto r1 = __builtin_amdgcn_permlane16_swap(__float_as_uint(ps), __float_as_uint(ps), false, false); ps = __uint_as_float(r1[0]) + __uint_as_float(r1[1]); }
                ps = xsum32(ps);
                if (fq == 0) RS[sb * 64 + t] = ps; }
            const int t = 8 * wid + (lane >> 3), kp = lane & 7;
            const u32x4 q0 = *(LAS const u32x4*)(L + ML_Q + t * 272 + kp * 32), q1 = *(LAS const u32x4*)(L + ML_Q + t * 272 + kp * 32 + 16);
            const f32x4 n0v = *(LAS const f32x4*)(NST + 16 * kp), n1v = *(LAS const f32x4*)(NST + 16 * kp + 4), n2v = *(LAS const f32x4*)(NST + 16 * kp + 8), n3v = *(LAS const f32x4*)(NST + 16 * kp + 12);
            float d = bflo(q0.x) * n0v[0] + bfhi(q0.x) * n0v[1] + bflo(q0.y) * n0v[2] + bfhi(q0.y) * n0v[3] + bflo(q0.z) * n1v[0] + bfhi(q0.z) * n1v[1] + bflo(q0.w) * n1v[2] + bfhi(q0.w) * n1v[3]
                    + bflo(q1.x) * n2v[0] + bfhi(q1.x) * n2v[1] + bflo(q1.y) * n2v[2] + bfhi(q1.y) * n2v[3] + bflo(q1.z) * n3v[0] + bfhi(q1.z) * n3v[1] + bflo(q1.w) * n3v[2] + bfhi(q1.w) * n3v[3];
            d += dpp_f(d, 0); d += dpp_f(d, 1); d += dpp_f(d, 2);
            if (kp == 0) NQ[t] = d;
        }
#pragma unroll
        for (int i = 0; i < 4; ++i) { const int c = tid + 512 * i, row = c >> 5, ch = c & 31; *(LAS u32x4*)(L + ML_V + row * VP + ch * 16) = vr[i]; }
        __syncthreads();
        bf16x8 vf[4];
#pragma unroll
        for (int ss = 0; ss < 4; ++ss) { LAS const char* vp = L + ML_V + (16 * ss + 8 * hi + (i16 >> 2)) * VP + (32 * wid + 16 * cb + 4 * (i16 & 3)) * 2; vf[ss] = cat44(lds_tr(vp), lds_tr(vp + 4 * VP)); }
        f32x16 oa[2];
#pragma unroll
        for (int tb = 0; tb < 2; ++tb)
#pragma unroll
            for (int r = 0; r < 16; ++r) oa[tb][r] = 0.f;
        {
            u32x2 qbuf[2][2][2];
#define ML_LDQ(buf, st_) do { _Pragma("unroll") for (int tb = 0; tb < 2; ++tb) { LAS const char* qp = L + ML_Q + (32 * tb + r32) * 272 + (16 * (st_) + 4 * hi) * 2; qbuf[buf][tb][0] = *(LAS const u32x2*)qp; qbuf[buf][tb][1] = *(LAS const u32x2*)(qp + 16); } } while (0)
            ML_LDQ(0, 0);
#pragma unroll
            for (int st = 0; st < 8; ++st) { const int kb = st >> 1, s2 = st & 1;
                if (st < 7) ML_LDQ((st + 1) & 1, st + 1);
                u32x4 w; w.x = pkbf(cT[kb][8 * s2], cT[kb][8 * s2 + 1]); w.y = pkbf(cT[kb][8 * s2 + 2], cT[kb][8 * s2 + 3]); w.z = pkbf(cT[kb][8 * s2 + 4], cT[kb][8 * s2 + 5]); w.w = pkbf(cT[kb][8 * s2 + 6], cT[kb][8 * s2 + 7]);
                const bf16x8 af = __builtin_bit_cast(bf16x8, w);
#pragma unroll
                for (int tb = 0; tb < 2; ++tb) { const u32x4 bw = (u32x4){qbuf[st & 1][tb][0].x, qbuf[st & 1][tb][0].y, qbuf[st & 1][tb][1].x, qbuf[st & 1][tb][1].y}; oa[tb] = mfma32(af, __builtin_bit_cast(bf16x8, bw), oa[tb]); }
                __builtin_amdgcn_sched_barrier(0); }
#undef ML_LDQ
        }
#pragma unroll
        for (int tb = 0; tb < 2; ++tb) { const float w = WINT[32 * tb + r32];
#pragma unroll
            for (int r = 0; r < 16; ++r) oa[tb][r] *= w;
#pragma unroll
            for (int ss = 0; ss < 4; ++ss) if (tb == 1 || ss < 2) { const u32x4 sw = *(LAS const u32x4*)(L + ML_S + (32 * tb + r32) * 144 + (16 * ss + 8 * hi) * 2);
                oa[tb] = mfma32(vf[ss], __builtin_bit_cast(bf16x8, sw), oa[tb]); } }
#pragma unroll
        for (int tb = 0; tb < 2; ++tb) { const int t = 32 * tb + r32; const float rs = (RS[t] + RS[64 + t]) + (RS[128 + t] + RS[192 + t]);
            const float den = WINT[t] * NQ[t] + rs, dn = fmaxf(fabsf(den), EMT[t]), inv = __builtin_amdgcn_rcpf(dn); float sq = 0.f;
#pragma unroll
            for (int r = 0; r < 16; ++r) { oa[tb][r] *= inv; sq += oa[tb][r] * oa[tb][r]; }
            sq = xsum32(sq);
            if (hi == 0) SSQ[wid * 64 + t] = sq; }
#pragma unroll
        for (int kb = 0; kb < 4; ++kb)
#pragma unroll
            for (int r = 0; r < 16; ++r) cT[kb][r] *= decay;
        {
            s16x4 ktb[2][2][2];
#define ML_LDK(buf, st_) do { _Pragma("unroll") for (int k2 = 0; k2 < 2; ++k2) { LAS const char* kp = L + ML_KT + (16 * ((st_) >> 1) + 8 * hi + (i16 >> 2)) * KTP + (32 * (2 * ((st_) & 1) + k2) + 16 * cb + 4 * (i16 & 3)) * 2; ktb[buf][k2][0] = lds_tr(kp); ktb[buf][k2][1] = lds_tr(kp + 4 * KTP); } } while (0)
            ML_LDK(0, 0);
#pragma unroll
            for (int st = 0; st < 8; ++st) {
                if (st < 7) ML_LDK((st + 1) & 1, st + 1);
#pragma unroll
                for (int k2 = 0; k2 < 2; ++k2) cT[2 * (st & 1) + k2] = mfma32(cat44(ktb[st & 1][k2][0], ktb[st & 1][k2][1]), vf[st >> 1], cT[2 * (st & 1) + k2]);
                __builtin_amdgcn_sched_barrier(0); }
#undef ML_LDK
        }
        { float a0 = 0.f, a1 = 0.f;
#pragma unroll
            for (int s = 0; s < 8; ++s) { a0 += bf2f(*(LAS const bf16_t*)(L + ML_KT + (8 * wid + s) * KTP + lane * 2)); a1 += bf2f(*(LAS const bf16_t*)(L + ML_KT + (8 * wid + s) * KTP + 128 + lane * 2)); }
            NPART[wid * 128 + lane] = a0; NPART[wid * 128 + 64 + lane] = a1; }
        __syncthreads();
        if (j + 1 < nch) ML_LOADV(j + 1);
        if (tid < 128) { float acc = 0.f;
#pragma unroll
            for (int w = 0; w < 8; ++w) acc += NPART[w * 128 + tid];
            NST[tid] = decay * NST[tid] + acc; }
#pragma unroll
        for (int tb = 0; tb < 2; ++tb) { const int t = 32 * tb + r32; float tot = 0.f;
#pragma unroll
            for (int w = 0; w < 8; ++w) tot += SSQ[w * 64 + t];
            const float rsn = __builtin_amdgcn_rsqf(tot * (1.0f / 256.0f) + HN_EPS);
            if (t < Lv) { bf16_t* op = MIX + (rb + 32 * tb + r32j) * DM + hh * 256 + 32 * wid + 4 * hij;
#pragma unroll
                for (int g = 0; g < 4; ++g) { const u32x2 ov = og[tb][g]; const float o0 = bflo(ov.x), o1 = bfhi(ov.x), o2 = bflo(ov.y), o3 = bfhi(ov.y);
                    const f32x4 gh = *(LAS const f32x4*)(GH + 32 * wid + 8 * g + 4 * hi);
                    const float v0 = oa[tb][4 * g] * (rsn * gh[0]) * __builtin_amdgcn_rcpf(1.0f + __expf(-o0)), v1 = oa[tb][4 * g + 1] * (rsn * gh[1]) * __builtin_amdgcn_rcpf(1.0f + __expf(-o1));
                    const float v2 = oa[tb][4 * g + 2] * (rsn * gh[2]) * __builtin_amdgcn_rcpf(1.0f + __expf(-o2)), v3 = oa[tb][4 * g + 3] * (rsn * gh[3]) * __builtin_amdgcn_rcpf(1.0f + __expf(-o3));
                    u32x2 w; w.x = pkbf(v0, v1); w.y = pkbf(v2, v3); *(GAS u32x2*)(op + 8 * g) = w; } } }
    }
#pragma unroll
    for (int kb = 0; kb < 4; ++kb)
#pragma unroll
        for (int g = 0; g < 4; ++g) { const f32x4 st = (f32x4){cT[kb][4 * g], cT[kb][4 * g + 1], cT[kb][4 * g + 2], cT[kb][4 * g + 3]};
            *(GAS f32x4*)(cout + (size_t)(32 * wid + r32) * 128 + 32 * kb + 8 * g + 4 * hi) = st; }
    __syncthreads();
    if (tid < 128) ((GAS float*)nout)[tid] = NST[tid];
    if (tid == 0) ((GAS float*)mout)[0] = m;
#undef ML_LOADQK
#undef ML_LOADV
}

__device__ __forceinline__ void mlstm_passA(LAS char* L, const bf16_t* P, const float* G, bf16_t* UC, float* GS, float* NL, int ci, size_t rb, int hh, const int wv) {
    const int tid = opaque_tid(wv), lane = tid & 63, wid = __builtin_amdgcn_readfirstlane(tid >> 6), r32 = lane & 31, hi = lane >> 5, i16 = lane & 15, cb = (lane >> 4) & 1;
    LAS float* NPART = (LAS float*)(L + ML_NP);
    const float ig = ((const GAS float*)G)[(rb + lane) * 16 + hh], lf = ((const GAS float*)G)[(rb + lane) * 16 + 4 + hh];
    const float bcs = scan_sum64l(lf, lane), u = ig - bcs, pm = scan_max64l(u, lane);
    const float pm63 = __int_as_float(__builtin_amdgcn_readlane(__float_as_int(pm), 63));
    const float av = __expf(u - pm63);
    if (wid == 0) { ((GAS float*)GS)[(size_t)ci * 128 + lane] = bcs; ((GAS float*)GS)[(size_t)ci * 128 + 64 + lane] = pm; }
#pragma unroll
    for (int i = 0; i < 2; ++i) { const int c = tid + 512 * i, row = c >> 4, ch = c & 15;
        const u32x4 kr = *(const GAS u32x4*)(P + (rb + row) * NP + PC_KA + hh * 128 + ch * 8);
        const float as = bperm_f(row, av); u32x4 w;
        w.x = pkbf(bflo(kr.x) * as, bfhi(kr.x) * as); w.y = pkbf(bflo(kr.y) * as, bfhi(kr.y) * as);
        w.z = pkbf(bflo(kr.z) * as, bfhi(kr.z) * as); w.w = pkbf(bflo(kr.w) * as, bfhi(kr.w) * as);
        *(LAS u32x4*)(L + ML_KT + row * KTP + ch * 16) = w; }
#pragma unroll
    for (int i = 0; i < 4; ++i) { const int c = tid + 512 * i, row = c >> 5, ch = c & 31;
        *(LAS u32x4*)(L + ML_V + row * VP + ch * 16) = *(const GAS u32x4*)(P + (rb + row) * NP + PC_VA + hh * 256 + ch * 8); }
    __syncthreads();
    bf16x8 vf[4];
#pragma unroll
    for (int ss = 0; ss < 4; ++ss) { LAS const char* vp = L + ML_V + (16 * ss + 8 * hi + (i16 >> 2)) * VP + (32 * wid + 16 * cb + 4 * (i16 & 3)) * 2; vf[ss] = cat44(lds_tr(vp), lds_tr(vp + 4 * VP)); }
    f32x16 cT[4];
#pragma unroll
    for (int kb = 0; kb < 4; ++kb)
#pragma unroll
        for (int r = 0; r < 16; ++r) cT[kb][r] = 0.f;
    {   s16x4 kt[16][2];
#pragma unroll
        for (int ss = 0; ss < 4; ++ss)
#pragma unroll
            for (int kb = 0; kb < 4; ++kb) { LAS const char* kp = L + ML_KT + (16 * ss + 8 * hi + (i16 >> 2)) * KTP + (32 * kb + 16 * cb + 4 * (i16 & 3)) * 2; kt[4 * ss + kb][0] = lds_tr(kp); kt[4 * ss + kb][1] = lds_tr(kp + 4 * KTP); }
        __builtin_amdgcn_sched_barrier(0);
#pragma unroll
        for (int ss = 0; ss < 4; ++ss)
#pragma unroll
            for (int kb = 0; kb < 4; ++kb) cT[kb] = mfma32(cat44(kt[4 * ss + kb][0], kt[4 * ss + kb][1]), vf[ss], cT[kb]);
        __builtin_amdgcn_sched_barrier(0); }
    { float a0 = 0.f, a1 = 0.f;
#pragma unroll
        for (int s = 0; s < 8; ++s) { a0 += bf2f(*(LAS const bf16_t*)(L + ML_KT + (8 * wid + s) * KTP + lane * 2)); a1 += bf2f(*(LAS const bf16_t*)(L + ML_KT + (8 * wid + s) * KTP + 128 + lane * 2)); }
        NPART[wid * 128 + lane] = a0; NPART[wid * 128 + 64 + lane] = a1; }
    GAS bf16_t* uo = (GAS bf16_t*)UC + (size_t)ci * 32768 + (size_t)wid * 4096 + lane * 8;
#pragma unroll
    for (int kb = 0; kb < 4; ++kb)
#pragma unroll
        for (int s2 = 0; s2 < 2; ++s2) { u32x4 w; w.x = pkbf(cT[kb][8 * s2], cT[kb][8 * s2 + 1]); w.y = pkbf(cT[kb][8 * s2 + 2], cT[kb][8 * s2 + 3]); w.z = pkbf(cT[kb][8 * s2 + 4], cT[kb][8 * s2 + 5]); w.w = pkbf(cT[kb][8 * s2 + 6], cT[kb][8 * s2 + 7]);
            *(GAS u32x4*)(uo + (kb * 2 + s2) * 512) = w; }
    __syncthreads();
    if (tid < 128) { float acc = 0.f;
#pragma unroll
        for (int w = 0; w < 8; ++w) acc += NPART[w * 128 + tid];
        ((GAS float*)NL)[(size_t)ci * 128 + tid] = acc; }
}

__device__ __forceinline__ void mlstm_passB(bf16_t* UC, const float* GS, const float* NL, float* NSV, float* MSV, float* out_c, float* out_n, float* out_m, int gtid, int nthreads) {
    const GAS float* gs = (const GAS float*)GS;
    for (int e = gtid; e < 16 * 4096; e += nthreads) {
        const int chain = e >> 12, f = e & 4095;
        float c[8]; float m = 0.f;
#pragma unroll
        for (int i = 0; i < 8; ++i) c[i] = 0.f;
        GAS u32x4* up = (GAS u32x4*)((GAS bf16_t*)UC + (size_t)chain * 64 * 32768 + (size_t)f * 8);
        for (int j0 = 0; j0 < 64; j0 += 8) {
            u32x4 uw8[8]; float b8[8], p8[8];
#pragma unroll
            for (int jj = 0; jj < 8; ++jj) { const int ci = chain * 64 + j0 + jj; uw8[jj] = up[(size_t)(j0 + jj) * 4096]; b8[jj] = gs[(size_t)ci * 128 + 63]; p8[jj] = gs[(size_t)ci * 128 + 127]; }
#pragma unroll
            for (int jj = 0; jj < 8; ++jj) { const float b63 = b8[jj], pm63 = p8[jj];
                const float mn = b63 + fmaxf(m, pm63), dec = __expf(b63 + m - mn), w = __expf(b63 + pm63 - mn); m = mn;
                const u32x4 uw = uw8[jj];
                c[0] = dec * c[0] + w * bflo(uw.x); c[1] = dec * c[1] + w * bfhi(uw.x); c[2] = dec * c[2] + w * bflo(uw.y); c[3] = dec * c[3] + w * bfhi(uw.y);
                c[4] = dec * c[4] + w * bflo(uw.z); c[5] = dec * c[5] + w * bfhi(uw.z); c[6] = dec * c[6] + w * bflo(uw.w); c[7] = dec * c[7] + w * bfhi(uw.w);
                u32x4 o; o.x = pkbf(c[0], c[1]); o.y = pkbf(c[2], c[3]); o.z = pkbf(c[4], c[5]); o.w = pkbf(c[6], c[7]); uw8[jj] = o; }
#pragma unroll
            for (int jj = 0; jj < 8; ++jj) up[(size_t)(j0 + jj) * 4096] = uw8[jj]; }
        const int ln = f & 63, ks = (f >> 6) & 7, w8 = f >> 9;
        const int v = 32 * w8 + (ln & 31), k = 32 * (ks >> 1) + 16 * (ks & 1) + 4 * (ln >> 5);
        GAS float* oc = (GAS float*)out_c + (size_t)chain * 32768 + (size_t)v * 128 + k;
        *(GAS f32x4*)oc = (f32x4){c[0], c[1], c[2], c[3]}; *(GAS f32x4*)(oc + 8) = (f32x4){c[4], c[5], c[6], c[7]};
    }
    const int nt = gtid - 16 * 4096;
    if (nt >= 0 && nt < 16 * 128) { const int chain = nt >> 7, k = nt & 127; float n = 0.f, m = 0.f;
        for (int j0 = 0; j0 < 64; j0 += 8) { float b8[8], p8[8], l8[8];
#pragma unroll
            for (int jj = 0; jj < 8; ++jj) { const int ci = chain * 64 + j0 + jj; b8[jj] = gs[(size_t)ci * 128 + 63]; p8[jj] = gs[(size_t)ci * 128 + 127]; l8[jj] = ((const GAS float*)NL)[(size_t)ci * 128 + k]; }
#pragma unroll
            for (int jj = 0; jj < 8; ++jj) { const int ci = chain * 64 + j0 + jj;
                const float mn = b8[jj] + fmaxf(m, p8[jj]), dec = __expf(b8[jj] + m - mn), w = __expf(b8[jj] + p8[jj] - mn); m = mn;
                n = dec * n + w * l8[jj];
                ((GAS float*)NSV)[(size_t)ci * 128 + k] = n; if (k == 0) ((GAS float*)MSV)[ci] = m; } }
        ((GAS float*)out_n)[chain * 128 + k] = n; if (k == 0) ((GAS float*)out_m)[chain] = m; }
}

__device__ __forceinline__ void mlstm_passC(LAS char* L, const bf16_t* P, const float* G, const bf16_t* UC, const float* GS, const float* NSV, const float* MSV, bf16_t* MIX, const float* ghead,
                                            int ci, int j, size_t rb, int hh, const int wv) {
    const int tid = opaque_tid(wv), lane = tid & 63, wid = __builtin_amdgcn_readfirstlane(tid >> 6), r32 = lane & 31, hi = lane >> 5, i16 = lane & 15, cb = (lane >> 4) & 1;
    LAS float* FA = (LAS float*)(L + ML_FA); LAS float* ROWT = FA, *COLS = FA + 64, *WINT = FA + 128, *EMT = FA + 192, *NQ = FA + 256;
    LAS float* NST = (LAS float*)(L + ML_N); LAS float* SSQ = (LAS float*)(L + ML_SSQ); LAS float* RS = (LAS float*)(L + ML_RS); LAS float* GH = (LAS float*)(L + ML_GH);
    {
        const float ig = ((const GAS float*)G)[(rb + lane) * 16 + hh], bcs = ((const GAS float*)GS)[(size_t)ci * 128 + lane], pm = ((const GAS float*)GS)[(size_t)ci * 128 + 64 + lane];
        const float m = j > 0 ? ((const GAS float*)MSV)[ci - 1] : 0.f, mt = bcs + fmaxf(m, pm);
        if (wid == 0) { ROWT[lane] = bcs - mt; COLS[lane] = ig - bcs; WINT[lane] = __expf(bcs + m - mt); EMT[lane] = __expf(-mt); }
    }
    u32x2 og[2][4];
#pragma unroll
    for (int tb = 0; tb < 2; ++tb)
#pragma unroll
        for (int g = 0; g < 4; ++g) og[tb][g] = *(const GAS u32x2*)(P + (rb + 32 * tb + r32) * NP + PC_OA + hh * 256 + 32 * wid + 8 * g + 4 * hi);
    u32x4 af[8];
    if (j > 0) { const GAS bf16_t* ui = (const GAS bf16_t*)UC + (size_t)(ci - 1) * 32768 + (size_t)wid * 4096 + lane * 8;
#pragma unroll
        for (int st = 0; st < 8; ++st) af[st] = *(const GAS u32x4*)(ui + st * 512); }
    if (tid < 128) NST[tid] = j > 0 ? ((const GAS float*)NSV)[(size_t)(ci - 1) * 128 + tid] : 0.f;
    if (tid < 256) GH[tid] = ((const GAS float*)ghead)[hh * 256 + tid];
#pragma unroll
    for (int i = 0; i < 2; ++i) { const int c = tid + 512 * i, row = c >> 4, ch = c & 15;
        *(LAS u32x4*)(L + ML_Q + row * 272 + ch * 16) = *(const GAS u32x4*)(P + (rb + row) * NP + PC_QA + hh * 128 + ch * 8);
        *(LAS u32x4*)(L + ML_K + row * 272 + ch * 16) = *(const GAS u32x4*)(P + (rb + row) * NP + PC_KA + hh * 128 + ch * 8); }
#pragma unroll
    for (int i = 0; i < 4; ++i) { const int c = tid + 512 * i, row = c >> 5, ch = c & 31;
        *(LAS u32x4*)(L + ML_V + row * VP + ch * 16) = *(const GAS u32x4*)(P + (rb + row) * NP + PC_VA + hh * 256 + ch * 8); }
    __syncthreads();
    {
        const int fr = lane & 15, fq = lane >> 4;
#pragma unroll
        for (int bi = 0; bi < 2; ++bi) { const int id = 2 * wid + bi, sb = id >> 2, tb = id & 3; const int t = 16 * tb + fr, s0 = 16 * sb + 4 * fq;
            u32x2 ow = (u32x2){0u, 0u};
            if (sb <= tb) { f32x4 acc = (f32x4){0.f, 0.f, 0.f, 0.f};
#pragma unroll
                for (int kk = 0; kk < 4; ++kk) { const bf16x8 a = *(LAS const bf16x8*)(L + ML_K + (16 * sb + fr) * 272 + kk * 64 + fq * 16), q = *(LAS const bf16x8*)(L + ML_Q + (16 * tb + fr) * 272 + kk * 64 + fq * 16);
                    acc = mfma16(a, q, acc); }
                const float rt = ROWT[t]; const f32x4 cs = *(LAS const f32x4*)(COLS + s0); float v[4];
#pragma unroll
                for (int i = 0; i < 4; ++i) v[i] = (s0 + i <= t) ? acc[i] * __expf(rt + cs[i]) : 0.f;
                ow.x = pkbf(v[0], v[1]); ow.y = pkbf(v[2], v[3]); }
            *(LAS u32x2*)(L + ML_S + t * 144 + s0 * 2) = ow;
            float ps = (bflo(ow.x) + bfhi(ow.x)) + (bflo(ow.y) + bfhi(ow.y));
            { auto r1 = __builtin_amdgcn_permlane16_swap(__float_as_uint(ps), __float_as_uint(ps), false, false); ps = __uint_as_float(r1[0]) + __uint_as_float(r1[1]); }
            ps = xsum32(ps);
            if (fq == 0) RS[sb * 64 + t] = ps; }
        const int t = 8 * wid + (lane >> 3), kp = lane & 7;
        const u32x4 q0 = *(LAS const u32x4*)(L + ML_Q + t * 272 + kp * 32), q1 = *(LAS const u32x4*)(L + ML_Q + t * 272 + kp * 32 + 16);
        const f32x4 n0v = *(LAS const f32x4*)(NST + 16 * kp), n1v = *(LAS const f32x4*)(NST + 16 * kp + 4), n2v = *(LAS const f32x4*)(NST + 16 * kp + 8), n3v = *(LAS const f32x4*)(NST + 16 * kp + 12);
        float d = bflo(q0.x) * n0v[0] + bfhi(q0.x) * n0v[1] + bflo(q0.y) * n0v[2] + bfhi(q0.y) * n0v[3] + bflo(q0.z) * n1v[0] + bfhi(q0.z) * n1v[1] + bflo(q0.w) * n1v[2] + bfhi(q0.w) * n1v[3]
                + bflo(q1.x) * n2v[0] + bfhi(q1.x) * n2v[1] + bflo(q1.y) * n2v[2] + bfhi(q1.y) * n2v[3] + bflo(q1.z) * n3v[0] + bfhi(q1.z) * n3v[1] + bflo(q1.w) * n3v[2] + bfhi(q1.w) * n3v[3];
        d += dpp_f(d, 0); d += dpp_f(d, 1); d += dpp_f(d, 2);
        if (kp == 0) NQ[t] = d;
    }
    __syncthreads();
    bf16x8 vf[4];
#pragma unroll
    for (int ss = 0; ss < 4; ++ss) { LAS const char* vp = L + ML_V + (16 * ss + 8 * hi + (i16 >> 2)) * VP + (32 * wid + 16 * cb + 4 * (i16 & 3)) * 2; vf[ss] = cat44(lds_tr(vp), lds_tr(vp + 4 * VP)); }
    f32x16 oa[2];
#pragma unroll
    for (int tb = 0; tb < 2; ++tb)
#pragma unroll
        for (int r = 0; r < 16; ++r) oa[tb][r] = 0.f;
    if (j > 0) {
        u32x2 qw[16][2];
#pragma unroll
        for (int st = 0; st < 8; ++st)
#pragma unroll
            for (int tb = 0; tb < 2; ++tb) { LAS const char* qp = L + ML_Q + (32 * tb + r32) * 272 + (16 * st + 4 * hi) * 2; qw[2 * st + tb][0] = *(LAS const u32x2*)qp; qw[2 * st + tb][1] = *(LAS const u32x2*)(qp + 16); }
        __builtin_amdgcn_sched_barrier(0);
#pragma unroll
        for (int st = 0; st < 8; ++st)
#pragma unroll
            for (int tb = 0; tb < 2; ++tb) { const u32x4 bw = (u32x4){qw[2 * st + tb][0].x, qw[2 * st + tb][0].y, qw[2 * st + tb][1].x, qw[2 * st + tb][1].y};
                oa[tb] = mfma32(__builtin_bit_cast(bf16x8, af[st]), __builtin_bit_cast(bf16x8, bw), oa[tb]); }
        __builtin_amdgcn_sched_barrier(0);
    }
#pragma unroll
    for (int tb = 0; tb < 2; ++tb) { const float w = WINT[32 * tb + r32];
#pragma unroll
        for (int r = 0; r < 16; ++r) oa[tb][r] *= w;
#pragma unroll
        for (int ss = 0; ss < 4; ++ss) if (tb == 1 || ss < 2) { const u32x4 sw = *(LAS const u32x4*)(L + ML_S + (32 * tb + r32) * 144 + (16 * ss + 8 * hi) * 2);
            oa[tb] = mfma32(vf[ss], __builtin_bit_cast(bf16x8, sw), oa[tb]); } }
#pragma unroll
    for (int tb = 0; tb < 2; ++tb) { const int t = 32 * tb + r32; const float rs = (RS[t] + RS[64 + t]) + (RS[128 + t] + RS[192 + t]);
        const float den = WINT[t] * NQ[t] + rs, dn = fmaxf(fabsf(den), EMT[t]), inv = __builtin_amdgcn_rcpf(dn); float sq = 0.f;
#pragma unroll
        for (int r = 0; r < 16; ++r) { oa[tb][r] *= inv; sq += oa[tb][r] * oa[tb][r]; }
        sq = xsum32(sq);
        if (hi == 0) SSQ[wid * 64 + t] = sq; }
    __syncthreads();
#pragma unroll
    for (int tb = 0; tb < 2; ++tb) { const int t = 32 * tb + r32; float tot = 0.f;
#pragma unroll
        for (int w = 0; w < 8; ++w) tot += SSQ[w * 64 + t];
        const float rsn = __builtin_amdgcn_rsqf(tot * (1.0f / 256.0f) + HN_EPS);
        GAS bf16_t* op = (GAS bf16_t*)MIX + (rb + t) * DM + hh * 256 + 32 * wid + 4 * hi;
#pragma unroll
        for (int g = 0; g < 4; ++g) { const u32x2 ov = og[tb][g]; const float o0 = bflo(ov.x), o1 = bfhi(ov.x), o2 = bflo(ov.y), o3 = bfhi(ov.y);
            const f32x4 gh = *(LAS const f32x4*)(GH + 32 * wid + 8 * g + 4 * hi);
            const float v0 = oa[tb][4 * g] * (rsn * gh[0]) * __builtin_amdgcn_rcpf(1.0f + __expf(-o0)), v1 = oa[tb][4 * g + 1] * (rsn * gh[1]) * __builtin_amdgcn_rcpf(1.0f + __expf(-o1));
            const float v2 = oa[tb][4 * g + 2] * (rsn * gh[2]) * __builtin_amdgcn_rcpf(1.0f + __expf(-o2)), v3 = oa[tb][4 * g + 3] * (rsn * gh[3]) * __builtin_amdgcn_rcpf(1.0f + __expf(-o3));
            u32x2 w; w.x = pkbf(v0, v1); w.y = pkbf(v2, v3); *(GAS u32x2*)(op + 8 * g) = w; } }
}

#define XB_TMO      128
#define XB_XCNT(j)  (256  + 64 * (j))
#define XB_XSUB(j)  (1280 + 64 * (j))
#define XB_XGEN(j)  (2304 + 64 * (j))
#define XB_TOP      3328
#define XB_TOPGEN   3392
#define XCD_BAR_WORDS 3456
#define XB_SPIN_CAP (1u << 18)

__device__ __forceinline__ unsigned xb_ld(unsigned* p)              { return __hip_atomic_load(p, __ATOMIC_RELAXED, __HIP_MEMORY_SCOPE_AGENT); }
__device__ __forceinline__ unsigned xb_add(unsigned* p, unsigned v) { return __hip_atomic_fetch_add(p, v, __ATOMIC_RELAXED, __HIP_MEMORY_SCOPE_AGENT); }
__device__ __forceinline__ unsigned xb_xcc_id() { return (unsigned)__builtin_amdgcn_s_getreg((3 << 11) | 20) & 0xFu; }
#define XB_SPIN(cond, bar) do { unsigned _sp = 0; while (cond) { __builtin_amdgcn_s_sleep(1); \
    if ((++_sp & 255u) == 0u) { if (xb_ld(&(bar)[XB_TMO])) break; if (_sp > XB_SPIN_CAP) { atomicAdd(&(bar)[XB_TMO], 1u); break; } } } } while (0)

struct XcdBarrier {
    unsigned* bar; unsigned x;
    volatile LAS unsigned* st;
};

__device__ __forceinline__ XcdBarrier xcd_barrier_post(unsigned* bar, volatile LAS unsigned* st) {
    XcdBarrier b; b.bar = bar; b.x = xb_xcc_id(); b.st = st;
    if (threadIdx.x == 0) (void)xb_add(&bar[XB_XCNT(b.x)], 1u);
    return b;
}
__device__ __forceinline__ void xcd_barrier_complete(unsigned* bar, unsigned x, unsigned& nloc, unsigned& nx) {
    const unsigned G = gridDim.x * gridDim.y * gridDim.z;
    unsigned sum, cnt, mine, sp = 0u;
    for (;;) {
        sum = 0u; cnt = 0u; mine = 0u;
#pragma unroll
        for (unsigned j = 0; j < 16; ++j) { const unsigned c = xb_ld(&bar[XB_XCNT(j)]); sum += c; cnt += (c > 0u) ? 1u : 0u; mine = (j == x) ? c : mine; }
        if (sum == G) break;
        __builtin_amdgcn_s_sleep(1);
        if ((++sp & 255u) == 0u) { if (xb_ld(&bar[XB_TMO])) break; if (sp > XB_SPIN_CAP) { atomicAdd(&bar[XB_TMO], 1u); break; } }
    }
    nloc = mine > 0u ? mine : 1u; nx = cnt > 0u ? cnt : 1u;
}

__device__ __forceinline__ void xcd_barrier(const XcdBarrier& b) {
    asm volatile("s_waitcnt vmcnt(0)" ::: "memory");
    __syncthreads();
    if (threadIdx.x == 0) {
        unsigned* bar = b.bar;
        __builtin_amdgcn_s_waitcnt(0);
        unsigned nloc = b.st[0], nx = b.st[1];
        if (nloc == 0u) { xcd_barrier_complete(bar, b.x, nloc, nx); b.st[0] = nloc; b.st[1] = nx; }
        const unsigned old = xb_add(&bar[XB_XSUB(b.x)], 1u);
        const unsigned gen = old / nloc;
        if (old + 1u == (gen + 1u) * nloc) {
            __builtin_amdgcn_fence(__ATOMIC_RELEASE, "agent");
            asm volatile("s_waitcnt vmcnt(0)" ::: "memory");
            const unsigned og = xb_add(&bar[XB_TOP], 1u);
            const unsigned tg = og / nx;
            if (og + 1u == (tg + 1u) * nx) xb_add(&bar[XB_TOPGEN], 1u);
            else XB_SPIN(xb_ld(&bar[XB_TOPGEN]) == tg, bar);
            __builtin_amdgcn_fence(__ATOMIC_ACQUIRE, "agent");
            xb_add(&bar[XB_XGEN(b.x)], 1u);
            asm volatile("s_waitcnt vmcnt(0)" ::: "memory");
        } else {
            XB_SPIN(xb_ld(&bar[XB_XGEN(b.x)]) == gen, bar);
            __builtin_amdgcn_fence(__ATOMIC_ACQUIRE, "agent");
            asm volatile("s_waitcnt vmcnt(0)" ::: "memory");
        }
    }
    __syncthreads();
}

constexpr int LDS_BYTES = 147456;
constexpr int NPHASE = 15;
constexpr int NCONV_EARLY = 32 * 200 + 32 * 64 + 32 * 256;
constexpr int NCONV_ITEMS = NCONV_EARLY / 16;
#ifndef PH_MASK
#define PH_MASK 0xFFFF
#endif
#define PHON(k) ((PH_MASK >> (k)) & 1)
__global__ void __launch_bounds__(512) fwd_megakernel(Args args) {
    extern __shared__ __attribute__((aligned(16))) unsigned char lds_raw[];
    LAS unsigned char* lds = (LAS unsigned char*)lds_raw;
    cg::grid_group grid = cg::this_grid();
    const int wv = __builtin_amdgcn_readfirstlane((int)threadIdx.x >> 6);
    volatile LAS unsigned* xst = (volatile LAS unsigned*)(lds + LDS_BYTES - 32);
    if (threadIdx.x < 2) xst[threadIdx.x] = 0u;
    __syncthreads();
    const XcdBarrier xbar = xcd_barrier_post((unsigned*)as_global(args.ws) + 4096, xst);
    if (args.ph_lo < 0) grid.sync();
#define GRID_SYNC() xcd_barrier(xbar)
    const int G = gridDim.x, NGW = G * 8, wave = wv, gw = blockIdx.x * 8 + wave;
#define KT_LANE() (opaque_tid(wv) & 63)
#ifndef REP_SUB
#define REP_SUB -1
#define REP_N 0
#endif
    for (int ph = args.ph_lo; ph < args.ph_hi; ++ph) {
      const int nrep = (REP_SUB >= 0 && ph > 0 && (ph - 1) % 7 == REP_SUB) ? 1 + REP_N : 1;
      for (int rep = 0; rep < nrep; ++rep) {
        unsigned char* ws = args.ws; float* out = args.out; asm volatile("" : "+s"(ws), "+s"(out)); ws = as_global(ws); out = as_global(out);
    bf16_t* XB = (bf16_t*)(ws + WS_XB); bf16_t* Pb = (bf16_t*)(ws + WS_P); bf16_t* MIX = (bf16_t*)(ws + WS_MIX); bf16_t* Hb = (bf16_t*)(ws + WS_H);
    float* Gt = (float*)(ws + WS_G); float* lfT = (float*)(ws + WS_LFT); float* lfS = (float*)(ws + WS_LFS); bf16_t* Z = (bf16_t*)(ws + WS_Z);
    unsigned* ctl = (unsigned*)(ws + WS_CTL); float* PART = (float*)(ws + WS_PART);
        const int wave = wv, gw = blockIdx.x * 8 + wave;
#define KT_LANE() (opaque_tid(wv) & 63)
        if (ph == 0) { if (PHON(0)) {
            convert_x(args, gw, NGW, KT_LANE());
            convert_weights(args, 0, (LAS float*)(lds + wave * 16384), gw, NGW, KT_LANE()); }
        } else {
            const int layer = (ph - 1) / 7, sub = (ph - 1) % 7;
            if (sub == 0) { if (PHON(1)) {
                pg8::Gemm g{XB, (const bf16_t*)(ws + WS_WIN), MPAD, NIN, DM, DM}; pg8::StaticOrder S; S.init(MPAD, NIN, G, (int)blockIdx.x);
                EpiIn E{Pb, Gt, lfT, lfS, as_global(args.in[9]) + layer * 16, out + O_KP + (size_t)layer * MP * 1024, out + O_VP + (size_t)layer * MP * 1024,
                        out + O_KS + (size_t)layer * MS * 1024, out + O_VS + (size_t)layer * MS * 1024, out + O_LFP + (size_t)layer * MP * 8, out + O_LFS + (size_t)layer * MS * 8};
                pg8::gemm_phase<EpiIn, pg8::StaticOrder, true, true>(lds, g, S, E, wv);
                if (layer == 0) {
                    LAS int* slot = (LAS int*)(lds + LDS_BYTES - 64);
                    for (;;) {
                        __syncthreads();
                        if (opaque_tid(wv) == 0) slot[0] = (int)atomicAdd(ctl + 64 * 15, 1u);
                        __syncthreads();
                        const int it = slot[0];
                        if (it >= 384) break;
                        const int c0i = 6400 + it * 16;
                        convert_weights(args, 1, (LAS float*)(lds + wave * 16384), c0i + wave, 8, KT_LANE(), c0i + 16); } } }
            } else if (sub == 1) {
                LAS int* slot = (LAS int*)(lds + LDS_BYTES - 64);
                bf16_t* UC = (bf16_t*)Z; float* GS = (float*)((unsigned char*)Z + 64 * MiB); float* NL = GS + 1024 * 128; float* NSV = NL + 1024 * 128; float* MSV = NSV + 1024 * 128;
#ifndef REP_STAGE
#define REP_STAGE 0
#endif
                for (int r2 = 0; r2 < (REP_STAGE == 1 ? 2 : 1); ++r2) { if (r2) GRID_SYNC();
                for (;;) {
                    __syncthreads();
                    if (opaque_tid(wv) == 0) slot[0] = (int)atomicAdd(ctl + 64 * (1 + layer + 2 * r2), 1u);
                    __syncthreads();
                    const int it = slot[0];
                    if (it >= 1632) break;
                    if (it >= 608) { if (PHON(2)) { const int ci = it - 608, chain = ci >> 6, j = ci & 63;
                        mlstm_passA((LAS char*)lds, Pb, Gt, UC, GS, NL, ci, (size_t)(chain >> 2) * SEQ + 64 * j, chain & 3, wv); }
                    } else if (it >= 64 && it < 96) { if (PHON(2)) { const int sb = (it - 64) >> 2, hh = (it - 64) & 3; const size_t si = (size_t)(layer * 8 + sb) * 4 + hh;
                        mlstm_item((LAS char*)lds, Pb, Gt, MIX, as_global(args.in[10]) + layer * 1024, (size_t)MP + sb * 16, hh, 1, 16, as_global(args.in[5]) + si * 32768, as_global(args.in[6]) + si * 128, as_global(args.in[7]) + si,
                                   out + O_CS + si * 32768, out + O_NS + si * 128, out + O_MS + si, wv); }
                    } else if (it < 64) { if (PHON(3)) { const int sb = it >> 3, h = it & 7;
                        fox_sample_item((LAS char*)lds, Pb, lfS, as_global(args.in[2]) + (size_t)layer * SBATCH * PAST * 1024, as_global(args.in[3]) + (size_t)layer * SBATCH * PAST * 1024,
                                        as_global(args.in[4]) + (size_t)layer * SBATCH * PAST * 8, MIX, sb, h, wv); }
                    } else if (PHON(4)) { const int qb = 15 - ((it - 96) >> 5), bh = (it - 96) & 31;
                        fox_prompt_unit((LAS char*)lds, Pb, lfT, MIX, bh >> 3, bh & 7, qb, wv); }
                } }
                GRID_SYNC();
                for (int r2 = 0; r2 < (REP_STAGE == 2 ? 2 : 1); ++r2) { if (r2) GRID_SYNC();
                if (PHON(2)) mlstm_passB(UC, GS, NL, NSV, MSV, out + O_CP + (size_t)layer * 16 * 32768, out + O_NP + (size_t)layer * 16 * 128, out + O_MP + layer * 16,
                                        (int)blockIdx.x * 512 + opaque_tid(wv), G * 512); }
                GRID_SYNC();
                for (int r2 = 0; r2 < (REP_STAGE == 3 ? 2 : 1); ++r2) { if (r2) GRID_SYNC();
                for (int it = (int)blockIdx.x; it < 1024; it += G) {
                    __syncthreads();
                    if (PHON(2)) { const int ci = it, chain = ci >> 6, j = ci & 63;
                        mlstm_passC((LAS char*)lds, Pb, Gt, UC, GS, NSV, MSV, MIX, as_global(args.in[10]) + layer * 1024, ci, j, (size_t)(chain >> 2) * SEQ + 64 * j, chain & 3, wv); }
                } }
            } else if (sub == 2) { if (PHON(5)) {
                { pg8::Gemm g{MIX, (const bf16_t*)(ws + (layer ? WS_WOUT2 : WS_WOUT)), MP, DM, DM, DM}; pg8::StaticOrder S; S.init(MP, DM, G, (int)blockIdx.x);
                  EpiRes E{XB, Z};
                  pg8::gemm_phase<EpiRes, pg8::StaticOrder, true, true>(lds, g, S, E, wv); }
                { pg8::Gemm g{MIX, (const bf16_t*)(ws + (layer ? WS_WOUT2 : WS_WOUT)), MPAD, DM, DM / NSL_OUT, DM}; pg8::SplitOrder S; S.init(DM, NSL_OUT, MP / 256, G, (int)blockIdx.x);
                  EpiPart E{PART};
                  pg8::gemm_phase<EpiPart, pg8::SplitOrder, true, true>(lds, g, S, E, wv); } }
            } else if (sub == 3) {
                if (PHON(6)) ln_phase(Z, XB, PART, NSL_OUT, as_global(args.in[12]) + layer * DM, as_global(args.in[13]) + layer * DM, XB, nullptr, nullptr, gw, NGW, KT_LANE(), (LAS float*)lds, wave, (int)blockIdx.x, G);
            } else if (sub == 4) { if (PHON(7)) {
                pg8::Gemm g{XB, (const bf16_t*)(ws + (layer ? WS_WUP2 : WS_WUP)), MPAD, DFF, DM, DM}; pg8::StaticOrder S; S.init(MPAD, DFF, G, (int)blockIdx.x);
                EpiUp E{Hb};
                pg8::gemm_phase<EpiUp, pg8::StaticOrder, true, true>(lds, g, S, E, wv);
                {
                    const int nitems = layer == 0 ? 400 + 256 : 512;
                    LAS int* slot = (LAS int*)(lds + LDS_BYTES - 64);
                    for (;;) {
                        __syncthreads();
                        if (opaque_tid(wv) == 0) slot[0] = (int)atomicAdd(ctl + 64 * (13 + layer), 1u);
                        __syncthreads();
                        const int it = slot[0];
                        if (it >= nitems) break;
                        const int c0i = layer == 0 ? (it < 400 ? it * 16 : 12544 + (it - 400) * 16) : NCONV_EARLY + it * 16;
                        convert_weights(args, 1, (LAS float*)(lds + wave * 16384), c0i + wave, 8, KT_LANE(), c0i + 16); } } }
            } else if (sub == 5) { if (PHON(8)) {
                { pg8::Gemm g{Hb, (const bf16_t*)(ws + WS_WDN), MP, DM, DFF, DFF}; pg8::StaticOrder S; S.init(MP, DM, G, (int)blockIdx.x);
                  EpiRes E{XB, Z};
                  pg8::gemm_phase<EpiRes, pg8::StaticOrder, true, true>(lds, g, S, E, wv); }
                { pg8::Gemm g{Hb, (const bf16_t*)(ws + WS_WDN), MPAD, DM, DFF / NSL_DN, DFF}; pg8::SplitOrder S; S.init(DM, NSL_DN, MP / 256, G, (int)blockIdx.x);
                  EpiPart E{PART};
                  pg8::gemm_phase<EpiPart, pg8::SplitOrder, true, true>(lds, g, S, E, wv); } }
            } else if (PHON(9)) {
                if (layer == 0) { ln_phase(Z, XB, PART, NSL_DN, as_global(args.in[16]), as_global(args.in[17]), XB, nullptr, nullptr, gw, NGW, KT_LANE(), (LAS float*)lds, wave, (int)blockIdx.x, G);
                    }
                else ln_phase(Z, XB, PART, NSL_DN, as_global(args.in[16]) + DM, as_global(args.in[17]) + DM, nullptr, out + O_YP, out + O_YS, gw, NGW, KT_LANE(), (LAS float*)lds, wave, (int)blockIdx.x, G);
            }
        }
        if (rep + 1 < nrep) GRID_SYNC();
      }
        if (ph + 1 < args.ph_hi) GRID_SYNC();
    }
}

extern "C" void kernel_launch(void* const* d_in, const int* in_sizes, int n_in, void* d_out, int out_size, void* d_ws, size_t ws_size, hipStream_t stream) {
    static int grid = 0;
    if (grid == 0) {
        if (n_in != 18 || (size_t)out_size != O_END || ws_size < WS_END) { fprintf(stderr, "kernel_launch: unexpected shapes (n_in %d out %d ws %zu)\n", n_in, out_size, ws_size); grid = -1; return; }
        int dev = 0, cus = 0, per_cu = 0;
        hipGetDevice(&dev); hipDeviceGetAttribute(&cus, hipDeviceAttributeMultiprocessorCount, dev);
        hipFuncSetAttribute((const void*)fwd_megakernel, hipFuncAttributeMaxDynamicSharedMemorySize, LDS_BYTES);
        hipOccupancyMaxActiveBlocksPerMultiprocessor(&per_cu, (const void*)fwd_megakernel, 512, LDS_BYTES);
        (void)hipGetLastError();
        if (per_cu < 1) per_cu = 1;
        grid = cus;
        if (grid > cus * per_cu) grid = cus * per_cu;
    }
    if (grid < 0) return;
    hipMemsetAsync((char*)d_ws + WS_CTL, 0, 65536, stream);
    Args a{};
    for (int i = 0; i < 18; ++i) a.in[i] = (const float*)d_in[i];
    a.out = (float*)d_out; a.ws = (unsigned char*)d_ws; a.ph_lo = 0; a.ph_hi = NPHASE;
    void* kargs[] = {&a};
    hipError_t e = hipLaunchCooperativeKernel((const void*)fwd_megakernel, dim3(grid), dim3(512), kargs, LDS_BYTES, stream);
    if (e != hipSuccess) fprintf(stderr, "cooperative launch failed: %s (grid %d)\n", hipGetErrorString(e), grid);
}
```

```cpp
#include <hip/hip_runtime.h>
#include <hip/hip_cooperative_groups.h>
#include <cstdio>
#include <cstdint>
namespace cg = cooperative_groups;

constexpr int DM = 2048, NBATCH = 4, SEQ = 4096, MP = NBATCH * SEQ;
constexpr int SBATCH = 8, SLEN = 16, MS = SBATCH * SLEN;
constexpr int MT = MP + MS, MPAD = 16640;
constexpr int PAST = 1024, HA = 4, DVA = 256, DKA = 128, HB = 8, DHB = 128, DFF = 8192;
constexpr int NP = 6144;
constexpr int NIN = 6400, NINSRC = 6160;
constexpr int PC_QA = 0, PC_KA = 512, PC_VA = 1024, PC_OA = 2048, PC_QB = 3072, PC_KB = 4096, PC_VB = 5120;
constexpr float ALPHA = 1.4142135623730951f;
constexpr float LN_EPS = 1e-5f, HN_EPS = 1e-6f;
constexpr float LOG2E = 1.4426950408889634f;
constexpr float QA_SCALE = 0.08838834764831845f;
constexpr float QB_SCALE = 0.08838834764831845f * 1.4426950408889634f;

constexpr size_t O_YP = 0, O_YS = O_YP + (size_t)MP * DM, O_KP = O_YS + (size_t)MS * DM, O_VP = O_KP + (size_t)2 * MP * 1024,
                 O_LFP = O_VP + (size_t)2 * MP * 1024, O_CP = O_LFP + (size_t)2 * MP * 8, O_NP = O_CP + (size_t)2 * 4 * 4 * 256 * 128,
                 O_MP = O_NP + (size_t)2 * 4 * 4 * 128, O_KS = O_MP + 32, O_VS = O_KS + (size_t)2 * MS * 1024, O_LFS = O_VS + (size_t)2 * MS * 1024,
                 O_CS = O_LFS + (size_t)2 * MS * 8, O_NS = O_CS + (size_t)2 * 8 * 4 * 256 * 128, O_MS = O_NS + (size_t)2 * 8 * 4 * 128, O_END = O_MS + 64;

constexpr size_t MiB = 1u << 20;
constexpr size_t WS_CTL = 0;
constexpr size_t WS_WIN = 1 * MiB;
constexpr size_t WS_WOUT = 26 * MiB;
constexpr size_t WS_WUP = 34 * MiB;
constexpr size_t WS_WDN = 66 * MiB;
constexpr size_t WS_XB = 98 * MiB;
constexpr size_t WS_G = 163 * MiB;
constexpr size_t WS_LFT = WS_G + (size_t)MPAD * 16 * 4;
constexpr size_t WS_LFS = WS_LFT + (size_t)32 * 4096 * 4;
constexpr size_t WS_Z = 166 * MiB;
constexpr size_t WS_P = 296 * MiB;
constexpr size_t WS_MIX = WS_P + (size_t)MPAD * NP * 2;
constexpr size_t WS_H = WS_P;
constexpr size_t WS_PART = WS_P + (size_t)MPAD * DFF * 2;
constexpr size_t WS_WOUT2 = WS_PART + (size_t)32 * MS * DM * 4;
constexpr size_t WS_WUP2 = WS_WOUT2 + 8 * MiB;
constexpr size_t WS_END = WS_WUP2 + 32 * MiB;
constexpr int NSL_OUT = 16, NSL_DN = 32;
static_assert(WS_LFS + 64 * 16 * 4 <= WS_Z && WS_Z + (size_t)MPAD * DM * 4 <= WS_P && WS_MIX + (size_t)MPAD * DM * 2 <= WS_PART, "ws map");

#define LAS __attribute__((address_space(3)))
#define GAS __attribute__((address_space(1)))
typedef unsigned short bf16_t;
typedef short bf16x8 __attribute__((ext_vector_type(8)));
typedef short s16x4 __attribute__((ext_vector_type(4)));
typedef float f32x2 __attribute__((ext_vector_type(2)));
typedef float f32x4 __attribute__((ext_vector_type(4)));
typedef float f32x16 __attribute__((ext_vector_type(16)));
typedef unsigned u32x2 __attribute__((ext_vector_type(2)));
typedef unsigned u32x4 __attribute__((ext_vector_type(4)));
typedef __bf16 bf16x2_t __attribute__((ext_vector_type(2)));

__device__ __forceinline__ int opaque_tid(int wv) { int l; asm volatile("v_mbcnt_lo_u32_b32 %0, -1, 0\n\tv_mbcnt_hi_u32_b32 %0, -1, %0" : "=v"(l)); return wv * 64 + l; }
template <class T> __device__ __forceinline__ T* as_global(T* p) { return (T*)(__attribute__((address_space(1))) T*)p; }
__device__ __forceinline__ float bf2f(unsigned short u) { return __uint_as_float((unsigned)u << 16); }
__device__ __forceinline__ float bflo(unsigned u) { return __uint_as_float(u << 16); }
__device__ __forceinline__ float bfhi(unsigned u) { return __uint_as_float(u & 0xffff0000u); }
__device__ __forceinline__ unsigned pkbf(float lo, float hi) { f32x2 v = {lo, hi}; bf16x2_t b = __builtin_convertvector(v, bf16x2_t); return __builtin_bit_cast(unsigned, b); }
__device__ __forceinline__ float log_sigmoid(float x) {
    const float e = __expf(-fabsf(x));
    const float l = e < 0.03125f ? e * (1.0f - e * (0.5f - e * (0.33333334f - 0.25f * e))) : __logf(1.0f + e);
    return fminf(x, 0.f) - l; }
__device__ __forceinline__ int crow(int r, int hi) { return (r & 3) + 8 * (r >> 2) + 4 * hi; }
__device__ __forceinline__ s16x4 lds_tr(LAS const char* p) { return __builtin_bit_cast(s16x4, __builtin_amdgcn_ds_read_tr16_b64_v4i16((LAS s16x4*)p)); }
__device__ __forceinline__ bf16x8 cat44(s16x4 a, s16x4 b) { return (bf16x8){a[0], a[1], a[2], a[3], b[0], b[1], b[2], b[3]}; }

namespace pg8 {
#define PG8_LAS __attribute__((address_space(3)))
typedef unsigned short bf16_t;
typedef short bf16x8 __attribute__((ext_vector_type(8)));
typedef float f32x4 __attribute__((ext_vector_type(4)));
typedef unsigned u32x4 __attribute__((ext_vector_type(4)));
constexpr int BM = 256, BK = 64, HALF = 128, HTB = HALF * BK * 2  , STAGE_BYTES = 8 * HTB, NXCD = 8, WGM = 8;

__host__ __device__ __forceinline__ int lds_byte(int r, int c) { const int st = (r >> 4) * 2 + (c >> 5), rr = r & 15, cc = c & 31, ob = rr * 64 + cc * 2; return st * 1024 + (ob ^ (((ob >> 9) & 1) << 5)); }
__host__ __device__ __forceinline__ void stage_rc(int b, int& R, int& C) { const int st = b / 1024, sb = b % 1024, swz = sb ^ (((sb >> 9) & 1) << 5); R = (st >> 1) * 16 + swz / 64; C = (st & 1) * 32 + (swz % 64) / 2; }
__host__ __device__ __forceinline__ int perm32(int rho) { const int n = rho >> 4, i = rho & 15; return 8 * (i >> 2) + 4 * n + (i & 3); }

struct Unit { int pm, pn, pk; };
struct Gemm { const bf16_t* A; const bf16_t* Bt; int M, N, K, ld; };

struct StaticOrder {
    int nM, nN, nwg, G, c;
    __host__ __device__ void init(int M, int N, int G_, int c_) { nM = M / BM; nN = N / BM; nwg = nM * nN; G = G_; c = c_; }
    __host__ __device__ bool next(int i, Unit& u) const {
        const long L = (long)i * G + c; if (L >= nwg) return false;
        int wgid = (int)L; { const int q = nwg / NXCD, r = nwg % NXCD, xcd = wgid % NXCD, off = wgid / NXCD; wgid = (xcd < r ? xcd * (q + 1) : r * (q + 1) + (xcd - r) * q) + off; }
        const int nig = WGM * nN, gid = wgid / nig, fm = gid * WGM, gsz = (nM - fm) < WGM ? (nM - fm) : WGM;
        u.pm = fm + ((wgid % nig) % gsz); u.pn = (wgid % nig) / gsz; u.pk = 0; return true;
    }
    __device__ __forceinline__ void a_ready(const Unit&) const {}
    __device__ __forceinline__ void done(const Unit&) const {}
};

__device__ __forceinline__ unsigned cvt_pk_bf16(float lo, float hi) { unsigned r; asm volatile("v_cvt_pk_bf16_f32 %0, %1, %2" : "=v"(r) : "v"(lo), "v"(hi)); return r; }
typedef float f32x2 __attribute__((ext_vector_type(2)));
struct SplitOrder {
    int nN, np, G, c, pm0;
    __host__ __device__ void init(int N, int nsl, int pm0_, int G_, int c_) { nN = N / BM; np = nN * nsl; G = G_; c = c_; pm0 = pm0_; }
    __host__ __device__ bool next(int i, Unit& u) const { const long L = (long)i * G + c; if (L >= np) return false; u.pm = pm0; u.pn = (int)(L % nN); u.pk = (int)(L / nN); return true; }
    __device__ __forceinline__ void a_ready(const Unit&) const {}
    __device__ __forceinline__ void done(const Unit&) const {}
};
template <class Epi, class Sched, bool ALIGN_EPI = false, bool SP2 = false>
__device__ __forceinline__ void gemm_phase(PG8_LAS unsigned char* lds, const Gemm g, const Sched& S, const Epi& E, const int wv) {
    const int tid = opaque_tid(wv), wid = __builtin_amdgcn_readfirstlane(tid >> 6), lane = tid & 63, wr = wid >> 2, wc = wid & 3, fr = lane & 15, fq = lane >> 4;
    const int K = g.K, nt = K / BK;
    unsigned voffA[2], voffB[2];
#pragma unroll
    for (int i = 0; i < 2; ++i) { int R, C; stage_rc(tid * 16 + i * 8192, R, C); const int Rb = Epi::PERM ? ((R & ~31) + perm32(R & 31)) : R;
        voffA[i] = (unsigned)(R * g.ld + C) * 2u; voffB[i] = (unsigned)(Rb * g.ld + C) * 2u; }
    const size_t kstep = (size_t)(BK * 2);
    const size_t hstep = (size_t)HALF * g.ld * 2;
    const size_t tstep = 2 * hstep;
    const unsigned ldsw = (unsigned)wid * 1024u;
    const int aoff = lds_byte(wr * 64 + fr, fq * 8), boff = lds_byte(wc * 32 + fr, fq * 8);
#define PG8_SA(b, h) (((b) * 2 + (h)) * HTB)
#define PG8_SB(b, h) ((4 + (b) * 2 + (h)) * HTB)
#define PG8_STAGE(bufoff, gbase, voff) do { _Pragma("unroll") for (int _i = 0; _i < 2; ++_i) \
        __builtin_amdgcn_global_load_lds((const unsigned*)((const char*)(gbase) + (voff)[_i]), (PG8_LAS unsigned*)(lds + (bufoff) + ldsw + _i * 8192), 16, 0, 0); } while (0)
#define PG8_LDA(dst, b, h) do { _Pragma("unroll") for (int m = 0; m < 4; ++m) _Pragma("unroll") for (int k = 0; k < 2; ++k) dst[m][k] = *(const PG8_LAS bf16x8*)(lds + PG8_SA(b, h) + aoff + m * 2048 + k * 1024); } while (0)
#define PG8_LDB(dst, b, h) do { _Pragma("unroll") for (int n = 0; n < 2; ++n) _Pragma("unroll") for (int k = 0; k < 2; ++k) dst[n][k] = *(const PG8_LAS bf16x8*)(lds + PG8_SB(b, h) + boff + n * 2048 + k * 1024); } while (0)
#define PG8_MMA(ai, bj, At, Bt) do { __builtin_amdgcn_s_setprio(1); _Pragma("unroll") for (int m = 0; m < 4; ++m) _Pragma("unroll") for (int n = 0; n < 2; ++n) _Pragma("unroll") for (int k = 0; k < 2; ++k) \
        acc[ai][bj][m][n] = __builtin_amdgcn_mfma_f32_16x16x32_bf16(Bt[n][k], At[m][k], acc[ai][bj][m][n], 0, 0, 0); __builtin_amdgcn_s_setprio(0); } while (0)
#define PG8_WAIT_V(n) asm volatile("s_waitcnt vmcnt(" #n ")" ::: "memory")
#define PG8_WAIT_L(n) asm volatile("s_waitcnt lgkmcnt(" #n ")" ::: "memory")
#define PG8_BAR __builtin_amdgcn_s_barrier()
#define PG8_SCHED __builtin_amdgcn_sched_barrier(0)
    Unit cur, nxt; int ui = 0;
    if (!S.next(0, cur)) return;
    f32x4 acc[2][2][4][2];
#pragma unroll
    for (int a = 0; a < 2; ++a)
#pragma unroll
        for (int b = 0; b < 2; ++b)
#pragma unroll
            for (int m = 0; m < 4; ++m)
#pragma unroll
                for (int n = 0; n < 2; ++n) acc[a][b][m][n] = (f32x4){0.f, 0.f, 0.f, 0.f};
    bf16x8 At[4][2], B0[2][2], B1[2][2];
    const char* cA = (const char*)g.A + (size_t)cur.pm * tstep + (size_t)cur.pk * K * 2; const char* cB = (const char*)g.Bt + (size_t)cur.pn * tstep + (size_t)cur.pk * K * 2;
    S.a_ready(cur);
    if constexpr (SP2) {
        PG8_STAGE(PG8_SB(0, 0), cB, voffB); PG8_STAGE(PG8_SB(0, 1), cB + hstep, voffB); PG8_STAGE(PG8_SA(0, 0), cA, voffA); PG8_STAGE(PG8_SA(0, 1), cA + hstep, voffA);
        if (wr == 1) PG8_BAR;
        PG8_WAIT_V(2); PG8_BAR;
        PG8_STAGE(PG8_SB(1, 0), cB + kstep, voffB); PG8_STAGE(PG8_SA(1, 0), cA + kstep, voffA); PG8_STAGE(PG8_SB(1, 1), cB + hstep + kstep, voffB);
        PG8_WAIT_V(6); PG8_BAR;
    } else {
        PG8_STAGE(PG8_SB(0, 0), cB, voffB); PG8_STAGE(PG8_SA(0, 0), cA, voffA); PG8_STAGE(PG8_SB(0, 1), cB + hstep, voffB); PG8_STAGE(PG8_SA(0, 1), cA + hstep, voffA);
        if (wr == 1) PG8_BAR;
        PG8_WAIT_V(4); PG8_BAR;
        PG8_STAGE(PG8_SB(1, 0), cB + kstep, voffB); PG8_STAGE(PG8_SA(1, 0), cA + kstep, voffA); PG8_STAGE(PG8_SB(1, 1), cB + hstep + kstep, voffB);
        PG8_WAIT_V(6); PG8_BAR;
    }
    for (;;) {
        const bool has_next = S.next(ui + 1, nxt);
        const char* nA = has_next ? (const char*)g.A + (size_t)nxt.pm * tstep + (size_t)nxt.pk * K * 2 : cA; const char* nB = has_next ? (const char*)g.Bt + (size_t)nxt.pn * tstep + (size_t)nxt.pk * K * 2 : cB;
        for (int t = 0; t < nt; t += 2) {
            const bool last = (t == nt - 2);
            const char* a1 = cA + (size_t)(t + 1) * kstep;
            const char* a2 = last ? nA : cA + (size_t)(t + 2) * kstep; const char* b2 = last ? nB : cB + (size_t)(t + 2) * kstep;
            const char* a3 = a2 + kstep; const char* b3 = b2 + kstep;
            if (last && has_next) S.a_ready(nxt);
            if constexpr (SP2) {
            PG8_LDB(B0, 0, 0); PG8_LDB(B1, 0, 1); PG8_SCHED; PG8_LDA(At, 0, 0); PG8_STAGE(PG8_SA(1, 1), a1 + hstep, voffA);
            PG8_WAIT_V(8); PG8_WAIT_L(0); PG8_BAR; PG8_MMA(0, 0, At, B0); PG8_MMA(0, 1, At, B1); PG8_BAR; PG8_SCHED;
            PG8_LDA(At, 0, 1); PG8_STAGE(PG8_SB(0, 0), b2, voffB); PG8_STAGE(PG8_SB(0, 1), b2 + hstep, voffB); PG8_STAGE(PG8_SA(0, 0), a2, voffA);
            PG8_WAIT_V(8); PG8_WAIT_L(0); PG8_BAR; PG8_MMA(1, 0, At, B0); PG8_MMA(1, 1, At, B1); PG8_BAR; PG8_SCHED;
            PG8_LDB(B0, 1, 0); PG8_LDB(B1, 1, 1); PG8_SCHED; PG8_LDA(At, 1, 0); PG8_STAGE(PG8_SA(0, 1), a2 + hstep, voffA);
            PG8_WAIT_V(8); PG8_WAIT_L(0); PG8_BAR; PG8_MMA(0, 0, At, B0); PG8_MMA(0, 1, At, B1); PG8_BAR; PG8_SCHED;
            PG8_LDA(At, 1, 1); PG8_STAGE(PG8_SB(1, 0), b3, voffB); PG8_STAGE(PG8_SB(1, 1), b3 + hstep, voffB); PG8_STAGE(PG8_SA(1, 0), a3, voffA);
            PG8_WAIT_V(8); PG8_WAIT_L(0); PG8_BAR; PG8_MMA(1, 0, At, B0); PG8_MMA(1, 1, At, B1); PG8_BAR; PG8_SCHED;
            } else {
            PG8_LDB(B0, 0, 0); PG8_SCHED; PG8_LDA(At, 0, 0); PG8_STAGE(PG8_SA(1, 1), a1 + hstep, voffA);
            PG8_WAIT_L(8); PG8_BAR; PG8_WAIT_L(0); PG8_MMA(0, 0, At, B0); PG8_BAR; PG8_SCHED;
            PG8_LDB(B1, 0, 1); PG8_STAGE(PG8_SB(0, 0), b2, voffB);
            PG8_BAR; PG8_WAIT_L(0); PG8_MMA(0, 1, At, B1); PG8_BAR;
            PG8_LDA(At, 0, 1); PG8_STAGE(PG8_SA(0, 0), a2, voffA);
            PG8_BAR; PG8_WAIT_L(0); PG8_MMA(1, 0, At, B0); PG8_BAR; PG8_SCHED;
            PG8_STAGE(PG8_SB(0, 1), b2 + hstep, voffB);
            PG8_WAIT_V(6); PG8_BAR; PG8_MMA(1, 1, At, B1); PG8_BAR;
            PG8_LDB(B0, 1, 0); PG8_SCHED; PG8_LDA(At, 1, 0); PG8_STAGE(PG8_SA(0, 1), a2 + hstep, voffA);
            PG8_WAIT_L(8); PG8_BAR; PG8_WAIT_L(0); PG8_MMA(0, 0, At, B0); PG8_BAR; PG8_SCHED;
            PG8_LDB(B1, 1, 1); PG8_STAGE(PG8_SB(1, 0), b3, voffB);
            PG8_BAR; PG8_WAIT_L(0); PG8_MMA(0, 1, At, B1); PG8_BAR;
            PG8_LDA(At, 1, 1); PG8_STAGE(PG8_SA(1, 0), a3, voffA);
            PG8_BAR; PG8_WAIT_L(0); PG8_MMA(1, 0, At, B0); PG8_BAR; PG8_SCHED;
            PG8_STAGE(PG8_SB(1, 1), b3 + hstep, voffB);
            PG8_WAIT_V(6); PG8_BAR; PG8_MMA(1, 1, At, B1); PG8_BAR;
            }
        }
        if constexpr (ALIGN_EPI) { if (wr == 0) PG8_BAR; }
        if constexpr (!Epi::AFTER_DRAIN) { E(acc, cur, wr, wc, fr, fq); S.done(cur); }
        if (!has_next) break;
#pragma unroll
        for (int a = 0; a < 2; ++a)
#pragma unroll
            for (int b = 0; b < 2; ++b)
#pragma unroll
                for (int m = 0; m < 4; ++m)
#pragma unroll
                    for (int n = 0; n < 2; ++n) acc[a][b][m][n] = (f32x4){0.f, 0.f, 0.f, 0.f};
        cur = nxt; cA = nA; cB = nB; ++ui;
        if constexpr (ALIGN_EPI) { if (wr == 1) PG8_BAR; }
    }
    PG8_WAIT_V(0);
    if constexpr (!ALIGN_EPI) { if (wr == 0) PG8_BAR; }
    PG8_BAR;
    if constexpr (Epi::AFTER_DRAIN) { E.fused(acc, cur, wr, wc, fr, fq, lds, wid, lane); S.done(cur); }
#undef PG8_SA
#undef PG8_SB
#undef PG8_STAGE
#undef PG8_LDA
#undef PG8_LDB
#undef PG8_MMA
#undef PG8_WAIT_V
#undef PG8_WAIT_L
#undef PG8_BAR
#undef PG8_SCHED
}
}

struct EpiIn {
    static constexpr bool PERM = true, AFTER_DRAIN = false;
    bf16_t* P; float* G; float* lfT; float* lfS; const float* bg; float* kp; float* vp; float* ks; float* vs; float* lfp; float* lfs;
    __device__ __forceinline__ void operator()(const f32x4 (&acc)[2][2][4][2], const pg8::Unit& u, int wr, int wc, int fr, int fq) const {
        const int pn = u.pn, row0 = u.pm * 256 + wr * 64 + fr;
        if (pn < 24) {
            float sc = 1.f; if (pn < 2) sc = QA_SCALE; else if (pn >= 12 && pn < 16) sc = QB_SCALE;
            const int col0 = pn * 256 + wc * 32 + 8 * fq;
            const bool kv = pn >= 16; const bool isv = pn >= 20; const int fcol0 = (pn - (isv ? 20 : 16)) * 256 + wc * 32 + 8 * fq;
#pragma unroll
            for (int ai = 0; ai < 2; ++ai)
#pragma unroll
                for (int m = 0; m < 4; ++m) { const int row = row0 + ai * 128 + m * 16;
#pragma unroll
                    for (int bj = 0; bj < 2; ++bj) { const f32x4 v0 = acc[ai][bj][m][0] * sc, v1 = acc[ai][bj][m][1] * sc;
                        u32x4 w; w.x = pkbf(v0[0], v0[1]); w.y = pkbf(v0[2], v0[3]); w.z = pkbf(v1[0], v1[1]); w.w = pkbf(v1[2], v1[3]);
                        *(GAS u32x4*)(P + (size_t)row * NP + col0 + bj * 128) = w;
                        if (kv && row < MT) { float* dst = row < MP ? (isv ? vp : kp) + (size_t)row * 1024 : (isv ? vs : ks) + (size_t)(row - MP) * 1024;
                            dst += fcol0 + bj * 128; *(GAS f32x4*)dst = v0; *(GAS f32x4*)(dst + 4) = v1; } } }
        } else if (wc == 0 && fq < 2) {
#pragma unroll
            for (int ai = 0; ai < 2; ++ai)
#pragma unroll
                for (int m = 0; m < 4; ++m) { const int row = row0 + ai * 128 + m * 16;
                    if (row < MT) {
#pragma unroll
                        for (int n = 0; n < 2; ++n)
#pragma unroll
                            for (int i = 0; i < 4; ++i) { const int c = 8 * fq + 4 * n + i; float gt = acc[ai][0][m][n][i] + ((const GAS float*)bg)[c];
                                if (c >= 4) gt = log_sigmoid(gt);
                                ((GAS float*)G)[(size_t)row * 16 + c] = gt;
                                if (c >= 8) { const int h = c - 8;
                                    if (row < MP) { ((GAS float*)lfp)[(size_t)row * 8 + h] = gt; ((GAS float*)lfT)[(size_t)((row >> 12) * 8 + h) * 4096 + (row & 4095)] = gt; }
                                    else { const int rs = row - MP; ((GAS float*)lfs)[(size_t)rs * 8 + h] = gt; ((GAS float*)lfS)[((rs >> 4) * 8 + h) * 16 + (rs & 15)] = gt; } } } } }
        }
    }
};
struct EpiRes {
    static constexpr bool PERM = true, AFTER_DRAIN = false;
    const bf16_t* R; bf16_t* Z;
    __device__ __forceinline__ void operator()(const f32x4 (&acc)[2][2][4][2], const pg8::Unit& u, int wr, int wc, int fr, int fq) const {
        const int row0 = u.pm * 256 + wr * 64 + fr, col0 = u.pn * 256 + wc * 32 + 8 * fq;
#pragma unroll
        for (int ai = 0; ai < 2; ++ai)
#pragma unroll
            for (int m = 0; m < 4; ++m) { const size_t off = (size_t)(row0 + ai * 128 + m * 16) * DM + col0;
#pragma unroll
                for (int bj = 0; bj < 2; ++bj) { const u32x4 r = *(const GAS u32x4*)(R + off + bj * 128);
                    f32x4 v0 = acc[ai][bj][m][0], v1 = acc[ai][bj][m][1];
                    v0[0] += ALPHA * bflo(r.x); v0[1] += ALPHA * bfhi(r.x); v0[2] += ALPHA * bflo(r.y); v0[3] += ALPHA * bfhi(r.y);
                    v1[0] += ALPHA * bflo(r.z); v1[1] += ALPHA * bfhi(r.z); v1[2] += ALPHA * bflo(r.w); v1[3] += ALPHA * bfhi(r.w);
                    u32x4 w; w.x = pkbf(v0[0], v0[1]); w.y = pkbf(v0[2], v0[3]); w.z = pkbf(v1[0], v1[1]); w.w = pkbf(v1[2], v1[3]);
                    *(GAS u32x4*)(Z + off + bj * 128) = w; } }
    }
};
struct EpiPart {
    static constexpr bool PERM = true, AFTER_DRAIN = false;
    float* part;
    __device__ __forceinline__ void operator()(const f32x4 (&acc)[2][2][4][2], const pg8::Unit& u, int wr, int wc, int fr, int fq) const {
        const int r0 = wr * 64 + fr, col0 = u.pn * 256 + wc * 32 + 8 * fq;
#pragma unroll
        for (int m = 0; m < 4; ++m) { float* dst = part + ((size_t)u.pk * MS + r0 + m * 16) * DM + col0;
#pragma unroll
            for (int bj = 0; bj < 2; ++bj) { *(GAS f32x4*)(dst + bj * 128) = acc[0][bj][m][0]; *(GAS f32x4*)(dst + bj * 128 + 4) = acc[0][bj][m][1]; } }
    }
};
struct EpiUp {
    static constexpr bool PERM = true, AFTER_DRAIN = false;
    bf16_t* H;
    __device__ __forceinline__ void operator()(const f32x4 (&acc)[2][2][4][2], const pg8::Unit& u, int wr, int wc, int fr, int fq) const {
        const int row0 = u.pm * 256 + wr * 64 + fr, col0 = u.pn * 256 + wc * 32 + 8 * fq;
#pragma unroll
        for (int ai = 0; ai < 2; ++ai)
#pragma unroll
            for (int m = 0; m < 4; ++m) { const size_t off = (size_t)(row0 + ai * 128 + m * 16) * DFF + col0;
#pragma unroll
                for (int bj = 0; bj < 2; ++bj) { f32x4 v0 = acc[ai][bj][m][0], v1 = acc[ai][bj][m][1];
#pragma unroll
                    for (int i = 0; i < 4; ++i) { const float a = fmaxf(v0[i], 0.f), b = fmaxf(v1[i], 0.f); v0[i] = a * a; v1[i] = b * b; }
                    u32x4 w; w.x = pkbf(v0[0], v0[1]); w.y = pkbf(v0[2], v0[3]); w.z = pkbf(v1[0], v1[1]); w.w = pkbf(v1[2], v1[3]);
                    *(GAS u32x4*)(H + off + bj * 128) = w; } }
    }
};

#define LDS_WAIT() asm volatile("s_waitcnt lgkmcnt(0)" ::: "memory")
__device__ __forceinline__ float scan_sum64(float x, int lane) {
#pragma unroll
    for (int o = 1; o < 64; o <<= 1) { const float y = __shfl_up(x, o); if (lane >= o) x += y; }
    return x;
}
__device__ __forceinline__ float scan_max64(float x, int lane) {
#pragma unroll
    for (int o = 1; o < 64; o <<= 1) { const float y = __shfl_up(x, o); if (lane >= o) x = fmaxf(x, y); }
    return x;
}
__device__ __forceinline__ float wave_sum64(float v) {
#pragma unroll
    for (int o = 1; o < 64; o <<= 1) v += __shfl_xor(v, o);
    return v;
}

__device__ __forceinline__ float xsum32(float x) { auto rr = __builtin_amdgcn_permlane32_swap(__float_as_uint(x), __float_as_uint(x), false, false); return __uint_as_float(rr[0]) + __uint_as_float(rr[1]); }
__device__ __forceinline__ float xmax32(float x) { auto rr = __builtin_amdgcn_permlane32_swap(__float_as_uint(x), __float_as_uint(x), false, false); return fmaxf(__uint_as_float(rr[0]), __uint_as_float(rr[1])); }
__device__ __forceinline__ float dpp_f(float x, const int ctrl_sel) {
    const int v = __float_as_int(x); int r;
    if (ctrl_sel == 0) r = __builtin_amdgcn_update_dpp(v, v, 0xB1, 0xF, 0xF, false);
    else if (ctrl_sel == 1) r = __builtin_amdgcn_update_dpp(v, v, 0x4E, 0xF, 0xF, false);
    else r = __builtin_amdgcn_update_dpp(v, v, 0x141, 0xF, 0xF, false);
    return __int_as_float(r);
}
__device__ __forceinline__ float bperm_f(int srclane, float x) { return __int_as_float(__builtin_amdgcn_ds_bpermute(srclane << 2, __float_as_int(x))); }
__device__ __forceinline__ float scan_sum64l(float x, int lane) {
#pragma unroll
    for (int o = 1; o < 64; o <<= 1) { const float y = bperm_f(lane - o, x); if (lane >= o) x += y; }
    return x;
}
__device__ __forceinline__ float scan_max64l(float x, int lane) {
#pragma unroll
    for (int o = 1; o < 64; o <<= 1) { const float y = bperm_f(lane - o, x); if (lane >= o) x = fmaxf(x, y); }
    return x;
}
__device__ __forceinline__ f32x16 mfma32(bf16x8 a, bf16x8 b, f32x16 c) { return __builtin_amdgcn_mfma_f32_32x32x16_bf16(a, b, c, 0, 0, 0); }
__device__ __forceinline__ f32x4 mfma16(bf16x8 a, bf16x8 b, f32x4 c) { return __builtin_amdgcn_mfma_f32_16x16x32_bf16(a, b, c, 0, 0, 0); }
__device__ __forceinline__ float fexp2(float x) { return __builtin_amdgcn_exp2f(x); }

__device__ __forceinline__ void transpose_item(const float* W, int Nsrc, int K, bf16_t* WT, LAS float* scr, int item, int nblk, int lane, bool inmap) {
    const int kb = item / nblk, nb = item % nblk, k0 = 64 * kb, n0 = 32 * nb;
    const int nd = n0 + (lane & 31); int sc = nd;
    if (inmap) sc = nd < 3072 ? nd : (nd < 6144 ? nd + 8 : (nd < 6152 ? nd - 3072 : (nd < 6160 ? nd : -1)));
    float wv_[32];
    const GAS float* wp = (const GAS float*)W + (size_t)(k0 + (lane >> 5)) * Nsrc + (sc >= 0 ? sc : 0);
#pragma unroll
    for (int i = 0; i < 32; ++i) wv_[i] = wp[(size_t)(2 * i) * Nsrc];
#pragma unroll
    for (int i = 0; i < 32; ++i) scr[(2 * i + (lane >> 5)) * 33 + (lane & 31)] = sc >= 0 ? wv_[i] : 0.f;
    LDS_WAIT();
    const int c = lane & 7;
#pragma unroll
    for (int j = 0; j < 4; ++j) { const int n = (lane >> 3) + 8 * j; const LAS float* s = scr + (8 * c) * 33 + n;
        u32x4 o; o.x = pkbf(s[0 * 33], s[1 * 33]); o.y = pkbf(s[2 * 33], s[3 * 33]); o.z = pkbf(s[4 * 33], s[5 * 33]); o.w = pkbf(s[6 * 33], s[7 * 33]);
        *(GAS u32x4*)(WT + (size_t)(n0 + n) * K + k0 + 8 * c) = o; }
    LDS_WAIT();
}
struct Args { const float* in[18]; float* out; unsigned char* ws; int ph_lo, ph_hi; };

__device__ __forceinline__ void convert_weights(const Args& a, int layer, LAS float* scr, int gw, int NGW, int lane, int it_end = 1 << 30) {
    unsigned char* ws = as_global(a.ws);
    const float* w_in = as_global(a.in[8]) + (size_t)layer * DM * NINSRC; const float* w_out = as_global(a.in[11]) + (size_t)layer * DM * DM;
    const float* w_up = as_global(a.in[14]) + (size_t)layer * DM * DFF; const float* w_dn = as_global(a.in[15]) + (size_t)layer * DFF * DM;
    constexpr int I_IN = 32 * 200, I_OUT = 32 * 64, I_UP = 32 * 256, I_DN = 128 * 64;
    const int it_stop = it_end < I_IN + I_OUT + I_UP + I_DN ? it_end : I_IN + I_OUT + I_UP + I_DN;
    for (int it = gw; it < it_stop; it += NGW) {
        int r = it;
        if (r < I_IN) { transpose_item(w_in, NINSRC, DM, (bf16_t*)(ws + WS_WIN), scr, r, 200, lane, true); continue; } r -= I_IN;
        if (r < I_OUT) { transpose_item(w_out, DM, DM, (bf16_t*)(ws + (layer ? WS_WOUT2 : WS_WOUT)), scr, r, 64, lane, false); continue; } r -= I_OUT;
        if (r < I_UP) { transpose_item(w_up, DFF, DM, (bf16_t*)(ws + (layer ? WS_WUP2 : WS_WUP)), scr, r, 256, lane, false); continue; } r -= I_UP;
        transpose_item(w_dn, DM, DFF, (bf16_t*)(ws + WS_WDN), scr, r, 64, lane, false);
    }
}
__device__ __forceinline__ void convert_x(const Args& a, int gw, int NGW, int lane) {
    bf16_t* XB = (bf16_t*)(as_global(a.ws) + WS_XB);
    f32x4 xr[8];
#define CX_LOAD(row_) do { const GAS f32x4* x_ = (const GAS f32x4*)((row_) < MP ? as_global(a.in[0]) + (size_t)(row_) * DM : as_global(a.in[1]) + (size_t)((row_) - MP) * DM) + lane; _Pragma("unroll") for (int j = 0; j < 8; ++j) xr[j] = x_[64 * j]; } while (0)
    if (gw < MT) CX_LOAD(gw);
    for (int row = gw; row < MPAD; row += NGW) {
        GAS u32x2* o = (GAS u32x2*)(XB + (size_t)row * DM) + lane;
        if (row < MT) { u32x2 w[8];
#pragma unroll
            for (int j = 0; j < 8; ++j) { w[j].x = pkbf(xr[j][0], xr[j][1]); w[j].y = pkbf(xr[j][2], xr[j][3]); }
            if (row + NGW < MT) CX_LOAD(row + NGW);
#pragma unroll
            for (int j = 0; j < 8; ++j) o[64 * j] = w[j]; }
        else {
#pragma unroll
            for (int j = 0; j < 8; ++j) o[64 * j] = (u32x2){0u, 0u}; }
    }
#undef CX_LOAD
}
__device__ __forceinline__ void ln_phase(const bf16_t* Z, const bf16_t* RES, const float* part, int nsl, const float* g, const float* b, bf16_t* XB, float* outp, float* outs, int gw, int NGW, int lane,
                                         LAS float* scr, int wave, int bid, int nblk) {
    f32x4 gv[8], bv[8];
#pragma unroll
    for (int j = 0; j < 8; ++j) { gv[j] = ((const GAS f32x4*)g)[lane + 64 * j]; bv[j] = ((const GAS f32x4*)b)[lane + 64 * j]; }
#define LN_FINISH(v, row) do { float s = 0.f; \
        _Pragma("unroll") for (int j = 0; j < 8; ++j) s += (v[j][0] + v[j][1]) + (v[j][2] + v[j][3]); \
        const float mean = wave_sum64(s) * (1.f / DM); float s2 = 0.f; \
        _Pragma("unroll") for (int j = 0; j < 8; ++j) { v[j] = v[j] - mean; s2 += (v[j][0] * v[j][0] + v[j][1] * v[j][1]) + (v[j][2] * v[j][2] + v[j][3] * v[j][3]); } \
        const float rstd = 1.0f / sqrtf(wave_sum64(s2) * (1.f / DM) + LN_EPS); \
        _Pragma("unroll") for (int j = 0; j < 8; ++j) v[j] = v[j] * rstd * gv[j] + bv[j]; \
        if (XB) { GAS u32x2* o = (GAS u32x2*)(XB + (size_t)(row) * DM) + lane; \
            _Pragma("unroll") for (int j = 0; j < 8; ++j) { u32x2 w; w.x = pkbf(v[j][0], v[j][1]); w.y = pkbf(v[j][2], v[j][3]); o[64 * j] = w; } } \
        if (outp) { GAS f32x4* o = (GAS f32x4*)((row) < MP ? outp + (size_t)(row) * DM : outs + (size_t)((row) - MP) * DM) + lane; \
            _Pragma("unroll") for (int j = 0; j < 8; ++j) o[64 * j] = v[j]; } } while (0)
    for (int r = bid; r < MS; r += nblk) {
        f32x4 acc[8];
#pragma unroll
        for (int j = 0; j < 8; ++j) acc[j] = (f32x4){0.f, 0.f, 0.f, 0.f};
        for (int sl = wave; sl < nsl; sl += 8) { const GAS f32x4* p = (const GAS f32x4*)(part + ((size_t)sl * MS + r) * DM) + lane;
#pragma unroll
            for (int j = 0; j < 8; ++j) acc[j] += p[64 * j]; }
#pragma unroll
        for (int j = 0; j < 8; ++j) *(LAS f32x4*)(scr + wave * 2048 + (lane + 64 * j) * 4) = acc[j];
        __syncthreads();
        if (wave == 0) { const GAS u32x2* z_ = (const GAS u32x2*)(RES + (size_t)(MP + r) * DM) + lane; f32x4 v[8];
#pragma unroll
            for (int j = 0; j < 8; ++j) { const u32x2 w = z_[64 * j]; v[j] = (f32x4){ALPHA * bflo(w.x), ALPHA * bfhi(w.x), ALPHA * bflo(w.y), ALPHA * bfhi(w.y)}; }
#pragma unroll
            for (int w8 = 0; w8 < 8; ++w8)
#pragma unroll
                for (int j = 0; j < 8; ++j) v[j] += *(LAS const f32x4*)(scr + w8 * 2048 + (lane + 64 * j) * 4);
            LN_FINISH(v, MP + r); }
        __syncthreads();
    }
    u32x2 zr[8];
#define LN_LOAD(row_) do { const GAS u32x2* z_ = (const GAS u32x2*)(Z + (size_t)(row_) * DM) + lane; _Pragma("unroll") for (int j = 0; j < 8; ++j) zr[j] = z_[64 * j]; } while (0)
    if (gw < MP) LN_LOAD(gw);
    for (int row = gw; row < MP; row += NGW) {
        f32x4 v[8];
#pragma unroll
        for (int j = 0; j < 8; ++j) v[j] = (f32x4){bflo(zr[j].x), bfhi(zr[j].x), bflo(zr[j].y), bfhi(zr[j].y)};
        if (row + NGW < MP) LN_LOAD(row + NGW);
        LN_FINISH(v, row);
    }
#undef LN_LOAD
#undef LN_FINISH
}

constexpr int AT_K = 0, AT_V = 34816, AT_NF = 75776, AT_SCR = 92160, AVP = 320;
__device__ __forceinline__ void fox_prompt_unit(LAS char* L, const bf16_t* P, const float* lfT, bf16_t* MIX, int b, int h, int qb, const int wv) {
    const int tid = opaque_tid(wv), lane = tid & 63, wid = __builtin_amdgcn_readfirstlane(tid >> 6), r32 = lane & 31, hi = lane >> 5, i16 = lane & 15, cb = (lane >> 4) & 1;
    const int qend = 256 * (qb + 1), NT = 4 * (qb + 1);
    const size_t rowb = (size_t)b * SEQ;
    LAS float* nfk = (LAS float*)(L + AT_NF); LAS float* scr = (LAS float*)(L + AT_SCR);
    {
        float v[8]; const bool act = 8 * tid < qend;
        if (act) { const GAS f32x4* src = (const GAS f32x4*)(lfT + (size_t)(b * 8 + h) * 4096 + 8 * tid); const f32x4 a = src[0], c = src[1];
            v[0] = a[0]; v[1] = a[1]; v[2] = a[2]; v[3] = a[3]; v[4] = c[0]; v[5] = c[1]; v[6] = c[2]; v[7] = c[3]; }
        else {
#pragma unroll
            for (int i = 0; i < 8; ++i) v[i] = 0.f; }
#pragma unroll
        for (int i = 1; i < 8; ++i) v[i] += v[i - 1];
        const float tot = v[7]; const float x = scan_sum64(tot, lane);
        if (lane == 63) scr[wid] = x;
        __syncthreads();
        float off = 0.f;
        for (int w = 0; w < wid; ++w) off += scr[w];
        const float base = off + x - tot;
        if (act) {
#pragma unroll
            for (int i = 0; i < 8; ++i) nfk[8 * tid + i] = -(base + v[i]) * LOG2E; }
    }
    const bf16_t* Kg = P + rowb * NP + PC_KB + h * 128; const bf16_t* Vg = P + rowb * NP + PC_VB + h * 128;
    u32x4 kr[2], vr[2];
#define AT_LOAD(t) do { _Pragma("unroll") for (int i_ = 0; i_ < 2; ++i_) { const int c_ = tid + 512 * i_, row_ = c_ >> 4, ch_ = c_ & 15; \
        kr[i_] = *(const GAS u32x4*)(Kg + (size_t)(64 * (t) + row_) * NP + ch_ * 8); vr[i_] = *(const GAS u32x4*)(Vg + (size_t)(64 * (t) + row_) * NP + ch_ * 8); } } while (0)
#define AT_STORE(buf) do { _Pragma("unroll") for (int i_ = 0; i_ < 2; ++i_) { const int c_ = tid + 512 * i_, row_ = c_ >> 4, ch_ = c_ & 15; \
        *(LAS u32x4*)(L + AT_K + (buf) * 17408 + row_ * 272 + ch_ * 16) = kr[i_]; *(LAS u32x4*)(L + AT_V + (buf) * 20480 + row_ * AVP + ch_ * 16) = vr[i_]; } } while (0)
    bf16x8 qf[8];
    { const bf16_t* Qg = P + (rowb + 256 * qb + 32 * wid + r32) * NP + PC_QB + h * 128 + 8 * hi;
#pragma unroll
        for (int kk = 0; kk < 8; ++kk) qf[kk] = *(const GAS bf16x8*)(Qg + 16 * kk); }
    f32x16 o[4];
#pragma unroll
    for (int d = 0; d < 4; ++d)
#pragma unroll
        for (int r = 0; r < 16; ++r) o[d][r] = 0.f;
    float m = -INFINITY, l = 0.f;
    AT_LOAD(0); AT_STORE(0);
    __syncthreads();
    for (int t = 0; t < NT; ++t) {
        if (t + 1 < NT) AT_LOAD(t + 1);
        const int jb = t - (NT - 4);
        if (!(jb >= 0 && 64 * jb > 32 * wid + 31)) {
            LAS const char* Kb = L + AT_K + (t & 1) * 17408; LAS const char* Vb = L + AT_V + (t & 1) * 20480;
            LAS const float* nf = nfk + 64 * t;
            f32x16 s0, s1;
#pragma unroll
            for (int g = 0; g < 4; ++g) { const f32x4 a = *(LAS const f32x4*)(nf + 8 * g + 4 * hi), c = *(LAS const f32x4*)(nf + 32 + 8 * g + 4 * hi);
                s0[4 * g] = a[0]; s0[4 * g + 1] = a[1]; s0[4 * g + 2] = a[2]; s0[4 * g + 3] = a[3]; s1[4 * g] = c[0]; s1[4 * g + 1] = c[1]; s1[4 * g + 2] = c[2]; s1[4 * g + 3] = c[3]; }
            {
                bf16x8 ka[16];
#pragma unroll
                for (int kk = 0; kk < 8; ++kk) { ka[2 * kk] = *(LAS const bf16x8*)(Kb + r32 * 272 + kk * 32 + hi * 16); ka[2 * kk + 1] = *(LAS const bf16x8*)(Kb + (32 + r32) * 272 + kk * 32 + hi * 16); }
                __builtin_amdgcn_sched_barrier(0);
#pragma unroll
                for (int kk = 0; kk < 8; ++kk) { s0 = mfma32(ka[2 * kk], qf[kk], s0); s1 = mfma32(ka[2 * kk + 1], qf[kk], s1); }
                __builtin_amdgcn_sched_barrier(0);
            }
            if (jb >= 0 && 64 * jb + 63 > 32 * wid) { const int q = 32 * wid + r32;
#pragma unroll
                for (int r = 0; r < 16; ++r) { const int kv = 64 * jb + crow(r, hi); if (kv > q) s0[r] = -INFINITY; if (kv + 32 > q) s1[r] = -INFINITY; } }
            float mx = fmaxf(s0[0], s1[0]);
#pragma unroll
            for (int r = 1; r < 16; ++r) mx = fmaxf(mx, fmaxf(s0[r], s1[r]));
            mx = xmax32(mx);
            const float mn = fmaxf(m, mx), alpha = fexp2(m - mn); m = mn;
            float ls = 0.f;
#pragma unroll
            for (int r = 0; r < 16; ++r) { s0[r] = fexp2(s0[r] - mn); s1[r] = fexp2(s1[r] - mn); ls += s0[r] + s1[r]; }
            l = l * alpha + ls;
#pragma unroll
            for (int d = 0; d < 4; ++d)
#pragma unroll
                for (int r = 0; r < 16; ++r) o[d][r] *= alpha;
            bf16x8 pf[4];
            { u32x4 w;
              w.x = pkbf(s0[0], s0[1]); w.y = pkbf(s0[2], s0[3]); w.z = pkbf(s0[4], s0[5]); w.w = pkbf(s0[6], s0[7]); pf[0] = __builtin_bit_cast(bf16x8, w);
              w.x = pkbf(s0[8], s0[9]); w.y = pkbf(s0[10], s0[11]); w.z = pkbf(s0[12], s0[13]); w.w = pkbf(s0[14], s0[15]); pf[1] = __builtin_bit_cast(bf16x8, w);
              w.x = pkbf(s1[0], s1[1]); w.y = pkbf(s1[2], s1[3]); w.z = pkbf(s1[4], s1[5]); w.w = pkbf(s1[6], s1[7]); pf[2] = __builtin_bit_cast(bf16x8, w);
              w.x = pkbf(s1[8], s1[9]); w.y = pkbf(s1[10], s1[11]); w.z = pkbf(s1[12], s1[13]); w.w = pkbf(s1[14], s1[15]); pf[3] = __builtin_bit_cast(bf16x8, w); }
#pragma unroll
            for (int ss = 0; ss < 4; ++ss)
#pragma unroll
                for (int d = 0; d < 4; ++d) { LAS const char* vp = Vb + (16 * ss + 4 * hi + (i16 >> 2)) * AVP + (32 * d + 16 * cb + 4 * (i16 & 3)) * 2;
                    o[d] = mfma32(cat44(lds_tr(vp), lds_tr(vp + 8 * AVP)), pf[ss], o[d]); }
        }
        if (t + 1 < NT) AT_STORE((t + 1) & 1);
        __syncthreads();
    }
    l = xsum32(l);
    const float inv = 1.0f / l;
    bf16_t* Og = MIX + (rowb + 256 * qb + 32 * wid + r32) * DM + 1024 + h * 128 + 4 * hi;
#pragma unroll
    for (int d = 0; d < 4; ++d)
#pragma unroll
        for (int g = 0; g < 4; ++g) { u32x2 w; w.x = pkbf(o[d][4 * g] * inv, o[d][4 * g + 1] * inv); w.y = pkbf(o[d][4 * g + 2] * inv, o[d][4 * g + 3] * inv);
            *(GAS u32x2*)(Og + 32 * d + 8 * g) = w; }
#undef AT_LOAD
#undef AT_STORE
}

constexpr int FS_Q = 0, FS_NF = 8448, FS_SC = 12672, FS_TL = 80512, FS_LI = 97408, FS_SCP = 1060;
__device__ __forceinline__ void fox_sample_item(LAS char* L, const bf16_t* P, const float* lfS, const float* ck, const float* cv, const float* clf, bf16_t* MIX, int sb, int h, const int wv) {
    const int tid = opaque_tid(wv), lane = tid & 63, wid = __builtin_amdgcn_readfirstlane(tid >> 6);
    LAS float* QF = (LAS float*)(L + FS_Q); LAS float* NF = (LAS float*)(L + FS_NF); LAS float* SC = (LAS float*)(L + FS_SC); LAS float* TL = (LAS float*)(L + FS_TL); LAS float* LI = (LAS float*)(L + FS_LI);
    const size_t srow = (size_t)MP + sb * 16;
    for (int e = tid; e < 16 * 128; e += 512) { const int q = e >> 7, d = e & 127; QF[q * 132 + d] = bf2f(((const GAS bf16_t*)P)[(srow + q) * NP + PC_QB + h * 128 + d]); }
    if (wid == 0) {
        float v[17];
#pragma unroll
        for (int i = 0; i < 17; ++i) { const int idx = 17 * lane + i; float x = 0.f;
            if (idx < PAST) x = ((const GAS float*)clf)[((size_t)sb * PAST + idx) * 8 + h]; else if (idx < PAST + 16) x = ((const GAS float*)lfS)[(sb * 8 + h) * 16 + idx - PAST];
            v[i] = x; }
#pragma unroll
        for (int i = 1; i < 17; ++i) v[i] += v[i - 1];
        const float tot = v[16], x = scan_sum64(tot, lane), base = x - tot;
#pragma unroll
        for (int i = 0; i < 17; ++i) { const int idx = 17 * lane + i; if (idx < 1056) NF[idx] = -(base + v[i]) * LOG2E; }
    }
    f32x4 ta[2], tb2[2], tc[2];
#define FS_LOAD(R, src, pcol, tile) do { _Pragma("unroll") for (int i_ = 0; i_ < 2; ++i_) { const int c_ = tid + 512 * i_, row_ = c_ >> 5, ch_ = c_ & 31, kv_ = 32 * (tile) + row_; \
        if (kv_ < PAST) R[i_] = *(const GAS f32x4*)((src) + (((size_t)sb * PAST + kv_) * 8 + h) * 128 + 4 * ch_); \
        else if (kv_ < PAST + 16) { const u32x2 w_ = *(const GAS u32x2*)(P + (srow + kv_ - PAST) * NP + (pcol) + h * 128 + 4 * ch_); R[i_] = (f32x4){bflo(w_.x), bfhi(w_.x), bflo(w_.y), bfhi(w_.y)}; } \
        else R[i_] = (f32x4){0.f, 0.f, 0.f, 0.f}; } } while (0)
#define FS_STORE(R) do { _Pragma("unroll") for (int i_ = 0; i_ < 2; ++i_) { const int c_ = tid + 512 * i_, row_ = c_ >> 5, ch_ = c_ & 31; *(LAS f32x4*)(TL + row_ * 132 + 4 * ch_) = R[i_]; } } while (0)
    FS_LOAD(ta, ck, PC_KB, 0); FS_LOAD(tb2, ck, PC_KB, 1); FS_LOAD(tc, ck, PC_KB, 2);
    __syncthreads();
    {
        const int q = tid & 15, kl = tid >> 4;
#define FS_SC_STEP(R, tile_) do { const int tile = (tile_); FS_STORE(R); __syncthreads(); if (tile + 3 < 33) FS_LOAD(R, ck, PC_KB, tile + 3); \
            float acc = 0.f; \
            _Pragma("unroll 8") for (int i = 0; i < 32; ++i) { const f32x4 a = *(LAS const f32x4*)(QF + q * 132 + 4 * i), k = *(LAS const f32x4*)(TL + kl * 132 + 4 * i); acc += a[0] * k[0] + a[1] * k[1] + a[2] * k[2] + a[3] * k[3]; } \
            const int kv = 32 * tile + kl; float s = acc + NF[kv]; \
            if (kv >= PAST + 16 || (kv >= PAST && kv - PAST > q)) s = -INFINITY; \
            SC[q * FS_SCP + kv] = s; __syncthreads(); } while (0)
        for (int t3 = 0; t3 < 33; t3 += 3) { FS_SC_STEP(ta, t3); FS_SC_STEP(tb2, t3 + 1); FS_SC_STEP(tc, t3 + 2); }
#undef FS_SC_STEP
    }
    FS_LOAD(ta, cv, PC_VB, 0); FS_LOAD(tb2, cv, PC_VB, 1); FS_LOAD(tc, cv, PC_VB, 2);
    {
#pragma unroll
        for (int qq = 0; qq < 2; ++qq) { const int q = 2 * wid + qq; float mx = -INFINITY;
            for (int kv = lane; kv < 1056; kv += 64) mx = fmaxf(mx, SC[q * FS_SCP + kv]);
#pragma unroll
            for (int o = 1; o < 64; o <<= 1) mx = fmaxf(mx, __shfl_xor(mx, o));
            float sm = 0.f;
            for (int kv = lane; kv < 1056; kv += 64) { const float p = fexp2(SC[q * FS_SCP + kv] - mx); SC[q * FS_SCP + kv] = p; sm += p; }
            sm = wave_sum64(sm);
            if (lane == 0) LI[q] = 1.0f / sm; }
    }
    __syncthreads();
    {
        const int d = tid & 127, qg = tid >> 7; float o0 = 0.f, o1 = 0.f, o2 = 0.f, o3 = 0.f;
#define FS_PV_STEP(R, tile_) do { const int tile = (tile_); FS_STORE(R); __syncthreads(); if (tile + 3 < 33) FS_LOAD(R, cv, PC_VB, tile + 3); \
            _Pragma("unroll 8") for (int kl = 0; kl < 32; ++kl) { const float v = TL[kl * 132 + d]; const int kv = 32 * tile + kl; LAS const float* sp = SC + (4 * qg) * FS_SCP + kv; \
                o0 += sp[0] * v; o1 += sp[FS_SCP] * v; o2 += sp[2 * FS_SCP] * v; o3 += sp[3 * FS_SCP] * v; } \
            __syncthreads(); } while (0)
        for (int t3 = 0; t3 < 33; t3 += 3) { FS_PV_STEP(ta, t3); FS_PV_STEP(tb2, t3 + 1); FS_PV_STEP(tc, t3 + 2); }
#undef FS_PV_STEP
        GAS bf16_t* Og = (GAS bf16_t*)MIX + (srow + 4 * qg) * DM + 1024 + h * 128 + d;
        Og[0] = (bf16_t)(pkbf(o0 * LI[4 * qg], 0.f) & 0xffffu); Og[DM] = (bf16_t)(pkbf(o1 * LI[4 * qg + 1], 0.f) & 0xffffu);
        Og[2 * DM] = (bf16_t)(pkbf(o2 * LI[4 * qg + 2], 0.f) & 0xffffu); Og[3 * DM] = (bf16_t)(pkbf(o3 * LI[4 * qg + 3], 0.f) & 0xffffu);
    }
#undef FS_LOAD
#undef FS_STORE
}

constexpr int ML_Q = 0, ML_K = 17408, ML_KT = 34816, ML_V = 55296, ML_S = 92160, ML_FA = 101376, ML_N = 102656, ML_SSQ = 103168, ML_GH = 105216, ML_GP = 106240, ML_NP = 139008, ML_RS = 143104;
constexpr int KTP = 320, VP = 576;
__device__ __forceinline__ void mlstm_item(LAS char* L, const bf16_t* P, const float* G, bf16_t* MIX, const float* ghead, size_t row0, int hh, int nch, int Lv,
                                           const float* c0, const float* n0, const float* m0, float* cout, float* nout, float* mout, const int wv) {
    const int tid = opaque_tid(wv), lane = tid & 63, wid = __builtin_amdgcn_readfirstlane(tid >> 6), r32 = lane & 31, hi = lane >> 5, i16 = lane & 15, cb = (lane >> 4) & 1;
    LAS float* FA = (LAS float*)(L + ML_FA); LAS float* ROWT = FA, *COLS = FA + 64, *WINT = FA + 128, *EMT = FA + 192, *NQ = FA + 256;
    LAS float* NST = (LAS float*)(L + ML_N); LAS float* SSQ = (LAS float*)(L + ML_SSQ); LAS float* RS = (LAS float*)(L + ML_RS);
    f32x16 cT[4];
#pragma unroll
    for (int kb = 0; kb < 4; ++kb)
#pragma unroll
        for (int r = 0; r < 16; ++r) cT[kb][r] = c0 ? ((const GAS float*)c0)[(size_t)(32 * wid + r32) * 128 + 32 * kb + crow(r, hi)] : 0.f;
    if (tid < 128) NST[tid] = n0 ? ((const GAS float*)n0)[tid] : 0.f;
    float m = m0 ? ((const GAS float*)m0)[0] : 0.f;
    LAS float* GH = (LAS float*)(L + ML_GH);
    if (tid < 256) GH[tid] = ((const GAS float*)ghead)[hh * 256 + tid];
    u32x4 qr[2], kr[2], vr[4]; float igr;
#define ML_LOADQK(j) do { const size_t rb_ = row0 + 64 * (size_t)(j); \
        _Pragma("unroll") for (int i_ = 0; i_ < 2; ++i_) { const int c_ = tl_ + 512 * i_, row_ = c_ >> 4, ch_ = c_ & 15; \
            if (row_ < Lv) { qr[i_] = *(const GAS u32x4*)(P + (rb_ + row_) * NP + PC_QA + hh * 128 + ch_ * 8); kr[i_] = *(const GAS u32x4*)(P + (rb_ + row_) * NP + PC_KA + hh * 128 + ch_ * 8); } \
            else { qr[i_] = (u32x4){0u, 0u, 0u, 0u}; kr[i_] = (u32x4){0u, 0u, 0u, 0u}; } } \
        if ((tl_ & 63) < Lv) { igr = ((const GAS float*)G)[(rb_ + (tl_ & 63)) * 16 + hh]; } else { igr = -INFINITY; } } while (0)
#define ML_LOADV(j) do { const size_t rb_ = row0 + 64 * (size_t)(j); \
        _Pragma("unroll") for (int i_ = 0; i_ < 4; ++i_) { const int c_ = tl_ + 512 * i_, row_ = c_ >> 5, ch_ = c_ & 31; \
            if (row_ < Lv) vr[i_] = *(const GAS u32x4*)(P + (rb_ + row_) * NP + PC_VA + hh * 256 + ch_ * 8); else vr[i_] = (u32x4){0u, 0u, 0u, 0u}; } } while (0)
    { int tl_ = tid; ML_LOADQK(0); ML_LOADV(0); }
    LAS float* BCS = (LAS float*)(L + ML_GP); LAS float* PMX = BCS + 4096; LAS float* NPART = (LAS float*)(L + ML_NP);
    for (int jj = wid; jj < nch; jj += 8) {
        float ig0 = -INFINITY, lf0 = 0.f;
        if (lane < Lv) { ig0 = ((const GAS float*)G)[(row0 + 64 * (size_t)jj + lane) * 16 + hh]; lf0 = ((const GAS float*)G)[(row0 + 64 * (size_t)jj + lane) * 16 + 4 + hh]; }
        const float bc = scan_sum64l(lf0, lane), pmx = scan_max64l(ig0 - bc, lane);
        BCS[jj * 64 + lane] = bc; PMX[jj * 64 + lane] = pmx;
    }
    __syncthreads();
    for (int j = 0; j < nch; ++j) {
        int tl_ = tid; asm volatile("" : "+v"(tl_));
        const int r32j = tl_ & 31, hij = (tl_ >> 5) & 1;
        const int lj = tl_ & 63;
        const float bcs = BCS[j * 64 + lj], pm = PMX[j * 64 + lj], u = igr - bcs;
        const float mt = bcs + fmaxf(m, pm);
        const float b63 = __int_as_float(__builtin_amdgcn_readlane(__float_as_int(bcs), 63)), mnew = __int_as_float(__builtin_amdgcn_readlane(__float_as_int(mt), 63));
        const float av = __expf(b63 + u - mnew), decay = __expf(b63 + m - mnew);
        if (wid == 0) { ROWT[lane] = bcs - mt; COLS[lane] = u; WINT[lane] = __expf(bcs + m - mt); EMT[lane] = __expf(-mt); }
        m = mnew;
#pragma unroll
        for (int i = 0; i < 2; ++i) { const int c = tid + 512 * i, row = c >> 4, ch = c & 15;
            *(LAS u32x4*)(L + ML_Q + row * 272 + ch * 16) = qr[i]; *(LAS u32x4*)(L + ML_K + row * 272 + ch * 16) = kr[i];
            const float as = bperm_f(row, av); u32x4 w;
            w.x = pkbf(bflo(kr[i].x) * as, bfhi(kr[i].x) * as); w.y = pkbf(bflo(kr[i].y) * as, bfhi(kr[i].y) * as);
            w.z = pkbf(bflo(kr[i].z) * as, bfhi(kr[i].z) * as); w.w = pkbf(bflo(kr[i].w) * as, bfhi(kr[i].w) * as);
            *(LAS u32x4*)(L + ML_KT + row * KTP + ch * 16) = w; }
        __syncthreads();
        const size_t rb = row0 + 64 * (size_t)j;
        if (j + 1 < nch) ML_LOADQK(j + 1);
        u32x2 og[2][4];
#pragma unroll
        for (int tb = 0; tb < 2; ++tb)
#pragma unroll
            for (int g = 0; g < 4; ++g) og[tb][g] = *(const GAS u32x2*)(P + (rb + 32 * tb + r32j) * NP + PC_OA + hh * 256 + 32 * wid + 8 * g + 4 * hij);
        {
            const int fr = lane & 15, fq = lane >> 4;
#pragma unroll
            for (int bi = 0; bi < 2; ++bi) { const int id = 2 * wid + bi, sb = id >> 2, tb = id & 3; const int t = 16 * tb + fr, s0 = 16 * sb + 4 * fq;
                u32x2 ow = (u32x2){0u, 0u};
                if (sb <= tb) { f32x4 acc = (f32x4){0.f, 0.f, 0.f, 0.f}; bf16x8 a4[4], q4[4];
#pragma unroll
                    for (int kk = 0; kk < 4; ++kk) { a4[kk] = *(LAS const bf16x8*)(L + ML_K + (16 * sb + fr) * 272 + kk * 64 + fq * 16); q4[kk] = *(LAS const bf16x8*)(L + ML_Q + (16 * tb + fr) * 272 + kk * 64 + fq * 16); }
                    __builtin_amdgcn_sched_barrier(0);
#pragma unroll
                    for (int kk = 0; kk < 4; ++kk) acc = mfma16(a4[kk], q4[kk], acc);
                    const float rt = ROWT[t]; const f32x4 cs = *(LAS const f32x4*)(COLS + s0); float v[4];
#pragma unroll
                    for (int i = 0; i < 4; ++i) v[i] = (s0 + i <= t) ? acc[i] * __expf(rt + cs[i]) : 0.f;
                    ow.x = pkbf(v[0], v[1]); ow.y = pkbf(v[2], v[3]); }
                *(LAS u32x2*)(L + ML_S + t * 144 + s0 * 2) = ow;
                float ps = (bflo(ow.x) + bfhi(ow.x)) + (bflo(ow.y) + bfhi(ow.y));
                { auto r1 = __builtin_amdgcn_permlane16_swap(__float_as_uint(ps), __float_as_uint(ps), false, false); ps = __uint_as_float(r1[0]) + __uint_as_float(r1[1]); }
                ps = xsum32(ps);
                if (fq == 0) RS[sb * 64 + t] = ps; }
            const int t = 8 * wid + (lane >> 3), kp = lane & 7;
            const u32x4 q0 = *(LAS const u32x4*)(L + ML_Q + t * 272 + kp * 32), q1 = *(LAS const u32x4*)(L + ML_Q + t * 272 + kp * 32 + 16);
            const f32x4 n0v = *(LAS const f32x4*)(NST + 16 * kp), n1v = *(LAS const f32x4*)(NST + 16 * kp + 4), n2v = *(LAS const f32x4*)(NST + 16 * kp + 8), n3v = *(LAS const f32x4*)(NST + 16 * kp + 12);
            float d = bflo(q0.x) * n0v[0] + bfhi(q0.x) * n0v[1] + bflo(q0.y) * n0v[2] + bfhi(q0.y) * n0v[3] + bflo(q0.z) * n1v[0] + bfhi(q0.z) * n1v[1] + bflo(q0.w) * n1v[2] + bfhi(q0.w) * n1v[3]
                    + bflo(q1.x) * n2v[0] + bfhi(q1.x) * n2v[1] + bflo(q1.y) * n2v[2] + bfhi(q1.y) * n2v[3] + bflo(q1.z) * n3v[0] + bfhi(q1.z) * n3v[1] + bflo(q1.w) * n3v[2] + bfhi(q1.w) * n3v[3];
            d += dpp_f(d, 0); d += dpp_f(d, 1); d += dpp_f(d, 2);
            if (kp == 0) NQ[t] = d;
        }
#pragma unroll
        for (int i = 0; i < 4; ++i) { const int c = tid + 512 * i, row = c >> 5, ch = c & 31; *(LAS u32x4*)(L + ML_V + row * VP + ch * 16) = vr[i]; }
        __syncthreads();
        bf16x8 vf[4];
#pragma unroll
        for (int ss = 0; ss < 4; ++ss) { LAS const char* vp = L + ML_V + (16 * ss + 8 * hi + (i16 >> 2)) * VP + (32 * wid + 16 * cb + 4 * (i16 & 3)) * 2; vf[ss] = cat44(lds_tr(vp), lds_tr(vp + 4 * VP)); }
        f32x16 oa[2];
#pragma unroll
        for (int tb = 0; tb < 2; ++tb)
#pragma unroll
            for (int r = 0; r < 16; ++r) oa[tb][r] = 0.f;
        {
            u32x2 qbuf[2][2][2];
#define ML_LDQ(buf, st_) do { _Pragma("unroll") for (int tb = 0; tb < 2; ++tb) { LAS const char* qp = L + ML_Q + (32 * tb + r32) * 272 + (16 * (st_) + 4 * hi) * 2; qbuf[buf][tb][0] = *(LAS const u32x2*)qp; qbuf[buf][tb][1] = *(LAS const u32x2*)(qp + 16); } } while (0)
            ML_LDQ(0, 0);
#pragma unroll
            for (int st = 0; st < 8; ++st) { const int kb = st >> 1, s2 = st & 1;
                if (st < 7) ML_LDQ((st + 1) & 1, st + 1);
                u32x4 w; w.x = pkbf(cT[kb][8 * s2], cT[kb][8 * s2 + 1]); w.y = pkbf(cT[kb][8 * s2 + 2], cT[kb][8 * s2 + 3]); w.z = pkbf(cT[kb][8 * s2 + 4], cT[kb][8 * s2 + 5]); w.w = pkbf(cT[kb][8 * s2 + 6], cT[kb][8 * s2 + 7]);
                const bf16x8 af = __builtin_bit_cast(bf16x8, w);
#pragma unroll
                for (int tb = 0; tb < 2; ++tb) { const u32x4 bw = (u32x4){qbuf[st & 1][tb][0].x, qbuf[st & 1][tb][0].y, qbuf[st & 1][tb][1].x, qbuf[st & 1][tb][1].y}; oa[tb] = mfma32(af, __builtin_bit_cast(bf16x8, bw), oa[tb]); }
                __builtin_amdgcn_sched_barrier(0); }
#undef ML_LDQ
        }
#pragma unroll
        for (int tb = 0; tb < 2; ++tb) { const float w = WINT[32 * tb + r32];
#pragma unroll
            for (int r = 0; r < 16; ++r) oa[tb][r] *= w;
#pragma unroll
            for (int ss = 0; ss < 4; ++ss) if (tb == 1 || ss < 2) { const u32x4 sw = *(LAS const u32x4*)(L + ML_S + (32 * tb + r32) * 144 + (16 * ss + 8 * hi) * 2);
                oa[tb] = mfma32(vf[ss], __builtin_bit_cast(bf16x8, sw), oa[tb]); } }
#pragma unroll
        for (int tb = 0; tb < 2; ++tb) { const int t = 32 * tb + r32; const float rs = (RS[t] + RS[64 + t]) + (RS[128 + t] + RS[192 + t]);
            const float den = WINT[t] * NQ[t] + rs, dn = fmaxf(fabsf(den), EMT[t]), inv = __builtin_amdgcn_rcpf(dn); float sq = 0.f;
#pragma unroll
            for (int r = 0; r < 16; ++r) { oa[tb][r] *= inv; sq += oa[tb][r] * oa[tb][r]; }
            sq = xsum32(sq);
            if (hi == 0) SSQ[wid * 64 + t] = sq; }
#pragma unroll
        for (int kb = 0; kb < 4; ++kb)
#pragma unroll
            for (int r = 0; r < 16; ++r) cT[kb][r] *= decay;
        {
            s16x4 ktb[2][2][2];
#define ML_LDK(buf, st_) do { _Pragma("unroll") for (int k2 = 0; k2 < 2; ++k2) { LAS const char* kp = L + ML_KT + (16 * ((st_) >> 1) + 8 * hi + (i16 >> 2)) * KTP + (32 * (2 * ((st_) & 1) + k2) + 16 * cb + 4 * (i16 & 3)) * 2; ktb[buf][k2][0] = lds_tr(kp); ktb[buf][k2][1] = lds_tr(kp + 4 * KTP); } } while (0)
            ML_LDK(0, 0);
#pragma unroll
            for (int st = 0; st < 8; ++st) {
                if (st < 7) ML_LDK((st + 1) & 1, st + 1);
#pragma unroll
                for (int k2 = 0; k2 < 2; ++k2) cT[2 * (st & 1) + k2] = mfma32(cat44(ktb[st & 1][k2][0], ktb[st & 1][k2][1]), vf[st >> 1], cT[2 * (st & 1) + k2]);
                __builtin_amdgcn_sched_barrier(0); }
#undef ML_LDK
        }
        { float a0 = 0.f, a1 = 0.f;
#pragma unroll
            for (int s = 0; s < 8; ++s) { a0 += bf2f(*(LAS const bf16_t*)(L + ML_KT + (8 * wid + s) * KTP + lane * 2)); a1 += bf2f(*(LAS const bf16_t*)(L + ML_KT + (8 * wid + s) * KTP + 128 + lane * 2)); }
            NPART[wid * 128 + lane] = a0; NPART[wid * 128 + 64 + lane] = a1; }
        __syncthreads();
        if (j + 1 < nch) ML_LOADV(j + 1);
        if (tid < 128) { float acc = 0.f;
#pragma unroll
            for (int w = 0; w < 8; ++w) acc += NPART[w * 128 + tid];
            NST[tid] = decay * NST[tid] + acc; }
#pragma unroll
        for (int tb = 0; tb < 2; ++tb) { const int t = 32 * tb + r32; float tot = 0.f;
#pragma unroll
            for (int w = 0; w < 8; ++w) tot += SSQ[w * 64 + t];
            const float rsn = __builtin_amdgcn_rsqf(tot * (1.0f / 256.0f) + HN_EPS);
            if (t < Lv) { bf16_t* op = MIX + (rb + 32 * tb + r32j) * DM + hh * 256 + 32 * wid + 4 * hij;
#pragma unroll
                for (int g = 0; g < 4; ++g) { const u32x2 ov = og[tb][g]; const float o0 = bflo(ov.x), o1 = bfhi(ov.x), o2 = bflo(ov.y), o3 = bfhi(ov.y);
                    const f32x4 gh = *(LAS const f32x4*)(GH + 32 * wid + 8 * g + 4 * hi);
                    const float v0 = oa[tb][4 * g] * (rsn * gh[0]) * __builtin_amdgcn_rcpf(1.0f + __expf(-o0)), v1 = oa[tb][4 * g + 1] * (rsn * gh[1]) * __builtin_amdgcn_rcpf(1.0f + __expf(-o1));
                    const float v2 = oa[tb][4 * g + 2] * (rsn * gh[2]) * __builtin_amdgcn_rcpf(1.0f + __expf(-o2)), v3 = oa[tb][4 * g + 3] * (rsn * gh[3]) * __builtin_amdgcn_rcpf(1.0f + __expf(-o3));
                    u32x2 w; w.x = pkbf(v0, v1); w.y = pkbf(v2, v3); *(GAS u32x2*)(op + 8 * g) = w; } } }
    }
#pragma unroll
    for (int kb = 0; kb < 4; ++kb)
#pragma unroll
        for (int g = 0; g < 4; ++g) { const f32x4 st = (f32x4){cT[kb][4 * g], cT[kb][4 * g + 1], cT[kb][4 * g + 2], cT[kb][4 * g + 3]};
            *(GAS f32x4*)(cout + (size_t)(32 * wid + r32) * 128 + 32 * kb + 8 * g + 4 * hi) = st; }
    __syncthreads();
    if (tid < 128) ((GAS float*)nout)[tid] = NST[tid];
    if (tid == 0) ((GAS float*)mout)[0] = m;
#undef ML_LOADQK
#undef ML_LOADV
}

__device__ __forceinline__ void mlstm_passA(LAS char* L, const bf16_t* P, const float* G, bf16_t* UC, float* GS, float* NL, int ci, size_t rb, int hh, const int wv) {
    const int tid = opaque_tid(wv), lane = tid & 63, wid = __builtin_amdgcn_readfirstlane(tid >> 6), r32 = lane & 31, hi = lane >> 5, i16 = lane & 15, cb = (lane >> 4) & 1;
    LAS float* NPART = (LAS float*)(L + ML_NP);
    const float ig = ((const GAS float*)G)[(rb + lane) * 16 + hh], lf = ((const GAS float*)G)[(rb + lane) * 16 + 4 + hh];
    const float bcs = scan_sum64l(lf, lane), u = ig - bcs, pm = scan_max64l(u, lane);
    const float pm63 = __int_as_float(__builtin_amdgcn_readlane(__float_as_int(pm), 63));
    const float av = __expf(u - pm63);
    if (wid == 0) { ((GAS float*)GS)[(size_t)ci * 128 + lane] = bcs; ((GAS float*)GS)[(size_t)ci * 128 + 64 + lane] = pm; }
#pragma unroll
    for (int i = 0; i < 2; ++i) { const int c = tid + 512 * i, row = c >> 4, ch = c & 15;
        const u32x4 kr = *(const GAS u32x4*)(P + (rb + row) * NP + PC_KA + hh * 128 + ch * 8);
        const float as = bperm_f(row, av); u32x4 w;
        w.x = pkbf(bflo(kr.x) * as, bfhi(kr.x) * as); w.y = pkbf(bflo(kr.y) * as, bfhi(kr.y) * as);
        w.z = pkbf(bflo(kr.z) * as, bfhi(kr.z) * as); w.w = pkbf(bflo(kr.w) * as, bfhi(kr.w) * as);
        *(LAS u32x4*)(L + ML_KT + row * KTP + ch * 16) = w; }
#pragma unroll
    for (int i = 0; i < 4; ++i) { const int c = tid + 512 * i, row = c >> 5, ch = c & 31;
        *(LAS u32x4*)(L + ML_V + row * VP + ch * 16) = *(const GAS u32x4*)(P + (rb + row) * NP + PC_VA + hh * 256 + ch * 8); }
    __syncthreads();
    bf16x8 vf[4];
#pragma unroll
    for (int ss = 0; ss < 4; ++ss) { LAS const char* vp = L + ML_V + (16 * ss + 8 * hi + (i16 >> 2)) * VP + (32 * wid + 16 * cb + 4 * (i16 & 3)) * 2; vf[ss] = cat44(lds_tr(vp), lds_tr(vp + 4 * VP)); }
    f32x16 cT[4];
#pragma unroll
    for (int kb = 0; kb < 4; ++kb)
#pragma unroll
        for (int r = 0; r < 16; ++r) cT[kb][r] = 0.f;
    {   s16x4 kt[16][2];
#pragma unroll
        for (int ss = 0; ss < 4; ++ss)
#pragma unroll
            for (int kb = 0; kb < 4; ++kb) { LAS const char* kp = L + ML_KT + (16 * ss + 8 * hi + (i16 >> 2)) * KTP + (32 * kb + 16 * cb + 4 * (i16 & 3)) * 2; kt[4 * ss + kb][0] = lds_tr(kp); kt[4 * ss + kb][1] = lds_tr(kp + 4 * KTP); }
        __builtin_amdgcn_sched_barrier(0);
#pragma unroll
        for (int ss = 0; ss < 4; ++ss)
#pragma unroll
            for (int kb = 0; kb < 4; ++kb) cT[kb] = mfma32(cat44(kt[4 * ss + kb][0], kt[4 * ss + kb][1]), vf[ss], cT[kb]);
        __builtin_amdgcn_sched_barrier(0); }
    { float a0 = 0.f, a1 = 0.f;
#pragma unroll
        for (int s = 0; s < 8; ++s) { a0 += bf2f(*(LAS const bf16_t*)(L + ML_KT + (8 * wid + s) * KTP + lane * 2)); a1 += bf2f(*(LAS const bf16_t*)(L + ML_KT + (8 * wid + s) * KTP + 128 + lane * 2)); }
        NPART[wid * 128 + lane] = a0; NPART[wid * 128 + 64 + lane] = a1; }
    GAS bf16_t* uo = (GAS bf16_t*)UC + (size_t)ci * 32768 + (size_t)wid * 4096 + lane * 8;
#pragma unroll
    for (int kb = 0; kb < 4; ++kb)
#pragma unroll
        for (int s2 = 0; s2 < 2; ++s2) { u32x4 w; w.x = pkbf(cT[kb][8 * s2], cT[kb][8 * s2 + 1]); w.y = pkbf(cT[kb][8 * s2 + 2], cT[kb][8 * s2 + 3]); w.z = pkbf(cT[kb][8 * s2 + 4], cT[kb][8 * s2 + 5]); w.w = pkbf(cT[kb][8 * s2 + 6], cT[kb][8 * s2 + 7]);
            *(GAS u32x4*)(uo + (kb * 2 + s2) * 512) = w; }
    __syncthreads();
    if (tid < 128) { float acc = 0.f;
#pragma unroll
        for (int w = 0; w < 8; ++w) acc += NPART[w * 128 + tid];
        ((GAS float*)NL)[(size_t)ci * 128 + tid] = acc; }
}

__device__ __forceinline__ void mlstm_passB(bf16_t* UC, const float* GS, const float* NL, float* NSV, float* MSV, float* out_c, float* out_n, float* out_m, int gtid, int nthreads) {
    const GAS float* gs = (const GAS float*)GS;
    for (int e = gtid; e < 16 * 4096; e += nthreads) {
        const int chain = e >> 12, f = e & 4095;
        float c[8]; float m = 0.f;
#pragma unroll
        for (int i = 0; i < 8; ++i) c[i] = 0.f;
        GAS u32x4* up = (GAS u32x4*)((GAS bf16_t*)UC + (size_t)chain * 64 * 32768 + (size_t)f * 8);
        for (int j0 = 0; j0 < 64; j0 += 8) {
            u32x4 uw8[8]; float b8[8], p8[8];
#pragma unroll
            for (int jj = 0; jj < 8; ++jj) { const int ci = chain * 64 + j0 + jj; uw8[jj] = up[(size_t)(j0 + jj) * 4096]; b8[jj] = gs[(size_t)ci * 128 + 63]; p8[jj] = gs[(size_t)ci * 128 + 127]; }
#pragma unroll
            for (int jj = 0; jj < 8; ++jj) { const float b63 = b8[jj], pm63 = p8[jj];
                const float mn = b63 + fmaxf(m, pm63), dec = __expf(b63 + m - mn), w = __expf(b63 + pm63 - mn); m = mn;
                const u32x4 uw = uw8[jj];
                c[0] = dec * c[0] + w * bflo(uw.x); c[1] = dec * c[1] + w * bfhi(uw.x); c[2] = dec * c[2] + w * bflo(uw.y); c[3] = dec * c[3] + w * bfhi(uw.y);
                c[4] = dec * c[4] + w * bflo(uw.z); c[5] = dec * c[5] + w * bfhi(uw.z); c[6] = dec * c[6] + w * bflo(uw.w); c[7] = dec * c[7] + w * bfhi(uw.w);
                u32x4 o; o.x = pkbf(c[0], c[1]); o.y = pkbf(c[2], c[3]); o.z = pkbf(c[4], c[5]); o.w = pkbf(c[6], c[7]); uw8[jj] = o; }
#pragma unroll
            for (int jj = 0; jj < 8; ++jj) up[(size_t)(j0 + jj) * 4096] = uw8[jj]; }
        const int ln = f & 63, ks = (f >> 6) & 7, w8 = f >> 9;
        const int v = 32 * w8 + (ln & 31), k = 32 * (ks >> 1) + 16 * (ks & 1) + 4 * (ln >> 5);
        GAS float* oc = (GAS float*)out_c + (size_t)chain * 32768 + (size_t)v * 128 + k;
        *(GAS f32x4*)oc = (f32x4){c[0], c[1], c[2], c[3]}; *(GAS f32x4*)(oc + 8) = (f32x4){c[4], c[5], c[6], c[7]};
    }
    const int nt = gtid - 16 * 4096;
    if (nt >= 0 && nt < 16 * 128) { const int chain = nt >> 7, k = nt & 127; float n = 0.f, m = 0.f;
        for (int j0 = 0; j0 < 64; j0 += 8) { float b8[8], p8[8], l8[8];
#pragma unroll
            for (int jj = 0; jj < 8; ++jj) { const int ci = chain * 64 + j0 + jj; b8[jj] = gs[(size_t)ci * 128 + 63]; p8[jj] = gs[(size_t)ci * 128 + 127]; l8[jj] = ((const GAS float*)NL)[(size_t)ci * 128 + k]; }
#pragma unroll
            for (int jj = 0; jj < 8; ++jj) { const int ci = chain * 64 + j0 + jj;
                const float mn = b8[jj] + fmaxf(m, p8[jj]), dec = __expf(b8[jj] + m - mn), w = __expf(b8[jj] + p8[jj] - mn); m = mn;
                n = dec * n + w * l8[jj];
                ((GAS float*)NSV)[(size_t)ci * 128 + k] = n; if (k == 0) ((GAS float*)MSV)[ci] = m; } }
        ((GAS float*)out_n)[chain * 128 + k] = n; if (k == 0) ((GAS float*)out_m)[chain] = m; }
}

__device__ __forceinline__ void mlstm_passC(LAS char* L, const bf16_t* P, const float* G, const bf16_t* UC, const float* GS, const float* NSV, const float* MSV, bf16_t* MIX, const float* ghead,
                                            int ci, int j, size_t rb, int hh, const int wv) {
    const int tid = opaque_tid(wv), lane = tid & 63, wid = __builtin_amdgcn_readfirstlane(tid >> 6), r32 = lane & 31, hi = lane >> 5, i16 = lane & 15, cb = (lane >> 4) & 1;
    LAS float* FA = (LAS float*)(L + ML_FA); LAS float* ROWT = FA, *COLS = FA + 64, *WINT = FA + 128, *EMT = FA + 192, *NQ = FA + 256;
    LAS float* NST = (LAS float*)(L + ML_N); LAS float* SSQ = (LAS float*)(L + ML_SSQ); LAS float* RS = (LAS float*)(L + ML_RS); LAS float* GH = (LAS float*)(L + ML_GH);
    {
        const float ig = ((const GAS float*)G)[(rb + lane) * 16 + hh], bcs = ((const GAS float*)GS)[(size_t)ci * 128 + lane], pm = ((const GAS float*)GS)[(size_t)ci * 128 + 64 + lane];
        const float m = j > 0 ? ((const GAS float*)MSV)[ci - 1] : 0.f, mt = bcs + fmaxf(m, pm);
        if (wid == 0) { ROWT[lane] = bcs - mt; COLS[lane] = ig - bcs; WINT[lane] = __expf(bcs + m - mt); EMT[lane] = __expf(-mt); }
    }
    u32x2 og[2][4];
#pragma unroll
    for (int tb = 0; tb < 2; ++tb)
#pragma unroll
        for (int g = 0; g < 4; ++g) og[tb][g] = *(const GAS u32x2*)(P + (rb + 32 * tb + r32) * NP + PC_OA + hh * 256 + 32 * wid + 8 * g + 4 * hi);
    u32x4 af[8];
    if (j > 0) { const GAS bf16_t* ui = (const GAS bf16_t*)UC + (size_t)(ci - 1) * 32768 + (size_t)wid * 4096 + lane * 8;
#pragma unroll
        for (int st = 0; st < 8; ++st) af[st] = *(const GAS u32x4*)(ui + st * 512); }
    if (tid < 128) NST[tid] = j > 0 ? ((const GAS float*)NSV)[(size_t)(ci - 1) * 128 + tid] : 0.f;
    if (tid < 256) GH[tid] = ((const GAS float*)ghead)[hh * 256 + tid];
#pragma unroll
    for (int i = 0; i < 2; ++i) { const int c = tid + 512 * i, row = c >> 4, ch = c & 15;
        *(LAS u32x4*)(L + ML_Q + row * 272 + ch * 16) = *(const GAS u32x4*)(P + (rb + row) * NP + PC_QA + hh * 128 + ch * 8);
        *(LAS u32x4*)(L + ML_K + row * 272 + ch * 16) = *(const GAS u32x4*)(P + (rb + row) * NP + PC_KA + hh * 128 + ch * 8); }
#pragma unroll
    for (int i = 0; i < 4; ++i) { const int c = tid + 512 * i, row = c >> 5, ch = c & 31;
        *(LAS u32x4*)(L + ML_V + row * VP + ch * 16) = *(const GAS u32x4*)(P + (rb + row) * NP + PC_VA + hh * 256 + ch * 8); }
    __syncthreads();
    {
        const int fr = lane & 15, fq = lane >> 4;
#pragma unroll
        for (int bi = 0; bi < 2; ++bi) { const int id = 2 * wid + bi, sb = id >> 2, tb = id & 3; const int t = 16 * tb + fr, s0 = 16 * sb + 4 * fq;
            u32x2 ow = (u32x2){0u, 0u};
            if (sb <= tb) { f32x4 acc = (f32x4){0.f, 0.f, 0.f, 0.f};
#pragma unroll
                for (int kk = 0; kk < 4; ++kk) { const bf16x8 a = *(LAS const bf16x8*)(L + ML_K + (16 * sb + fr) * 272 + kk * 64 + fq * 16), q = *(LAS const bf16x8*)(L + ML_Q + (16 * tb + fr) * 272 + kk * 64 + fq * 16);
                    acc = mfma16(a, q, acc); }
                const float rt = ROWT[t]; const f32x4 cs = *(LAS const f32x4*)(COLS + s0); float v[4];
#pragma unroll
                for (int i = 0; i < 4; ++i) v[i] = (s0 + i <= t) ? acc[i] * __expf(rt + cs[i]) : 0.f;
                ow.x = pkbf(v[0], v[1]); ow.y = pkbf(v[2], v[3]); }
            *(LAS u32x2*)(L + ML_S + t * 144 + s0 * 2) = ow;
            float ps = (bflo(ow.x) + bfhi(ow.x)) + (bflo(ow.y) + bfhi(ow.y));
            { auto r1 = __builtin_amdgcn_permlane16_swap(__float_as_uint(ps), __float_as_uint(ps), false, false); ps = __uint_as_float(r1[0]) + __uint_as_float(r1[1]); }
            ps = xsum32(ps);
            if (fq == 0) RS[sb * 64 + t] = ps; }
        const int t = 8 * wid + (lane >> 3), kp = lane & 7;
        const u32x4 q0 = *(LAS const u32x4*)(L + ML_Q + t * 272 + kp * 32), q1 = *(LAS const u32x4*)(L + ML_Q + t * 272 + kp * 32 + 16);
        const f32x4 n0v = *(LAS const f32x4*)(NST + 16 * kp), n1v = *(LAS const f32x4*)(NST + 16 * kp + 4), n2v = *(LAS const f32x4*)(NST + 16 * kp + 8), n3v = *(LAS const f32x4*)(NST + 16 * kp + 12);
        float d = bflo(q0.x) * n0v[0] + bfhi(q0.x) * n0v[1] + bflo(q0.y) * n0v[2] + bfhi(q0.y) * n0v[3] + bflo(q0.z) * n1v[0] + bfhi(q0.z) * n1v[1] + bflo(q0.w) * n1v[2] + bfhi(q0.w) * n1v[3]
                + bflo(q1.x) * n2v[0] + bfhi(q1.x) * n2v[1] + bflo(q1.y) * n2v[2] + bfhi(q1.y) * n2v[3] + bflo(q1.z) * n3v[0] + bfhi(q1.z) * n3v[1] + bflo(q1.w) * n3v[2] + bfhi(q1.w) * n3v[3];
        d += dpp_f(d, 0); d += dpp_f(d, 1); d += dpp_f(d, 2);
        if (kp == 0) NQ[t] = d;
    }
    __syncthreads();
    bf16x8 vf[4];
#pragma unroll
    for (int ss = 0; ss < 4; ++ss) { LAS const char* vp = L + ML_V + (16 * ss + 8 * hi + (i16 >> 2)) * VP + (32 * wid + 16 * cb + 4 * (i16 & 3)) * 2; vf[ss] = cat44(lds_tr(vp), lds_tr(vp + 4 * VP)); }
    f32x16 oa[2];
#pragma unroll
    for (int tb = 0; tb < 2; ++tb)
#pragma unroll
        for (int r = 0; r < 16; ++r) oa[tb][r] = 0.f;
    if (j > 0) {
        u32x2 qw[16][2];
#pragma unroll
        for (int st = 0; st < 8; ++st)
#pragma unroll
            for (int tb = 0; tb < 2; ++tb) { LAS const char* qp = L + ML_Q + (32 * tb + r32) * 272 + (16 * st + 4 * hi) * 2; qw[2 * st + tb][0] = *(LAS const u32x2*)qp; qw[2 * st + tb][1] = *(LAS const u32x2*)(qp + 16); }
        __builtin_amdgcn_sched_barrier(0);
#pragma unroll
        for (int st = 0; st < 8; ++st)
#pragma unroll
            for (int tb = 0; tb < 2; ++tb) { const u32x4 bw = (u32x4){qw[2 * st + tb][0].x, qw[2 * st + tb][0].y, qw[2 * st + tb][1].x, qw[2 * st + tb][1].y};
                oa[tb] = mfma32(__builtin_bit_cast(bf16x8, af[st]), __builtin_bit_cast(bf16x8, bw), oa[tb]); }
        __builtin_amdgcn_sched_barrier(0);
    }
#pragma unroll
    for (int tb = 0; tb < 2; ++tb) { const float w = WINT[32 * tb + r32];
#pragma unroll
        for (int r = 0; r < 16; ++r) oa[tb][r] *= w;
#pragma unroll
        for (int ss = 0; ss < 4; ++ss) if (tb == 1 || ss < 2) { const u32x4 sw = *(LAS const u32x4*)(L + ML_S + (32 * tb + r32) * 144 + (16 * ss + 8 * hi) * 2);
            oa[tb] = mfma32(vf[ss], __builtin_bit_cast(bf16x8, sw), oa[tb]); } }
#pragma unroll
    for (int tb = 0; tb < 2; ++tb) { const int t = 32 * tb + r32; const float rs = (RS[t] + RS[64 + t]) + (RS[128 + t] + RS[192 + t]);
        const float den = WINT[t] * NQ[t] + rs, dn = fmaxf(fabsf(den), EMT[t]), inv = __builtin_amdgcn_rcpf(dn); float sq = 0.f;
#pragma unroll
        for (int r = 0; r < 16; ++r) { oa[tb][r] *= inv; sq += oa[tb][r] * oa[tb][r]; }
        sq = xsum32(sq);
        if (hi == 0) SSQ[wid * 64 + t] = sq; }
    __syncthreads();
#pragma unroll
    for (int tb = 0; tb < 2; ++tb) { const int t = 32 * tb + r32; float tot = 0.f;
#pragma unroll
        for (int w = 0; w < 8; ++w) tot += SSQ[w * 64 + t];
        const float rsn = __builtin_amdgcn_rsqf(tot * (1.0f / 256.0f) + HN_EPS);
        GAS bf16_t* op = (GAS bf16_t*)MIX + (rb + t) * DM + hh * 256 + 32 * wid + 4 * hi;
#pragma unroll
        for (int g = 0; g < 4; ++g) { const u32x2 ov = og[tb][g]; const float o0 = bflo(ov.x), o1 = bfhi(ov.x), o2 = bflo(ov.y), o3 = bfhi(ov.y);
            const f32x4 gh = *(LAS const f32x4*)(GH + 32 * wid + 8 * g + 4 * hi);
            const float v0 = oa[tb][4 * g] * (rsn * gh[0]) * __builtin_amdgcn_rcpf(1.0f + __expf(-o0)), v1 = oa[tb][4 * g + 1] * (rsn * gh[1]) * __builtin_amdgcn_rcpf(1.0f + __expf(-o1));
            const float v2 = oa[tb][4 * g + 2] * (rsn * gh[2]) * __builtin_amdgcn_rcpf(1.0f + __expf(-o2)), v3 = oa[tb][4 * g + 3] * (rsn * gh[3]) * __builtin_amdgcn_rcpf(1.0f + __expf(-o3));
            u32x2 w; w.x = pkbf(v0, v1); w.y = pkbf(v2, v3); *(GAS u32x2*)(op + 8 * g) = w; } }
}

#define XB_TMO      128
#define XB_XCNT(j)  (256  + 64 * (j))
#define XB_XSUB(j)  (1280 + 64 * (j))
#define XB_XGEN(j)  (2304 + 64 * (j))
#define XB_TOP      3328
#define XB_TOPGEN   3392
#define XCD_BAR_WORDS 3456
#define XB_SPIN_CAP (1u << 18)

__device__ __forceinline__ unsigned xb_ld(unsigned* p)              { return __hip_atomic_load(p, __ATOMIC_RELAXED, __HIP_MEMORY_SCOPE_AGENT); }
__device__ __forceinline__ unsigned xb_add(unsigned* p, unsigned v) { return __hip_atomic_fetch_add(p, v, __ATOMIC_RELAXED, __HIP_MEMORY_SCOPE_AGENT); }
__device__ __forceinline__ unsigned xb_xcc_id() { return (unsigned)__builtin_amdgcn_s_getreg((3 << 11) | 20) & 0xFu; }
#define XB_SPIN(cond, bar) do { unsigned _sp = 0; while (cond) { __builtin_amdgcn_s_sleep(1); \
    if ((++_sp & 255u) == 0u) { if (xb_ld(&(bar)[XB_TMO])) break; if (_sp > XB_SPIN_CAP) { atomicAdd(&(bar)[XB_TMO], 1u); break; } } } } while (0)

struct XcdBarrier {
    unsigned* bar; unsigned x;
    volatile LAS unsigned* st;
};

__device__ __forceinline__ XcdBarrier xcd_barrier_post(unsigned* bar, volatile LAS unsigned* st) {
    XcdBarrier b; b.bar = bar; b.x = xb_xcc_id(); b.st = st;
    if (threadIdx.x == 0) (void)xb_add(&bar[XB_XCNT(b.x)], 1u);
    return b;
}
__device__ __forceinline__ void xcd_barrier_complete(unsigned* bar, unsigned x, unsigned& nloc, unsigned& nx) {
    const unsigned G = gridDim.x * gridDim.y * gridDim.z;
    unsigned sum, cnt, mine, sp = 0u;
    for (;;) {
        sum = 0u; cnt = 0u; mine = 0u;
#pragma unroll
        for (unsigned j = 0; j < 16; ++j) { const unsigned c = xb_ld(&bar[XB_XCNT(j)]); sum += c; cnt += (c > 0u) ? 1u : 0u; mine = (j == x) ? c : mine; }
        if (sum == G) break;
        __builtin_amdgcn_s_sleep(1);
        if ((++sp & 255u) == 0u) { if (xb_ld(&bar[XB_TMO])) break; if (sp > XB_SPIN_CAP) { atomicAdd(&bar[XB_TMO], 1u); break; } }
    }
    nloc = mine > 0u ? mine : 1u; nx = cnt > 0u ? cnt : 1u;
}

__device__ __forceinline__ void xcd_barrier(const XcdBarrier& b) {
    asm volatile("s_waitcnt vmcnt(0)" ::: "memory");
    __syncthreads();
    if (threadIdx.x == 0) {
        unsigned* bar = b.bar;
        __builtin_amdgcn_s_waitcnt(0);
        unsigned nloc = b.st[0], nx = b.st[1];
        if (nloc == 0u) { xcd_barrier_complete(bar, b.x, nloc, nx); b.st[0] = nloc; b.st[1] = nx; }
        const unsigned old = xb_add(&bar[XB_XSUB(b.x)], 1u);
        const unsigned gen = old / nloc;
        if (old + 1u == (gen + 1u) * nloc) {
            __builtin_amdgcn_fence(__ATOMIC_RELEASE, "agent");
            asm volatile("s_waitcnt vmcnt(0)" ::: "memory");
            const unsigned og = xb_add(&bar[XB_TOP], 1u);
            const unsigned tg = og / nx;
            if (og + 1u == (tg + 1u) * nx) xb_add(&bar[XB_TOPGEN], 1u);
            else XB_SPIN(xb_ld(&bar[XB_TOPGEN]) == tg, bar);
            __builtin_amdgcn_fence(__ATOMIC_ACQUIRE, "agent");
            xb_add(&bar[XB_XGEN(b.x)], 1u);
            asm volatile("s_waitcnt vmcnt(0)" ::: "memory");
        } else {
            XB_SPIN(xb_ld(&bar[XB_XGEN(b.x)]) == gen, bar);
            __builtin_amdgcn_fence(__ATOMIC_ACQUIRE, "agent");
            asm volatile("s_waitcnt vmcnt(0)" ::: "memory");
        }
    }
    __syncthreads();
}

constexpr int LDS_BYTES = 147456;
constexpr int NPHASE = 15;
constexpr int NCONV_EARLY = 32 * 200 + 32 * 64 + 32 * 256;
constexpr int NCONV_ITEMS = NCONV_EARLY / 16;
#ifndef PH_MASK
#define PH_MASK 0xFFFF
#endif
#define PHON(k) ((PH_MASK >> (k)) & 1)
__global__ void __launch_bounds__(512) fwd_megakernel(Args args) {
    extern __shared__ __attribute__((aligned(16))) unsigned char lds_raw[];
    LAS unsigned char* lds = (LAS unsigned char*)lds_raw;
    cg::grid_group grid = cg::this_grid();
    const int wv = __builtin_amdgcn_readfirstlane((int)threadIdx.x >> 6);
    volatile LAS unsigned* xst = (volatile LAS unsigned*)(lds + LDS_BYTES - 32);
    if (threadIdx.x < 2) xst[threadIdx.x] = 0u;
    __syncthreads();
    const XcdBarrier xbar = xcd_barrier_post((unsigned*)as_global(args.ws) + 4096, xst);
    if (args.ph_lo < 0) grid.sync();
#define GRID_SYNC() xcd_barrier(xbar)
    const int G = gridDim.x, NGW = G * 8, wave = wv, gw = blockIdx.x * 8 + wave;
#define KT_LANE() (opaque_tid(wv) & 63)
#ifndef REP_SUB
#define REP_SUB -1
#define REP_N 0
#endif
    for (int ph = args.ph_lo; ph < args.ph_hi; ++ph) {
      const int nrep = (REP_SUB >= 0 && ph > 0 && (ph - 1) % 7 == REP_SUB) ? 1 + REP_N : 1;
      for (int rep = 0; rep < nrep; ++rep) {
        unsigned char* ws = args.ws; float* out = args.out; asm volatile("" : "+s"(ws), "+s"(out)); ws = as_global(ws); out = as_global(out);
    bf16_t* XB = (bf16_t*)(ws + WS_XB); bf16_t* Pb = (bf16_t*)(ws + WS_P); bf16_t* MIX = (bf16_t*)(ws + WS_MIX); bf16_t* Hb = (bf16_t*)(ws + WS_H);
    float* Gt = (float*)(ws + WS_G); float* lfT = (float*)(ws + WS_LFT); float* lfS = (float*)(ws + WS_LFS); bf16_t* Z = (bf16_t*)(ws + WS_Z);
    unsigned* ctl = (unsigned*)(ws + WS_CTL); float* PART = (float*)(ws + WS_PART);
        const int wave = wv, gw = blockIdx.x * 8 + wave;
#define KT_LANE() (opaque_tid(wv) & 63)
        if (ph == 0) { if (PHON(0)) {
            convert_x(args, gw, NGW, KT_LANE());
            convert_weights(args, 0, (LAS float*)(lds + wave * 16384), gw, NGW, KT_LANE(), 6400);
            convert_weights(args, 0, (LAS float*)(lds + wave * 16384), 12544 + gw, NGW, KT_LANE()); }
        } else {
            const int layer = (ph - 1) / 7, sub = (ph - 1) % 7;
            if (sub == 0) { if (PHON(1)) {
                pg8::Gemm g{XB, (const bf16_t*)(ws + WS_WIN), MPAD, NIN, DM, DM}; pg8::StaticOrder S; S.init(MPAD, NIN, G, (int)blockIdx.x);
                EpiIn E{Pb, Gt, lfT, lfS, as_global(args.in[9]) + layer * 16, out + O_KP + (size_t)layer * MP * 1024, out + O_VP + (size_t)layer * MP * 1024,
                        out + O_KS + (size_t)layer * MS * 1024, out + O_VS + (size_t)layer * MS * 1024, out + O_LFP + (size_t)layer * MP * 8, out + O_LFS + (size_t)layer * MS * 8};
                pg8::gemm_phase<EpiIn, pg8::StaticOrder, true, true>(lds, g, S, E, wv);
                {
                    LAS int* slot = (LAS int*)(lds + LDS_BYTES - 64);
                    for (;;) {
                        __syncthreads();
                        if (opaque_tid(wv) == 0) slot[0] = (int)atomicAdd(ctl + 64 * (15 + layer), 1u);
                        __syncthreads();
                        const int it = slot[0];
                        if (it >= 384) break;
                        const int c0i = 6400 + it * 16;
                        convert_weights(args, layer, (LAS float*)(lds + wave * 16384), c0i + wave, 8, KT_LANE(), c0i + 16); } } }
            } else if (sub == 1) {
                LAS int* slot = (LAS int*)(lds + LDS_BYTES - 64);
                bf16_t* UC = (bf16_t*)Z; float* GS = (float*)((unsigned char*)Z + 64 * MiB); float* NL = GS + 1024 * 128; float* NSV = NL + 1024 * 128; float* MSV = NSV + 1024 * 128;
#ifndef REP_STAGE
#define REP_STAGE 0
#endif
                for (int r2 = 0; r2 < (REP_STAGE == 1 ? 2 : 1); ++r2) { if (r2) GRID_SYNC();
                for (;;) {
                    __syncthreads();
                    if (opaque_tid(wv) == 0) slot[0] = (int)atomicAdd(ctl + 64 * (1 + layer + 2 * r2), 1u);
                    __syncthreads();
                    const int it = slot[0];
                    if (it >= 1632) break;
                    if (it >= 608) { if (PHON(2)) { const int ci = it - 608, chain = ci >> 6, j = ci & 63;
                        mlstm_passA((LAS char*)lds, Pb, Gt, UC, GS, NL, ci, (size_t)(chain >> 2) * SEQ + 64 * j, chain & 3, wv); }
                    } else if (it >= 64 && it < 96) { if (PHON(2)) { const int sb = (it - 64) >> 2, hh = (it - 64) & 3; const size_t si = (size_t)(layer * 8 + sb) * 4 + hh;
                        mlstm_item((LAS char*)lds, Pb, Gt, MIX, as_global(args.in[10]) + layer * 1024, (size_t)MP + sb * 16, hh, 1, 16, as_global(args.in[5]) + si * 32768, as_global(args.in[6]) + si * 128, as_global(args.in[7]) + si,
                                   out + O_CS + si * 32768, out + O_NS + si * 128, out + O_MS + si, wv); }
                    } else if (it < 64) { if (PHON(3)) { const int sb = it >> 3, h = it & 7;
                        fox_sample_item((LAS char*)lds, Pb, lfS, as_global(args.in[2]) + (size_t)layer * SBATCH * PAST * 1024, as_global(args.in[3]) + (size_t)layer * SBATCH * PAST * 1024,
                                        as_global(args.in[4]) + (size_t)layer * SBATCH * PAST * 8, MIX, sb, h, wv); }
                    } else if (PHON(4)) { const int qb = 15 - ((it - 96) >> 5), bh = (it - 96) & 31;
                        fox_prompt_unit((LAS char*)lds, Pb, lfT, MIX, bh >> 3, bh & 7, qb, wv); }
                } }
                GRID_SYNC();
                for (int r2 = 0; r2 < (REP_STAGE == 2 ? 2 : 1); ++r2) { if (r2) GRID_SYNC();
                if (PHON(2)) mlstm_passB(UC, GS, NL, NSV, MSV, out + O_CP + (size_t)layer * 16 * 32768, out + O_NP + (size_t)layer * 16 * 128, out + O_MP + layer * 16,
                                        (int)blockIdx.x * 512 + opaque_tid(wv), G * 512); }
                GRID_SYNC();
                for (int r2 = 0; r2 < (REP_STAGE == 3 ? 2 : 1); ++r2) { if (r2) GRID_SYNC();
                for (int it = (int)blockIdx.x; it < 1024; it += G) {
                    __syncthreads();
                    if (PHON(2)) { const int ci = it, chain = ci >> 6, j = ci & 63;
                        mlstm_passC((LAS char*)lds, Pb, Gt, UC, GS, NSV, MSV, MIX, as_global(args.in[10]) + layer * 1024, ci, j, (size_t)(chain >> 2) * SEQ + 64 * j, chain & 3, wv); }
                } }
            } else if (sub == 2) { if (PHON(5)) {
                { pg8::Gemm g{MIX, (const bf16_t*)(ws + (layer ? WS_WOUT2 : WS_WOUT)), MP, DM, DM, DM}; pg8::StaticOrder S; S.init(MP, DM, G, (int)blockIdx.x);
                  EpiRes E{XB, Z};
                  pg8::gemm_phase<EpiRes, pg8::StaticOrder, true, true>(lds, g, S, E, wv); }
                { pg8::Gemm g{MIX, (const bf16_t*)(ws + (layer ? WS_WOUT2 : WS_WOUT)), MPAD, DM, DM / NSL_OUT, DM}; pg8::SplitOrder S; S.init(DM, NSL_OUT, MP / 256, G, (int)blockIdx.x);
                  EpiPart E{PART};
                  pg8::gemm_phase<EpiPart, pg8::SplitOrder, true, true>(lds, g, S, E, wv); } }
            } else if (sub == 3) {
                if (PHON(6)) ln_phase(Z, XB, PART, NSL_OUT, as_global(args.in[12]) + layer * DM, as_global(args.in[13]) + layer * DM, XB, nullptr, nullptr, gw, NGW, KT_LANE(), (LAS float*)lds, wave, (int)blockIdx.x, G);
            } else if (sub == 4) { if (PHON(7)) {
                pg8::Gemm g{XB, (const bf16_t*)(ws + (layer ? WS_WUP2 : WS_WUP)), MPAD, DFF, DM, DM}; pg8::StaticOrder S; S.init(MPAD, DFF, G, (int)blockIdx.x);
                EpiUp E{Hb};
                pg8::gemm_phase<EpiUp, pg8::StaticOrder, true, true>(lds, g, S, E, wv);
                {
                    const int nitems = layer == 0 ? 400 + 256 : 512;
                    LAS int* slot = (LAS int*)(lds + LDS_BYTES - 64);
                    for (;;) {
                        __syncthreads();
                        if (opaque_tid(wv) == 0) slot[0] = (int)atomicAdd(ctl + 64 * (13 + layer), 1u);
                        __syncthreads();
                        const int it = slot[0];
                        if (it >= nitems) break;
                        const int c0i = layer == 0 ? (it < 400 ? it * 16 : 12544 + (it - 400) * 16) : NCONV_EARLY + it * 16;
                        convert_weights(args, 1, (LAS float*)(lds + wave * 16384), c0i + wave, 8, KT_LANE(), c0i + 16); } } }
            } else if (sub == 5) { if (PHON(8)) {
                { pg8::Gemm g{Hb, (const bf16_t*)(ws + WS_WDN), MP, DM, DFF, DFF}; pg8::StaticOrder S; S.init(MP, DM, G, (int)blockIdx.x);
                  EpiRes E{XB, Z};
                  pg8::gemm_phase<EpiRes, pg8::StaticOrder, true, true>(lds, g, S, E, wv); }
                { pg8::Gemm g{Hb, (const bf16_t*)(ws + WS_WDN), MPAD, DM, DFF / NSL_DN, DFF}; pg8::SplitOrder S; S.init(DM, NSL_DN, MP / 256, G, (int)blockIdx.x);
                  EpiPart E{PART};
                  pg8::gemm_phase<EpiPart, pg8::SplitOrder, true, true>(lds, g, S, E, wv); } }
            } else if (PHON(9)) {
                if (layer == 0) { ln_phase(Z, XB, PART, NSL_DN, as_global(args.in[16]), as_global(args.in[17]), XB, nullptr, nullptr, gw, NGW, KT_LANE(), (LAS float*)lds, wave, (int)blockIdx.x, G);
                    }
                else ln_phase(Z, XB, PART, NSL_DN, as_global(args.in[16]) + DM, as_global(args.in[17]) + DM, nullptr, out + O_YP, out + O_YS, gw, NGW, KT_LANE(), (LAS float*)lds, wave, (int)blockIdx.x, G);
            }
        }
        if (rep + 1 < nrep) GRID_SYNC();
      }
        if (ph + 1 < args.ph_hi) GRID_SYNC();
    }
}

extern "C" void kernel_launch(void* const* d_in, const int* in_sizes, int n_in, void* d_out, int out_size, void* d_ws, size_t ws_size, hipStream_t stream) {
    static int grid = 0;
    if (grid == 0) {
        if (n_in != 18 || (size_t)out_size != O_END || ws_size < WS_END) { fprintf(stderr, "kernel_launch: unexpected shapes (n_in %d out %d ws %zu)\n", n_in, out_size, ws_size); grid = -1; return; }
        int dev = 0, cus = 0, per_cu = 0;
        hipGetDevice(&dev); hipDeviceGetAttribute(&cus, hipDeviceAttributeMultiprocessorCount, dev);
        hipFuncSetAttribute((const void*)fwd_megakernel, hipFuncAttributeMaxDynamicSharedMemorySize, LDS_BYTES);
        hipOccupancyMaxActiveBlocksPerMultiprocessor(&per_cu, (const void*)fwd_megakernel, 512, LDS_BYTES);
        (void)hipGetLastError();
        if (per_cu < 1) per_cu = 1;
        grid = cus;
        if (grid > cus * per_cu) grid = cus * per_cu;
    }
    if (grid < 0) return;
    hipMemsetAsync((char*)d_ws + WS_CTL, 0, 65536, stream);
    Args a{};
    for (int i = 0; i < 18; ++i) a.in[i] = (const float*)d_in[i];
    a.out = (float*)d_out; a.ws = (unsigned char*)d_ws; a.ph_lo = 0; a.ph_hi = NPHASE;
    void* kargs[] = {&a};
    hipError_t e = hipLaunchCooperativeKernel((const void*)fwd_megakernel, dim3(grid), dim3(512), kargs, LDS_BYTES, stream);
    if (e != hipSuccess) fprintf(stderr, "cooperative launch failed: %s (grid %d)\n", hipGetErrorString(e), grid);
}
```
